# Optimizing an MI355X kernel written in HIP

```python
import jax, jax.numpy as jnp
from jax import lax
import numpy as np

D_MODEL = 1024
BATCH = 16
SEQ = 2048
DEPTH = 1

POOL_WINDOWS = (2, 4, 8, 16)
POOL_WIDTH = D_MODEL // 2
POOL_GROUP = POOL_WIDTH // len(POOL_WINDOWS)
N_HEADS = 8
QK_NOPE = 64
QK_ROPE = 32
QK_HEAD = QK_NOPE + QK_ROPE
V_HEAD = 64
ATTN_WIDTH = N_HEADS * V_HEAD
Q_LORA = D_MODEL // 4
KV_LORA = D_MODEL // 8
MIX_WIDTH = POOL_WIDTH + ATTN_WIDTH
IN_SPLITS = (POOL_WIDTH, POOL_WIDTH, Q_LORA, KV_LORA, QK_ROPE, ATTN_WIDTH)
IN_WIDTH = sum(IN_SPLITS)
ROPE_THETA = 10000.0
Q_BLOCK = 128
EPS = 1e-6

kernel_name = "hybrid_pool_mla_adaln_encoder_layer"


def rmsnorm(x, g):
    xf = x.astype(jnp.float32)
    r = lax.rsqrt(jnp.mean(xf * xf, axis=-1, keepdims=True) + EPS)
    return (xf * r).astype(x.dtype) * g


def rope_tables(positions):
    inv = ROPE_THETA ** (-jnp.arange(0, QK_ROPE, 2, dtype=jnp.float32) / QK_ROPE)
    ang = positions.astype(jnp.float32)[..., None] * inv
    return jnp.cos(ang)[:, :, None, :], jnp.sin(ang)[:, :, None, :]


def apply_rope(x, cos, sin):
    x1, x2 = jnp.split(x, 2, axis=-1)
    cos = cos.astype(x.dtype)
    sin = sin.astype(x.dtype)
    return jnp.concatenate([x1 * cos - x2 * sin, x2 * cos + x1 * sin], axis=-1)


def multiscale_pool(u, pool_w, pool_scale):
    B, S, P = u.shape
    uf = u.astype(jnp.float32)
    cs = jnp.concatenate([jnp.zeros((B, 1, P), jnp.float32), jnp.cumsum(uf, axis=1)], axis=1)
    t = jnp.arange(S)
    outs = []
    for gi, w in enumerate(POOL_WINDOWS):
        lo = jnp.clip(t - w // 2, 0, S)
        hi = jnp.clip(t + (w - w // 2), 0, S)
        csg = cs[..., gi * POOL_GROUP:(gi + 1) * POOL_GROUP]
        cnt = (hi - lo).astype(jnp.float32)[None, :, None]
        mean = (jnp.take(csg, hi, axis=1) - jnp.take(csg, lo, axis=1)) / cnt
        diff = (mean - uf[..., gi * POOL_GROUP:(gi + 1) * POOL_GROUP]).astype(u.dtype)
        outs.append(jnp.einsum('bsc,cd->bsd', diff, pool_w[gi]))
    return jnp.concatenate(outs, axis=-1) * pool_scale


def latent_attention(q_lat, kv_lat, k_rope_raw, cos, sin, g_q_lat, w_uq, g_kv_lat, w_ukv, g_qnorm, g_knorm):
    B, S, _ = q_lat.shape
    q = jnp.einsum('bsr,rd->bsd', rmsnorm(q_lat, g_q_lat), w_uq).reshape(B, S, N_HEADS, QK_HEAD)
    kv = jnp.einsum('bsr,rd->bsd', rmsnorm(kv_lat, g_kv_lat), w_ukv).reshape(B, S, N_HEADS, QK_NOPE + V_HEAD)
    k_nope, v = kv[..., :QK_NOPE], kv[..., QK_NOPE:]
    k_rope = jnp.broadcast_to(k_rope_raw[:, :, None, :], (B, S, N_HEADS, QK_ROPE))
    k = jnp.concatenate([k_nope, k_rope], axis=-1)
    q = rmsnorm(q, g_qnorm)
    k = rmsnorm(k, g_knorm)
    q = jnp.concatenate([q[..., :QK_NOPE], apply_rope(q[..., QK_NOPE:], cos, sin)], axis=-1)
    k = jnp.concatenate([k[..., :QK_NOPE], apply_rope(k[..., QK_NOPE:], cos, sin)], axis=-1)
    scale = QK_HEAD ** -0.5
    nblk = S // Q_BLOCK
    qb = q.reshape(B, nblk, Q_BLOCK, N_HEADS, QK_HEAD).transpose(1, 0, 2, 3, 4)

    def attend(qblk):
        s = jnp.einsum('bqhd,bkhd->bhqk', qblk, k, preferred_element_type=jnp.float32) * scale
        p = jax.nn.softmax(s, axis=-1)
        return jnp.einsum('bhqk,bkhd->bqhd', p.astype(v.dtype), v)

    o = lax.map(attend, qb)
    return o.transpose(1, 0, 2, 3, 4).reshape(B, S, ATTN_WIDTH)


def setup_inputs(seed: int = 0) -> dict:
    key = jax.random.key(seed)
    ks = jax.random.split(key, 20)
    L, D = DEPTH, D_MODEL
    nrm = lambda k, shape, fan: jax.random.normal(k, shape, jnp.float32) * fan ** -0.5
    gain = lambda k, shape: 1.0 + 0.05 * jax.random.normal(k, shape, jnp.float32)
    return {
        "x": jax.random.normal(ks[0], (BATCH, SEQ, D), jnp.float32),
        "c": jax.random.normal(ks[1], (BATCH, D), jnp.float32),
        "positions": jnp.tile(jnp.arange(SEQ, dtype=jnp.int32)[None, :], (BATCH, 1)),
        "ada_w": nrm(ks[2], (L, D, 3 * D), D) * 0.5,
        "ada_b": 0.02 * jax.random.normal(ks[3], (L, 3 * D), jnp.float32),
        "norm_g": gain(ks[4], (L, D)),
        "w_in": nrm(ks[5], (L, D, IN_WIDTH), D),
        "pool_w": nrm(ks[6], (L, len(POOL_WINDOWS), POOL_GROUP, POOL_GROUP), POOL_GROUP),
        "pool_scale": gain(ks[7], (L, POOL_WIDTH)),
        "g_q_lat": gain(ks[8], (L, Q_LORA)),
        "w_uq": nrm(ks[9], (L, Q_LORA, N_HEADS * QK_HEAD), Q_LORA),
        "g_kv_lat": gain(ks[10], (L, KV_LORA)),
        "w_ukv": nrm(ks[11], (L, KV_LORA, N_HEADS * (QK_NOPE + V_HEAD)), KV_LORA),
        "g_qnorm": gain(ks[12], (L, QK_HEAD)),
        "g_knorm": gain(ks[13], (L, QK_HEAD)),
        "w_out": nrm(ks[14], (L, MIX_WIDTH, D), MIX_WIDTH),
    }


def reference(x, c, positions, ada_w, ada_b, norm_g, w_in, pool_w, pool_scale, g_q_lat, w_uq,
              g_kv_lat, w_ukv, g_qnorm, g_knorm, w_out):
    cos, sin = rope_tables(positions)
    offs = list(np.cumsum(IN_SPLITS)[:-1])
    h = x
    c_act = jax.nn.silu(c)
    for l in range(DEPTH):
        mod = jnp.einsum('bd,de->be', c_act, ada_w[l]) + ada_b[l]
        shift, scale, gate = jnp.split(mod, 3, axis=-1)
        xn = rmsnorm(h, norm_g[l]) * (1.0 + scale[:, None, :]) + shift[:, None, :]
        proj = jnp.einsum('bsd,de->bse', xn, w_in[l])
        u_pool, g_pool, q_lat, kv_lat, k_rope_raw, g_attn = jnp.split(proj, offs, axis=-1)
        y_pool = multiscale_pool(u_pool, pool_w[l], pool_scale[l]) * jax.nn.silu(g_pool)
        y_attn = latent_attention(q_lat, kv_lat, k_rope_raw, cos, sin, g_q_lat[l], w_uq[l],
                                  g_kv_lat[l], w_ukv[l], g_qnorm[l], g_knorm[l]) * jax.nn.silu(g_attn)
        y = jnp.einsum('bsm,md->bsd', jnp.concatenate([y_pool, y_attn], axis=-1), w_out[l])
        h = h + gate[:, None, :] * y
    return h
```

```cpp
#include <hip/hip_runtime.h>
#include <cstdio>
#include <cstdint>

#ifndef MK_N_LAUNCHES
#define MK_N_LAUNCHES 6
#endif

#define GAS __attribute__((address_space(1)))
#define LAS __attribute__((address_space(3)))
typedef unsigned short bf16_t;

constexpr int DM = 1024, NB = 16, SEQ = 2048, TOK = NB * SEQ;
constexpr int NH = 8, DQK = 96, DNOPE = 64, DROPE = 32, DV = 64, QLORA = 256, KVLORA = 128, INW = 1952;
constexpr int OFF_UP = 0, OFF_GP = 512, OFF_QL = 1024, OFF_KVL = 1280, OFF_KR = 1408, OFF_GA = 1440;
constexpr float EPS = 1e-6f;
constexpr int NTHREADS = 512, NWAVES = 8;
constexpr int N_PHASES = 6;

constexpr size_t MiB = 1u << 20;
constexpr size_t WS_CTL = 0, CTL_ZERO_BYTES = 1 * MiB;
constexpr size_t WS_MODP = 1 * MiB;
constexpr size_t WS_ROPE = 2 * MiB;
constexpr size_t WS_XN = 16 * MiB;
constexpr size_t WS_UP = 80 * MiB;
constexpr size_t WS_GP = 112 * MiB;
constexpr size_t WS_GA = 144 * MiB;
constexpr size_t WS_QL = 176 * MiB;
constexpr size_t WS_KVL = 192 * MiB;
constexpr size_t WS_Q = 208 * MiB;
constexpr size_t WS_K = 256 * MiB;
constexpr size_t WS_V = 304 * MiB;
constexpr size_t WS_Y = 336 * MiB;
constexpr size_t WS_END = 400 * MiB;
constexpr int CW_BAR = 4096;

constexpr int RING_BYTES = 131072;
constexpr int LDSCTL_OFF = RING_BYTES, MISC_OFF = LDSCTL_OFF + 320;
constexpr int LDS_BYTES = 147456;

__device__ const float INVF[16] = {1.0f, 0.5623413251903491f, 0.31622776601683794f, 0.1778279410038923f, 0.1f, 0.05623413251903491f, 0.03162277660168379f,
                                   0.01778279410038923f, 0.01f, 0.005623413251903491f, 0.003162277660168379f, 0.001778279410038923f, 0.001f,
                                   0.0005623413251903491f, 0.00031622776601683794f, 0.0001778279410038923f};

__device__ __forceinline__ float bf2f(bf16_t v) { return __uint_as_float(((unsigned)v) << 16); }
__device__ __forceinline__ bf16_t f2bf(float f) { unsigned u = __float_as_uint(f); return (bf16_t)((u + 0x7fffu + ((u >> 16) & 1u)) >> 16); }
__device__ __forceinline__ float siluf(float v) { return v / (1.f + __expf(-v)); }
__device__ __forceinline__ float wave_sum(float v) {
#pragma unroll
    for (int o = 1; o < 64; o <<= 1) v += __shfl_xor(v, o);
    return v;
}

struct Params {
    const float *x, *c; const int* pos; const float *ada_w, *ada_b, *norm_g, *w_in, *pool_w, *pool_scale, *g_q_lat, *w_uq, *g_kv_lat, *w_ukv, *g_qnorm, *g_knorm, *w_out;
    float* out; unsigned char* ws; int ph_lo, ph_hi;
};

#define XB_TMO      128
#define XB_XCNT(j)  (256  + 64 * (j))
#define XB_XSUB(j)  (1280 + 64 * (j))
#define XB_XGEN(j)  (2304 + 64 * (j))
#define XB_TOP      3328
#define XB_TOPGEN   3392
#define XCD_BAR_WORDS 3456
#define XB_SPIN_CAP (1u << 22)
__device__ __forceinline__ unsigned xb_ld(unsigned* p)              { return __hip_atomic_load(p, __ATOMIC_RELAXED, __HIP_MEMORY_SCOPE_AGENT); }
__device__ __forceinline__ unsigned xb_add(unsigned* p, unsigned v) { return __hip_atomic_fetch_add(p, v, __ATOMIC_RELAXED, __HIP_MEMORY_SCOPE_AGENT); }
__device__ __forceinline__ unsigned xb_xcc_id() { return (unsigned)__builtin_amdgcn_s_getreg((3 << 11) | 20) & 0xFu; }
#define XB_SPIN(cond, bar) do { unsigned _sp = 0; while (cond) { __builtin_amdgcn_s_sleep(1); \
    if ((++_sp & 255u) == 0u) { if (xb_ld(&(bar)[XB_TMO])) break; if (_sp > XB_SPIN_CAP) { atomicAdd(&(bar)[XB_TMO], 1u); break; } } } } while (0)
struct XcdBarrier { unsigned* bar; unsigned x; volatile LAS unsigned* st; };
__device__ __forceinline__ XcdBarrier xcd_barrier_post(unsigned* bar, volatile LAS unsigned* st) {
    XcdBarrier b; b.bar = bar; b.x = xb_xcc_id(); b.st = st;
    if (threadIdx.x == 0) (void)xb_add(&bar[XB_XCNT(b.x)], 1u);
    return b;
}
__device__ __forceinline__ void xcd_barrier_complete(unsigned* bar, unsigned x, unsigned& nloc, unsigned& nx) {
    const unsigned G = gridDim.x * gridDim.y * gridDim.z;
    unsigned sum, cnt, mine, sp = 0u;
    for (;;) {
        sum = 0u; cnt = 0u; mine = 0u;
#pragma unroll
        for (unsigned j = 0; j < 16; ++j) { const unsigned c = xb_ld(&bar[XB_XCNT(j)]); sum += c; cnt += (c > 0u) ? 1u : 0u; mine = (j == x) ? c : mine; }
        if (sum == G) break;
        __builtin_amdgcn_s_sleep(1);
        if ((++sp & 255u) == 0u) { if (xb_ld(&bar[XB_TMO])) break; if (sp > XB_SPIN_CAP) { atomicAdd(&bar[XB_TMO], 1u); break; } }
    }
    nloc = mine > 0u ? mine : 1u; nx = cnt > 0u ? cnt : 1u;
}
__device__ __forceinline__ void xcd_barrier(const XcdBarrier& b) {
    asm volatile("s_waitcnt vmcnt(0)" ::: "memory");
    __syncthreads();
    if (threadIdx.x == 0) {
        unsigned* bar = b.bar;
        __builtin_amdgcn_s_waitcnt(0);
        unsigned nloc = b.st[0], nx = b.st[1];
        if (nloc == 0u) { xcd_barrier_complete(bar, b.x, nloc, nx); b.st[0] = nloc; b.st[1] = nx; }
        const unsigned old = xb_add(&bar[XB_XSUB(b.x)], 1u);
        const unsigned gen = old / nloc;
        if (old + 1u == (gen + 1u) * nloc) {
            __builtin_amdgcn_fence(__ATOMIC_RELEASE, "agent");
            asm volatile("s_waitcnt vmcnt(0)" ::: "memory");
            const unsigned og = xb_add(&bar[XB_TOP], 1u);
            const unsigned tg = og / nx;
            if (og + 1u == (tg + 1u) * nx) xb_add(&bar[XB_TOPGEN], 1u);
            else XB_SPIN(xb_ld(&bar[XB_TOPGEN]) == tg, bar);
            __builtin_amdgcn_fence(__ATOMIC_ACQUIRE, "agent");
            xb_add(&bar[XB_XGEN(b.x)], 1u);
            asm volatile("s_waitcnt vmcnt(0)" ::: "memory");
        } else {
            XB_SPIN(xb_ld(&bar[XB_XGEN(b.x)]) == gen, bar);
            __builtin_amdgcn_fence(__ATOMIC_ACQUIRE, "agent");
            asm volatile("s_waitcnt vmcnt(0)" ::: "memory");
        }
    }
    __syncthreads();
}

struct Frame {
    LAS unsigned char* lds;
    int tid, lane, wave, vb, G;
    float* modp; float* rope;
    bf16_t *XN, *UP, *GP, *GA, *QL, *KVL, *Q, *K, *V, *Y;
};
__device__ __forceinline__ float mod_val(const Params& P, const Frame& F, int b, int e) {
    float s = P.ada_b[e];
#pragma unroll
    for (int kq = 0; kq < 4; ++kq) s += F.modp[((size_t)kq * 16 + b) * 3072 + e];
    return s;
}

__device__ __forceinline__ void ph0_mod(const Params& P, Frame& F) {
    LAS float* cact = (LAS float*)F.lds;
    LAS float* red = (LAS float*)(F.lds + 65536);
    bool have = false;
    for (int item = F.vb; item < 192; item += F.G) {
        if (!have) { for (int i = F.tid; i < 16384; i += NTHREADS) cact[i] = siluf(P.c[i]); __syncthreads(); have = true; }
        const int cg = item % 48, kq = item / 48;
        const int col = cg * 64 + F.lane, r0 = kq * 256 + F.wave * 32;
        float acc[16];
#pragma unroll
        for (int b = 0; b < 16; ++b) acc[b] = 0.f;
#pragma unroll 4
        for (int r = 0; r < 32; ++r) {
            const float w = P.ada_w[(size_t)(r0 + r) * 3072 + col];
#pragma unroll
            for (int b = 0; b < 16; ++b) acc[b] += cact[b * 1024 + r0 + r] * w;
        }
#pragma unroll
        for (int b = 0; b < 16; ++b) red[(F.wave * 16 + b) * 64 + F.lane] = acc[b];
        __syncthreads();
        for (int o = F.tid; o < 1024; o += NTHREADS) {
            const int b = o >> 6, cl = o & 63; float s = 0.f;
#pragma unroll
            for (int w = 0; w < 8; ++w) s += red[(w * 16 + b) * 64 + cl];
            F.modp[((size_t)kq * 16 + b) * 3072 + cg * 64 + cl] = s;
        }
        __syncthreads();
    }
}

__device__ __forceinline__ void ph1_xn(const Params& P, Frame& F) {
    LAS float* gs = (LAS float*)F.lds; LAS float* sh = gs + 1024;
    for (int item = F.vb; item < TOK / 128; item += F.G) {
        const int row0 = item * 128, b = row0 / SEQ;
        __syncthreads();
        for (int d = F.tid; d < 1024; d += NTHREADS) { const float sc = mod_val(P, F, b, 1024 + d), sf = mod_val(P, F, b, d); gs[d] = P.norm_g[d] * (1.f + sc); sh[d] = sf; }
        __syncthreads();
        for (int i = 0; i < 16; ++i) {
            const int t = row0 + F.wave * 16 + i;
            const float4* xr = (const float4*)(P.x + (size_t)t * 1024) + F.lane;
            float4 v[4]; float ss = 0.f;
#pragma unroll
            for (int j = 0; j < 4; ++j) { v[j] = xr[64 * j]; ss += (v[j].x * v[j].x + v[j].y * v[j].y) + (v[j].z * v[j].z + v[j].w * v[j].w); }
            ss = wave_sum(ss);
            const float r = rsqrtf(ss * (1.f / 1024.f) + EPS);
#pragma unroll
            for (int j = 0; j < 4; ++j) {
                const int d = 4 * F.lane + 256 * j;
                const float o0 = (v[j].x * r) * gs[d] + sh[d], o1 = (v[j].y * r) * gs[d + 1] + sh[d + 1], o2 = (v[j].z * r) * gs[d + 2] + sh[d + 2], o3 = (v[j].w * r) * gs[d + 3] + sh[d + 3];
                uint2 pk; pk.x = (unsigned)f2bf(o0) | ((unsigned)f2bf(o1) << 16); pk.y = (unsigned)f2bf(o2) | ((unsigned)f2bf(o3) << 16);
                *(uint2*)(F.XN + (size_t)t * 1024 + d) = pk;
            }
            if (F.lane < 16) {
                const float ang = (float)P.pos[t] * INVF[F.lane];
                float sn, cs; sincosf(ang, &sn, &cs);
                F.rope[(size_t)t * 32 + F.lane] = cs; F.rope[(size_t)t * 32 + 16 + F.lane] = sn;
            }
        }
    }
}

template <class AF, class BF, class EF>
__device__ __forceinline__ void naive_gemm(Frame& F, int M, int N, int K, AF a, BF bfn, EF epi) {
    LAS float* As = (LAS float*)F.lds;
    LAS float* Bs = As + 16 * 132;
    const int tx = F.tid & 31, ty = F.tid >> 5;
    const int ntm = M / 128, ntn = (N + 127) / 128;
    for (int tile = F.vb; tile < ntm * ntn; tile += F.G) {
        const int m0 = (tile / ntn) * 128, n0 = (tile % ntn) * 128;
        float acc[8][4];
#pragma unroll
        for (int i = 0; i < 8; ++i)
#pragma unroll
            for (int j = 0; j < 4; ++j) acc[i][j] = 0.f;
        for (int k0 = 0; k0 < K; k0 += 16) {
            __syncthreads();
#pragma unroll
            for (int i = 0; i < 4; ++i) { const int e = F.tid + i * NTHREADS; As[(e & 15) * 132 + (e >> 4)] = a(m0 + (e >> 4), k0 + (e & 15)); }
#pragma unroll
            for (int i = 0; i < 4; ++i) { const int e = F.tid + i * NTHREADS; Bs[(e >> 7) * 132 + (e & 127)] = bfn(k0 + (e >> 7), n0 + (e & 127)); }
            __syncthreads();
#pragma unroll
            for (int kk = 0; kk < 16; ++kk) {
                float av[8], bv[4];
#pragma unroll
                for (int i = 0; i < 8; ++i) av[i] = As[kk * 132 + ty * 8 + i];
#pragma unroll
                for (int j = 0; j < 4; ++j) bv[j] = Bs[kk * 132 + tx * 4 + j];
#pragma unroll
                for (int i = 0; i < 8; ++i)
#pragma unroll
                    for (int j = 0; j < 4; ++j) acc[i][j] += av[i] * bv[j];
            }
        }
#pragma unroll
        for (int i = 0; i < 8; ++i)
#pragma unroll
            for (int j = 0; j < 4; ++j) epi(m0 + ty * 8 + i, n0 + tx * 4 + j, acc[i][j]);
    }
    __syncthreads();
}

__device__ __forceinline__ void ph2_inproj(const Params& P, Frame& F) {
    const bf16_t* XN = F.XN; const float* W = P.w_in;
    bf16_t *UP = F.UP, *GP = F.GP, *GA = F.GA, *QL = F.QL, *KVL = F.KVL;
    naive_gemm(F, TOK, INW, DM,
        [=](int m, int k) { return bf2f(XN[(size_t)m * 1024 + k]); },
        [=](int k, int n) { return n < INW ? W[(size_t)k * INW + n] : 0.f; },
        [=](int m, int n, float v) {
            const bf16_t h = f2bf(v);
            if (n < OFF_GP) UP[(size_t)m * 512 + n] = h;
            else if (n < OFF_QL) GP[(size_t)m * 512 + (n - OFF_GP)] = h;
            else if (n < OFF_KVL) QL[(size_t)m * 256 + (n - OFF_QL)] = h;
            else if (n < OFF_GA) KVL[(size_t)m * 160 + (n - OFF_KVL)] = h;
            else if (n < INW) GA[(size_t)m * 512 + (n - OFF_GA)] = h;
        });
}

__device__ __forceinline__ void ph3_upproj(const Params& P, Frame& F) {
    const int gw = F.vb * NWAVES + F.wave, NGW = F.G * NWAVES;
    for (int wi = gw; wi < (TOK / 64) * NH; wi += NGW) {
        const int h = wi % NH, t = (wi / NH) * 64 + F.lane, b = t / SEQ, s = t % SEQ;
        float acc[DQK];
#pragma unroll
        for (int d = 0; d < DQK; ++d) acc[d] = 0.f;
        float ssq = 0.f;
        for (int r = 0; r < QLORA; ++r) {
            float a = bf2f(F.QL[(size_t)t * 256 + r]); ssq += a * a; a *= P.g_q_lat[r];
            const float* w = P.w_uq + (size_t)r * (NH * DQK) + h * DQK;
#pragma unroll
            for (int d = 0; d < DQK; ++d) acc[d] += a * w[d];
        }
        const float rq = rsqrtf(ssq * (1.f / QLORA) + EPS);
        float s2 = 0.f;
#pragma unroll
        for (int d = 0; d < DQK; ++d) { acc[d] *= rq; s2 += acc[d] * acc[d]; }
        const float rh = rsqrtf(s2 * (1.f / DQK) + EPS);
#pragma unroll
        for (int d = 0; d < DQK; ++d) acc[d] = acc[d] * rh * P.g_qnorm[d];
#pragma unroll
        for (int i = 0; i < 16; ++i) {
            const float cs = F.rope[(size_t)t * 32 + i], sn = F.rope[(size_t)t * 32 + 16 + i];
            const float x1 = acc[64 + i], x2 = acc[80 + i];
            acc[64 + i] = x1 * cs - x2 * sn; acc[80 + i] = x2 * cs + x1 * sn;
        }
        bf16_t* qo = F.Q + ((size_t)(b * NH + h) * SEQ + s) * DQK;
#pragma unroll
        for (int d = 0; d < DQK; d += 2) *(unsigned*)(qo + d) = (unsigned)f2bf(acc[d]) | ((unsigned)f2bf(acc[d + 1]) << 16);
    }
    for (int wi = gw; wi < (TOK / 64) * NH; wi += NGW) {
        const int h = wi % NH, t = (wi / NH) * 64 + F.lane, b = t / SEQ, s = t % SEQ;
        float acc[64];
#pragma unroll
        for (int d = 0; d < 64; ++d) acc[d] = 0.f;
        float ssq = 0.f;
        for (int r = 0; r < KVLORA; ++r) {
            float a = bf2f(F.KVL[(size_t)t * 160 + r]); ssq += a * a; a *= P.g_kv_lat[r];
            const float* w = P.w_ukv + (size_t)r * (NH * 128) + h * 128;
#pragma unroll
            for (int d = 0; d < 64; ++d) acc[d] += a * w[d];
        }
        const float rkv = rsqrtf(ssq * (1.f / KVLORA) + EPS);
        float s2 = 0.f;
#pragma unroll
        for (int d = 0; d < 64; ++d) { acc[d] *= rkv; s2 += acc[d] * acc[d]; }
        float kr[32];
#pragma unroll
        for (int i = 0; i < 32; ++i) { kr[i] = bf2f(F.KVL[(size_t)t * 160 + 128 + i]); s2 += kr[i] * kr[i]; }
        const float rh = rsqrtf(s2 * (1.f / DQK) + EPS);
#pragma unroll
        for (int d = 0; d < 64; ++d) acc[d] = acc[d] * rh * P.g_knorm[d];
#pragma unroll
        for (int i = 0; i < 32; ++i) kr[i] = kr[i] * rh * P.g_knorm[64 + i];
#pragma unroll
        for (int i = 0; i < 16; ++i) {
            const float cs = F.rope[(size_t)t * 32 + i], sn = F.rope[(size_t)t * 32 + 16 + i];
            const float x1 = kr[i], x2 = kr[16 + i];
            kr[i] = x1 * cs - x2 * sn; kr[16 + i] = x2 * cs + x1 * sn;
        }
        bf16_t* ko = F.K + ((size_t)(b * NH + h) * SEQ + s) * DQK;
#pragma unroll
        for (int d = 0; d < 64; d += 2) *(unsigned*)(ko + d) = (unsigned)f2bf(acc[d]) | ((unsigned)f2bf(acc[d + 1]) << 16);
#pragma unroll
        for (int i = 0; i < 32; i += 2) *(unsigned*)(ko + 64 + i) = (unsigned)f2bf(kr[i]) | ((unsigned)f2bf(kr[i + 1]) << 16);
    }
    for (int wi = gw; wi < (TOK / 64) * NH; wi += NGW) {
        const int h = wi % NH, t = (wi / NH) * 64 + F.lane, b = t / SEQ, s = t % SEQ;
        float acc[64];
#pragma unroll
        for (int d = 0; d < 64; ++d) acc[d] = 0.f;
        float ssq = 0.f;
        for (int r = 0; r < KVLORA; ++r) {
            float a = bf2f(F.KVL[(size_t)t * 160 + r]); ssq += a * a; a *= P.g_kv_lat[r];
            const float* w = P.w_ukv + (size_t)r * (NH * 128) + h * 128 + 64;
#pragma unroll
            for (int d = 0; d < 64; ++d) acc[d] += a * w[d];
        }
        const float rkv = rsqrtf(ssq * (1.f / KVLORA) + EPS);
        bf16_t* vo = F.V + ((size_t)(b * NH + h) * SEQ + s) * DV;
#pragma unroll
        for (int d = 0; d < 64; d += 2) *(unsigned*)(vo + d) = (unsigned)f2bf(acc[d] * rkv) | ((unsigned)f2bf(acc[d + 1] * rkv) << 16);
    }
}

__device__ __forceinline__ void ph3_pool(const Params& P, Frame& F) {
    LAS float* df = (LAS float*)F.lds;
    for (int item = F.vb; item < (TOK / 32) * 4; item += F.G) {
        const int tt = item >> 2, gi = item & 3, t0 = tt * 32, b = t0 / SEQ, s0 = t0 % SEQ, half = 1 << gi;
        __syncthreads();
        for (int e = F.tid; e < 4096; e += NTHREADS) {
            const int tl = e >> 7, c = e & 127, s = s0 + tl;
            const int lo = (s - half) > 0 ? (s - half) : 0, hi = (s + half) < SEQ ? (s + half) : SEQ;
            float sum = 0.f;
            for (int sp = lo; sp < hi; ++sp) sum += bf2f(F.UP[((size_t)b * SEQ + sp) * 512 + gi * 128 + c]);
            df[e] = sum / (float)(hi - lo) - bf2f(F.UP[((size_t)b * SEQ + s) * 512 + gi * 128 + c]);
        }
        __syncthreads();
        for (int o = F.tid; o < 4096; o += NTHREADS) {
            const int tl = o >> 7, d = o & 127;
            float acc = 0.f;
            for (int c = 0; c < 128; ++c) acc += df[tl * 128 + c] * P.pool_w[((size_t)gi * 128 + c) * 128 + d];
            const int n = gi * 128 + d, t = t0 + tl;
            const float g = bf2f(F.GP[(size_t)t * 512 + n]);
            F.Y[(size_t)t * 1024 + n] = f2bf(acc * P.pool_scale[n] * siluf(g));
        }
    }
    __syncthreads();
}

__device__ __forceinline__ void ph4_attn(const Params& P, Frame& F) {
    LAS float* Ks = (LAS float*)F.lds;
    LAS float* Vs = Ks + 64 * 96;
    const float scale = 0.10206207261596577f;
    const int hf = F.tid & 1, row = F.tid >> 1;
    for (int item = F.vb; item < NB * NH * 8; item += F.G) {
        const int bh = item >> 3, qb = item & 7, s = qb * 256 + row, b = bh / NH, h = bh % NH;
        float q[48];
        { const bf16_t* qp = F.Q + ((size_t)bh * SEQ + s) * DQK + hf * 48;
#pragma unroll
          for (int d = 0; d < 48; ++d) q[d] = bf2f(qp[d]) * scale; }
        float o[32];
#pragma unroll
        for (int d = 0; d < 32; ++d) o[d] = 0.f;
        float m = -1e30f, l = 0.f;
        for (int kt = 0; kt < SEQ / 64; ++kt) {
            __syncthreads();
            { const bf16_t* kp = F.K + ((size_t)bh * SEQ + kt * 64) * DQK;
              for (int e = F.tid; e < 64 * DQK; e += NTHREADS) Ks[e] = bf2f(kp[e]);
              const bf16_t* vp = F.V + ((size_t)bh * SEQ + kt * 64) * DV;
              for (int e = F.tid; e < 64 * DV; e += NTHREADS) Vs[e] = bf2f(vp[e]); }
            __syncthreads();
#pragma unroll 1
            for (int kc = 0; kc < 8; ++kc) {
                float sc[8]; float mx = -1e30f;
#pragma unroll
                for (int j = 0; j < 8; ++j) {
                    float dot = 0.f;
#pragma unroll
                    for (int d = 0; d < 48; ++d) dot += q[d] * Ks[(kc * 8 + j) * DQK + hf * 48 + d];
                    dot += __shfl_xor(dot, 1);
                    sc[j] = dot; mx = fmaxf(mx, dot);
                }
                const float mn = fmaxf(m, mx), alpha = __expf(m - mn);
                l *= alpha;
#pragma unroll
                for (int d = 0; d < 32; ++d) o[d] *= alpha;
                m = mn;
#pragma unroll
                for (int j = 0; j < 8; ++j) {
                    const float p = __expf(sc[j] - m); l += p;
#pragma unroll
                    for (int d = 0; d < 32; ++d) o[d] += p * Vs[(kc * 8 + j) * DV + hf * 32 + d];
                }
            }
        }
        const float rl = 1.f / l; const size_t t = (size_t)b * SEQ + s;
#pragma unroll
        for (int d = 0; d < 32; d += 2) {
            const int col = h * 64 + hf * 32 + d;
            const float g0 = bf2f(F.GA[t * 512 + col]), g1 = bf2f(F.GA[t * 512 + col + 1]);
            *(unsigned*)(F.Y + t * 1024 + 512 + col) = (unsigned)f2bf(o[d] * rl * siluf(g0)) | ((unsigned)f2bf(o[d + 1] * rl * siluf(g1)) << 16);
        }
    }
    __syncthreads();
}

__device__ __forceinline__ void ph5_outproj(const Params& P, Frame& F) {
    const bf16_t* Y = F.Y; const float* W = P.w_out; const float* x = P.x; float* out = P.out;
    const float* ada_b = P.ada_b; const float* modp = F.modp;
    naive_gemm(F, TOK, DM, DM,
        [=](int m, int k) { return bf2f(Y[(size_t)m * 1024 + k]); },
        [=](int k, int n) { return W[(size_t)k * 1024 + n]; },
        [=](int m, int n, float v) {
            const int b = m / SEQ; float g = ada_b[2048 + n];
#pragma unroll
            for (int kq = 0; kq < 4; ++kq) g += modp[((size_t)kq * 16 + b) * 3072 + 2048 + n];
            out[(size_t)m * 1024 + n] = x[(size_t)m * 1024 + n] + g * v;
        });
}

__global__ void __launch_bounds__(NTHREADS, 2) fwd_kernel(Params P) {
    extern __shared__ __attribute__((aligned(16))) unsigned char lds[];
    Frame F;
    F.lds = (LAS unsigned char*)lds;
    F.tid = threadIdx.x; F.lane = F.tid & 63; F.wave = __builtin_amdgcn_readfirstlane(F.tid >> 6);
    F.G = gridDim.x; { const int bx = blockIdx.x; F.vb = (F.G % 8 == 0) ? (bx % 8) * (F.G / 8) + bx / 8 : bx; }
    unsigned char* ws = P.ws;
    F.modp = (float*)(ws + WS_MODP); F.rope = (float*)(ws + WS_ROPE);
    F.XN = (bf16_t*)(ws + WS_XN); F.UP = (bf16_t*)(ws + WS_UP); F.GP = (bf16_t*)(ws + WS_GP); F.GA = (bf16_t*)(ws + WS_GA);
    F.QL = (bf16_t*)(ws + WS_QL); F.KVL = (bf16_t*)(ws + WS_KVL); F.Q = (bf16_t*)(ws + WS_Q); F.K = (bf16_t*)(ws + WS_K); F.V = (bf16_t*)(ws + WS_V); F.Y = (bf16_t*)(ws + WS_Y);
    volatile LAS unsigned* MISC = (volatile LAS unsigned*)(F.lds + MISC_OFF);
    for (int u = F.tid; u < (LDS_BYTES - LDSCTL_OFF) / 4; u += NTHREADS) ((LAS unsigned*)(F.lds + LDSCTL_OFF))[u] = 0u;
    __syncthreads();
    const int lo = P.ph_lo, hi = P.ph_hi;
    XcdBarrier bar; bar.bar = (unsigned*)(ws + WS_CTL) + CW_BAR; bar.x = 0; bar.st = nullptr;
    if (hi - lo > 1) bar = xcd_barrier_post((unsigned*)(ws + WS_CTL) + CW_BAR, MISC + 8);
#define IN(k) (lo <= (k) && (k) < hi)
#define SEAM(k) do { if (IN(k) && IN((k) + 1)) xcd_barrier(bar); } while (0)
    if (IN(0)) { ph0_mod(P, F); } SEAM(0);
    if (IN(1)) { ph1_xn(P, F); } SEAM(1);
    if (IN(2)) { ph2_inproj(P, F); } SEAM(2);
    if (IN(3)) { ph3_upproj(P, F); ph3_pool(P, F); } SEAM(3);
    if (IN(4)) { ph4_attn(P, F); } SEAM(4);
    if (IN(5)) { ph5_outproj(P, F); }
#undef IN
#undef SEAM
}

extern "C" void kernel_launch(void* const* d_in, const int* in_sizes, int n_in, void* d_out, int out_size, void* d_ws, size_t ws_size, hipStream_t stream) {
    static int grid = 0;
    if (grid == 0) {
        if (n_in != 16 || in_sizes[0] != TOK * DM || out_size != TOK * DM || ws_size < WS_END) {
            fprintf(stderr, "kernel_launch: shape mismatch: n_in %d in0 %d out %d ws %zu\n", n_in, n_in > 0 ? in_sizes[0] : -1, out_size, ws_size); grid = -1; return; }
        int dev = 0, cus = 0, per_cu = 0;
        if (hipGetDevice(&dev) != hipSuccess || hipDeviceGetAttribute(&cus, hipDeviceAttributeMultiprocessorCount, dev) != hipSuccess) { grid = -1; return; }
        if (hipFuncSetAttribute((const void*)fwd_kernel, hipFuncAttributeMaxDynamicSharedMemorySize, LDS_BYTES) != hipSuccess) { fprintf(stderr, "kernel_launch: hipFuncSetAttribute failed\n"); grid = -1; return; }
        if (hipOccupancyMaxActiveBlocksPerMultiprocessor(&per_cu, (const void*)fwd_kernel, NTHREADS, LDS_BYTES) != hipSuccess || per_cu < 1) {
            fprintf(stderr, "kernel_launch: occupancy query reports %d blocks per CU\n", per_cu); (void)hipGetLastError(); grid = -1; return; }
        grid = cus;
    }
    if (grid < 0) return;
    (void)hipMemsetAsync((char*)d_ws + WS_CTL, 0, CTL_ZERO_BYTES, stream);
    Params p{};
    p.x = (const float*)d_in[0]; p.c = (const float*)d_in[1]; p.pos = (const int*)d_in[2]; p.ada_w = (const float*)d_in[3]; p.ada_b = (const float*)d_in[4];
    p.norm_g = (const float*)d_in[5]; p.w_in = (const float*)d_in[6]; p.pool_w = (const float*)d_in[7]; p.pool_scale = (const float*)d_in[8];
    p.g_q_lat = (const float*)d_in[9]; p.w_uq = (const float*)d_in[10]; p.g_kv_lat = (const float*)d_in[11]; p.w_ukv = (const float*)d_in[12];
    p.g_qnorm = (const float*)d_in[13]; p.g_knorm = (const float*)d_in[14]; p.w_out = (const float*)d_in[15];
    p.out = (float*)d_out; p.ws = (unsigned char*)d_ws;
    if (MK_N_LAUNCHES == 1) {
        p.ph_lo = 0; p.ph_hi = N_PHASES;
        hipLaunchKernelGGL(fwd_kernel, dim3(grid), dim3(NTHREADS), LDS_BYTES, stream, p);
    } else {
        for (int k = 0; k < N_PHASES; ++k) { p.ph_lo = k; p.ph_hi = k + 1; hipLaunchKernelGGL(fwd_kernel, dim3(grid), dim3(NTHREADS), LDS_BYTES, stream, p); }
    }
    const hipError_t le = hipPeekAtLastError();
    if (le != hipSuccess) fprintf(stderr, "kernel_launch: launch failed: %s\n", hipGetErrorName(le));
}
```

```cpp
#include <hip/hip_runtime.h>
#include <cstdio>
#include <cstdint>

#ifndef MK_N_LAUNCHES
#define MK_N_LAUNCHES 1
#endif

#define GAS __attribute__((address_space(1)))
#define LAS __attribute__((address_space(3)))
typedef unsigned short bf16_t;

constexpr int DM = 1024, NB = 16, SEQ = 2048, TOK = NB * SEQ;
constexpr int NH = 8, DQK = 96, DNOPE = 64, DROPE = 32, DV = 64, QLORA = 256, KVLORA = 128, INW = 1952;
constexpr int OFF_UP = 0, OFF_GP = 512, OFF_QL = 1024, OFF_KVL = 1280, OFF_KR = 1408, OFF_GA = 1440;
constexpr float EPS = 1e-6f;
constexpr int NTHREADS = 512, NWAVES = 8;
constexpr int N_PHASES = 6;

constexpr size_t MiB = 1u << 20;
constexpr size_t WS_CTL = 0, CTL_ZERO_BYTES = 1 * MiB;
constexpr size_t WS_MODP = 1 * MiB;
constexpr size_t WS_ROPE = 2 * MiB;
constexpr size_t WS_XN = 16 * MiB;
constexpr size_t WS_UP = 80 * MiB;
constexpr size_t WS_GP = 112 * MiB;
constexpr size_t WS_GA = 144 * MiB;
constexpr size_t WS_QL = 176 * MiB;
constexpr size_t WS_KVL = 192 * MiB;
constexpr size_t WS_Q = 208 * MiB;
constexpr size_t WS_K = 256 * MiB;
constexpr size_t WS_V = 304 * MiB;
constexpr size_t WS_Y = 336 * MiB;
constexpr size_t WS_END = 400 * MiB;
constexpr int CW_BAR = 4096;

constexpr int RING_BYTES = 131072;
constexpr int LDSCTL_OFF = RING_BYTES, MISC_OFF = LDSCTL_OFF + 320;
constexpr int LDS_BYTES = 147456;

__device__ const float INVF[16] = {1.0f, 0.5623413251903491f, 0.31622776601683794f, 0.1778279410038923f, 0.1f, 0.05623413251903491f, 0.03162277660168379f,
                                   0.01778279410038923f, 0.01f, 0.005623413251903491f, 0.003162277660168379f, 0.001778279410038923f, 0.001f,
                                   0.0005623413251903491f, 0.00031622776601683794f, 0.0001778279410038923f};

__device__ __forceinline__ float bf2f(bf16_t v) { return __uint_as_float(((unsigned)v) << 16); }
__device__ __forceinline__ bf16_t f2bf(float f) { unsigned u = __float_as_uint(f); return (bf16_t)((u + 0x7fffu + ((u >> 16) & 1u)) >> 16); }
__device__ __forceinline__ float siluf(float v) { return v / (1.f + __expf(-v)); }
__device__ __forceinline__ float wave_sum(float v) {
#pragma unroll
    for (int o = 1; o < 64; o <<= 1) v += __shfl_xor(v, o);
    return v;
}

struct Params {
    const float *x, *c; const int* pos; const float *ada_w, *ada_b, *norm_g, *w_in, *pool_w, *pool_scale, *g_q_lat, *w_uq, *g_kv_lat, *w_ukv, *g_qnorm, *g_knorm, *w_out;
    float* out; unsigned char* ws; int ph_lo, ph_hi;
};

#define XB_TMO      128
#define XB_XCNT(j)  (256  + 64 * (j))
#define XB_XSUB(j)  (1280 + 64 * (j))
#define XB_XGEN(j)  (2304 + 64 * (j))
#define XB_TOP      3328
#define XB_TOPGEN   3392
#define XCD_BAR_WORDS 3456
#define XB_SPIN_CAP (1u << 22)
__device__ __forceinline__ unsigned xb_ld(unsigned* p)              { return __hip_atomic_load(p, __ATOMIC_RELAXED, __HIP_MEMORY_SCOPE_AGENT); }
__device__ __forceinline__ unsigned xb_add(unsigned* p, unsigned v) { return __hip_atomic_fetch_add(p, v, __ATOMIC_RELAXED, __HIP_MEMORY_SCOPE_AGENT); }
__device__ __forceinline__ unsigned xb_xcc_id() { return (unsigned)__builtin_amdgcn_s_getreg((3 << 11) | 20) & 0xFu; }
#define XB_SPIN(cond, bar) do { unsigned _sp = 0; while (cond) { __builtin_amdgcn_s_sleep(1); \
    if ((++_sp & 255u) == 0u) { if (xb_ld(&(bar)[XB_TMO])) break; if (_sp > XB_SPIN_CAP) { atomicAdd(&(bar)[XB_TMO], 1u); break; } } } } while (0)
struct XcdBarrier { unsigned* bar; unsigned x; volatile LAS unsigned* st; };
__device__ __forceinline__ XcdBarrier xcd_barrier_post(unsigned* bar, volatile LAS unsigned* st) {
    XcdBarrier b; b.bar = bar; b.x = xb_xcc_id(); b.st = st;
    if (threadIdx.x == 0) (void)xb_add(&bar[XB_XCNT(b.x)], 1u);
    return b;
}
__device__ __forceinline__ void xcd_barrier_complete(unsigned* bar, unsigned x, unsigned& nloc, unsigned& nx) {
    const unsigned G = gridDim.x * gridDim.y * gridDim.z;
    unsigned sum, cnt, mine, sp = 0u;
    for (;;) {
        sum = 0u; cnt = 0u; mine = 0u;
#pragma unroll
        for (unsigned j = 0; j < 16; ++j) { const unsigned c = xb_ld(&bar[XB_XCNT(j)]); sum += c; cnt += (c > 0u) ? 1u : 0u; mine = (j == x) ? c : mine; }
        if (sum == G) break;
        __builtin_amdgcn_s_sleep(1);
        if ((++sp & 255u) == 0u) { if (xb_ld(&bar[XB_TMO])) break; if (sp > XB_SPIN_CAP) { atomicAdd(&bar[XB_TMO], 1u); break; } }
    }
    nloc = mine > 0u ? mine : 1u; nx = cnt > 0u ? cnt : 1u;
}
__device__ __forceinline__ void xcd_barrier(const XcdBarrier& b) {
    asm volatile("s_waitcnt vmcnt(0)" ::: "memory");
    __syncthreads();
    if (threadIdx.x == 0) {
        unsigned* bar = b.bar;
        __builtin_amdgcn_s_waitcnt(0);
        unsigned nloc = b.st[0], nx = b.st[1];
        if (nloc == 0u) { xcd_barrier_complete(bar, b.x, nloc, nx); b.st[0] = nloc; b.st[1] = nx; }
        const unsigned old = xb_add(&bar[XB_XSUB(b.x)], 1u);
        const unsigned gen = old / nloc;
        if (old + 1u == (gen + 1u) * nloc) {
            __builtin_amdgcn_fence(__ATOMIC_RELEASE, "agent");
            asm volatile("s_waitcnt vmcnt(0)" ::: "memory");
            const unsigned og = xb_add(&bar[XB_TOP], 1u);
            const unsigned tg = og / nx;
            if (og + 1u == (tg + 1u) * nx) xb_add(&bar[XB_TOPGEN], 1u);
            else XB_SPIN(xb_ld(&bar[XB_TOPGEN]) == tg, bar);
            __builtin_amdgcn_fence(__ATOMIC_ACQUIRE, "agent");
            xb_add(&bar[XB_XGEN(b.x)], 1u);
            asm volatile("s_waitcnt vmcnt(0)" ::: "memory");
        } else {
            XB_SPIN(xb_ld(&bar[XB_XGEN(b.x)]) == gen, bar);
            __builtin_amdgcn_fence(__ATOMIC_ACQUIRE, "agent");
            asm volatile("s_waitcnt vmcnt(0)" ::: "memory");
        }
    }
    __syncthreads();
}

struct Frame {
    LAS unsigned char* lds;
    int tid, lane, wave, vb, G;
    float* modp; float* rope;
    bf16_t *XN, *UP, *GP, *GA, *QL, *KVL, *Q, *K, *V, *Y;
};
__device__ __forceinline__ float mod_val(const Params& P, const Frame& F, int b, int e) {
    float s = P.ada_b[e];
#pragma unroll
    for (int kq = 0; kq < 4; ++kq) s += F.modp[((size_t)kq * 16 + b) * 3072 + e];
    return s;
}

__device__ __forceinline__ void ph0_mod(const Params& P, Frame& F) {
    LAS float* cact = (LAS float*)F.lds;
    LAS float* red = (LAS float*)(F.lds + 65536);
    bool have = false;
    for (int item = F.vb; item < 192; item += F.G) {
        if (!have) { for (int i = F.tid; i < 16384; i += NTHREADS) cact[i] = siluf(P.c[i]); __syncthreads(); have = true; }
        const int cg = item % 48, kq = item / 48;
        const int col = cg * 64 + F.lane, r0 = kq * 256 + F.wave * 32;
        float acc[16];
#pragma unroll
        for (int b = 0; b < 16; ++b) acc[b] = 0.f;
#pragma unroll 4
        for (int r = 0; r < 32; ++r) {
            const float w = P.ada_w[(size_t)(r0 + r) * 3072 + col];
#pragma unroll
            for (int b = 0; b < 16; ++b) acc[b] += cact[b * 1024 + r0 + r] * w;
        }
#pragma unroll
        for (int b = 0; b < 16; ++b) red[(F.wave * 16 + b) * 64 + F.lane] = acc[b];
        __syncthreads();
        for (int o = F.tid; o < 1024; o += NTHREADS) {
            const int b = o >> 6, cl = o & 63; float s = 0.f;
#pragma unroll
            for (int w = 0; w < 8; ++w) s += red[(w * 16 + b) * 64 + cl];
            F.modp[((size_t)kq * 16 + b) * 3072 + cg * 64 + cl] = s;
        }
        __syncthreads();
    }
}

__device__ __forceinline__ void ph1_xn(const Params& P, Frame& F) {
    LAS float* gs = (LAS float*)F.lds; LAS float* sh = gs + 1024;
    for (int item = F.vb; item < TOK / 128; item += F.G) {
        const int row0 = item * 128, b = row0 / SEQ;
        __syncthreads();
        for (int d = F.tid; d < 1024; d += NTHREADS) { const float sc = mod_val(P, F, b, 1024 + d), sf = mod_val(P, F, b, d); gs[d] = P.norm_g[d] * (1.f + sc); sh[d] = sf; }
        __syncthreads();
        for (int i = 0; i < 16; ++i) {
            const int t = row0 + F.wave * 16 + i;
            const float4* xr = (const float4*)(P.x + (size_t)t * 1024) + F.lane;
            float4 v[4]; float ss = 0.f;
#pragma unroll
            for (int j = 0; j < 4; ++j) { v[j] = xr[64 * j]; ss += (v[j].x * v[j].x + v[j].y * v[j].y) + (v[j].z * v[j].z + v[j].w * v[j].w); }
            ss = wave_sum(ss);
            const float r = rsqrtf(ss * (1.f / 1024.f) + EPS);
#pragma unroll
            for (int j = 0; j < 4; ++j) {
                const int d = 4 * F.lane + 256 * j;
                const float o0 = (v[j].x * r) * gs[d] + sh[d], o1 = (v[j].y * r) * gs[d + 1] + sh[d + 1], o2 = (v[j].z * r) * gs[d + 2] + sh[d + 2], o3 = (v[j].w * r) * gs[d + 3] + sh[d + 3];
                uint2 pk; pk.x = (unsigned)f2bf(o0) | ((unsigned)f2bf(o1) << 16); pk.y = (unsigned)f2bf(o2) | ((unsigned)f2bf(o3) << 16);
                *(uint2*)(F.XN + (size_t)t * 1024 + d) = pk;
            }
            if (F.lane < 16) {
                const float ang = (float)P.pos[t] * INVF[F.lane];
                float sn, cs; sincosf(ang, &sn, &cs);
                F.rope[(size_t)t * 32 + F.lane] = cs; F.rope[(size_t)t * 32 + 16 + F.lane] = sn;
            }
        }
    }
}

template <class AF, class BF, class EF>
__device__ __forceinline__ void naive_gemm(Frame& F, int M, int N, int K, AF a, BF bfn, EF epi) {
    LAS float* As = (LAS float*)F.lds;
    LAS float* Bs = As + 16 * 132;
    const int tx = F.tid & 31, ty = F.tid >> 5;
    const int ntm = M / 128, ntn = (N + 127) / 128;
    for (int tile = F.vb; tile < ntm * ntn; tile += F.G) {
        const int m0 = (tile / ntn) * 128, n0 = (tile % ntn) * 128;
        float acc[8][4];
#pragma unroll
        for (int i = 0; i < 8; ++i)
#pragma unroll
            for (int j = 0; j < 4; ++j) acc[i][j] = 0.f;
        for (int k0 = 0; k0 < K; k0 += 16) {
            __syncthreads();
#pragma unroll
            for (int i = 0; i < 4; ++i) { const int e = F.tid + i * NTHREADS; As[(e & 15) * 132 + (e >> 4)] = a(m0 + (e >> 4), k0 + (e & 15)); }
#pragma unroll
            for (int i = 0; i < 4; ++i) { const int e = F.tid + i * NTHREADS; Bs[(e >> 7) * 132 + (e & 127)] = bfn(k0 + (e >> 7), n0 + (e & 127)); }
            __syncthreads();
#pragma unroll
            for (int kk = 0; kk < 16; ++kk) {
                float av[8], bv[4];
#pragma unroll
                for (int i = 0; i < 8; ++i) av[i] = As[kk * 132 + ty * 8 + i];
#pragma unroll
                for (int j = 0; j < 4; ++j) bv[j] = Bs[kk * 132 + tx * 4 + j];
#pragma unroll
                for (int i = 0; i < 8; ++i)
#pragma unroll
                    for (int j = 0; j < 4; ++j) acc[i][j] += av[i] * bv[j];
            }
        }
#pragma unroll
        for (int i = 0; i < 8; ++i)
#pragma unroll
            for (int j = 0; j < 4; ++j) epi(m0 + ty * 8 + i, n0 + tx * 4 + j, acc[i][j]);
    }
    __syncthreads();
}

__device__ __forceinline__ void ph2_inproj(const Params& P, Frame& F) {
    const bf16_t* XN = F.XN; const float* W = P.w_in;
    bf16_t *UP = F.UP, *GP = F.GP, *GA = F.GA, *QL = F.QL, *KVL = F.KVL;
    naive_gemm(F, TOK, INW, DM,
        [=](int m, int k) { return bf2f(XN[(size_t)m * 1024 + k]); },
        [=](int k, int n) { return n < INW ? W[(size_t)k * INW + n] : 0.f; },
        [=](int m, int n, float v) {
            const bf16_t h = f2bf(v);
            if (n < OFF_GP) UP[(size_t)m * 512 + n] = h;
            else if (n < OFF_QL) GP[(size_t)m * 512 + (n - OFF_GP)] = h;
            else if (n < OFF_KVL) QL[(size_t)m * 256 + (n - OFF_QL)] = h;
            else if (n < OFF_GA) KVL[(size_t)m * 160 + (n - OFF_KVL)] = h;
            else if (n < INW) GA[(size_t)m * 512 + (n - OFF_GA)] = h;
        });
}

__device__ __forceinline__ void ph3_upproj(const Params& P, Frame& F) {
    const int gw = F.vb * NWAVES + F.wave, NGW = F.G * NWAVES;
    for (int wi = gw; wi < (TOK / 64) * NH; wi += NGW) {
        const int h = wi % NH, t = (wi / NH) * 64 + F.lane, b = t / SEQ, s = t % SEQ;
        float acc[DQK];
#pragma unroll
        for (int d = 0; d < DQK; ++d) acc[d] = 0.f;
        float ssq = 0.f;
        for (int r = 0; r < QLORA; ++r) {
            float a = bf2f(F.QL[(size_t)t * 256 + r]); ssq += a * a; a *= P.g_q_lat[r];
            const float* w = P.w_uq + (size_t)r * (NH * DQK) + h * DQK;
#pragma unroll
            for (int d = 0; d < DQK; ++d) acc[d] += a * w[d];
        }
        const float rq = rsqrtf(ssq * (1.f / QLORA) + EPS);
        float s2 = 0.f;
#pragma unroll
        for (int d = 0; d < DQK; ++d) { acc[d] *= rq; s2 += acc[d] * acc[d]; }
        const float rh = rsqrtf(s2 * (1.f / DQK) + EPS);
#pragma unroll
        for (int d = 0; d < DQK; ++d) acc[d] = acc[d] * rh * P.g_qnorm[d];
#pragma unroll
        for (int i = 0; i < 16; ++i) {
            const float cs = F.rope[(size_t)t * 32 + i], sn = F.rope[(size_t)t * 32 + 16 + i];
            const float x1 = acc[64 + i], x2 = acc[80 + i];
            acc[64 + i] = x1 * cs - x2 * sn; acc[80 + i] = x2 * cs + x1 * sn;
        }
        bf16_t* qo = F.Q + ((size_t)(b * NH + h) * SEQ + s) * DQK;
#pragma unroll
        for (int d = 0; d < DQK; d += 2) *(unsigned*)(qo + d) = (unsigned)f2bf(acc[d]) | ((unsigned)f2bf(acc[d + 1]) << 16);
    }
    for (int wi = gw; wi < (TOK / 64) * NH; wi += NGW) {
        const int h = wi % NH, t = (wi / NH) * 64 + F.lane, b = t / SEQ, s = t % SEQ;
        float acc[64];
#pragma unroll
        for (int d = 0; d < 64; ++d) acc[d] = 0.f;
        float ssq = 0.f;
        for (int r = 0; r < KVLORA; ++r) {
            float a = bf2f(F.KVL[(size_t)t * 160 + r]); ssq += a * a; a *= P.g_kv_lat[r];
            const float* w = P.w_ukv + (size_t)r * (NH * 128) + h * 128;
#pragma unroll
            for (int d = 0; d < 64; ++d) acc[d] += a * w[d];
        }
        const float rkv = rsqrtf(ssq * (1.f / KVLORA) + EPS);
        float s2 = 0.f;
#pragma unroll
        for (int d = 0; d < 64; ++d) { acc[d] *= rkv; s2 += acc[d] * acc[d]; }
        float kr[32];
#pragma unroll
        for (int i = 0; i < 32; ++i) { kr[i] = bf2f(F.KVL[(size_t)t * 160 + 128 + i]); s2 += kr[i] * kr[i]; }
        const float rh = rsqrtf(s2 * (1.f / DQK) + EPS);
#pragma unroll
        for (int d = 0; d < 64; ++d) acc[d] = acc[d] * rh * P.g_knorm[d];
#pragma unroll
        for (int i = 0; i < 32; ++i) kr[i] = kr[i] * rh * P.g_knorm[64 + i];
#pragma unroll
        for (int i = 0; i < 16; ++i) {
            const float cs = F.rope[(size_t)t * 32 + i], sn = F.rope[(size_t)t * 32 + 16 + i];
            const float x1 = kr[i], x2 = kr[16 + i];
            kr[i] = x1 * cs - x2 * sn; kr[16 + i] = x2 * cs + x1 * sn;
        }
        bf16_t* ko = F.K + ((size_t)(b * NH + h) * SEQ + s) * DQK;
#pragma unroll
        for (int d = 0; d < 64; d += 2) *(unsigned*)(ko + d) = (unsigned)f2bf(acc[d]) | ((unsigned)f2bf(acc[d + 1]) << 16);
#pragma unroll
        for (int i = 0; i < 32; i += 2) *(unsigned*)(ko + 64 + i) = (unsigned)f2bf(kr[i]) | ((unsigned)f2bf(kr[i + 1]) << 16);
    }
    for (int wi = gw; wi < (TOK / 64) * NH; wi += NGW) {
        const int h = wi % NH, t = (wi / NH) * 64 + F.lane, b = t / SEQ, s = t % SEQ;
        float acc[64];
#pragma unroll
        for (int d = 0; d < 64; ++d) acc[d] = 0.f;
        float ssq = 0.f;
        for (int r = 0; r < KVLORA; ++r) {
            float a = bf2f(F.KVL[(size_t)t * 160 + r]); ssq += a * a; a *= P.g_kv_lat[r];
            const float* w = P.w_ukv + (size_t)r * (NH * 128) + h * 128 + 64;
#pragma unroll
            for (int d = 0; d < 64; ++d) acc[d] += a * w[d];
        }
        const float rkv = rsqrtf(ssq * (1.f / KVLORA) + EPS);
        bf16_t* vo = F.V + ((size_t)(b * NH + h) * SEQ + s) * DV;
#pragma unroll
        for (int d = 0; d < 64; d += 2) *(unsigned*)(vo + d) = (unsigned)f2bf(acc[d] * rkv) | ((unsigned)f2bf(acc[d + 1] * rkv) << 16);
    }
}

__device__ __forceinline__ void ph3_pool(const Params& P, Frame& F) {
    LAS float* df = (LAS float*)F.lds;
    for (int item = F.vb; item < (TOK / 32) * 4; item += F.G) {
        const int tt = item >> 2, gi = item & 3, t0 = tt * 32, b = t0 / SEQ, s0 = t0 % SEQ, half = 1 << gi;
        __syncthreads();
        for (int e = F.tid; e < 4096; e += NTHREADS) {
            const int tl = e >> 7, c = e & 127, s = s0 + tl;
            const int lo = (s - half) > 0 ? (s - half) : 0, hi = (s + half) < SEQ ? (s + half) : SEQ;
            float sum = 0.f;
            for (int sp = lo; sp < hi; ++sp) sum += bf2f(F.UP[((size_t)b * SEQ + sp) * 512 + gi * 128 + c]);
            df[e] = sum / (float)(hi - lo) - bf2f(F.UP[((size_t)b * SEQ + s) * 512 + gi * 128 + c]);
        }
        __syncthreads();
        for (int o = F.tid; o < 4096; o += NTHREADS) {
            const int tl = o >> 7, d = o & 127;
            float acc = 0.f;
            for (int c = 0; c < 128; ++c) acc += df[tl * 128 + c] * P.pool_w[((size_t)gi * 128 + c) * 128 + d];
            const int n = gi * 128 + d, t = t0 + tl;
            const float g = bf2f(F.GP[(size_t)t * 512 + n]);
            F.Y[(size_t)t * 1024 + n] = f2bf(acc * P.pool_scale[n] * siluf(g));
        }
    }
    __syncthreads();
}

__device__ __forceinline__ void ph4_attn(const Params& P, Frame& F) {
    LAS float* Ks = (LAS float*)F.lds;
    LAS float* Vs = Ks + 64 * 96;
    const float scale = 0.10206207261596577f;
    const int hf = F.tid & 1, row = F.tid >> 1;
    for (int item = F.vb; item < NB * NH * 8; item += F.G) {
        const int bh = item >> 3, qb = item & 7, s = qb * 256 + row, b = bh / NH, h = bh % NH;
        float q[48];
        { const bf16_t* qp = F.Q + ((size_t)bh * SEQ + s) * DQK + hf * 48;
#pragma unroll
          for (int d = 0; d < 48; ++d) q[d] = bf2f(qp[d]) * scale; }
        float o[32];
#pragma unroll
        for (int d = 0; d < 32; ++d) o[d] = 0.f;
        float m = -1e30f, l = 0.f;
        for (int kt = 0; kt < SEQ / 64; ++kt) {
            __syncthreads();
            { const bf16_t* kp = F.K + ((size_t)bh * SEQ + kt * 64) * DQK;
              for (int e = F.tid; e < 64 * DQK; e += NTHREADS) Ks[e] = bf2f(kp[e]);
              const bf16_t* vp = F.V + ((size_t)bh * SEQ + kt * 64) * DV;
              for (int e = F.tid; e < 64 * DV; e += NTHREADS) Vs[e] = bf2f(vp[e]); }
            __syncthreads();
#pragma unroll 1
            for (int kc = 0; kc < 8; ++kc) {
                float sc[8]; float mx = -1e30f;
#pragma unroll
                for (int j = 0; j < 8; ++j) {
                    float dot = 0.f;
#pragma unroll
                    for (int d = 0; d < 48; ++d) dot += q[d] * Ks[(kc * 8 + j) * DQK + hf * 48 + d];
                    dot += __shfl_xor(dot, 1);
                    sc[j] = dot; mx = fmaxf(mx, dot);
                }
                const float mn = fmaxf(m, mx), alpha = __expf(m - mn);
                l *= alpha;
#pragma unroll
                for (int d = 0; d < 32; ++d) o[d] *= alpha;
                m = mn;
#pragma unroll
                for (int j = 0; j < 8; ++j) {
                    const float p = __expf(sc[j] - m); l += p;
#pragma unroll
                    for (int d = 0; d < 32; ++d) o[d] += p * Vs[(kc * 8 + j) * DV + hf * 32 + d];
                }
            }
        }
        const float rl = 1.f / l; const size_t t = (size_t)b * SEQ + s;
#pragma unroll
        for (int d = 0; d < 32; d += 2) {
            const int col = h * 64 + hf * 32 + d;
            const float g0 = bf2f(F.GA[t * 512 + col]), g1 = bf2f(F.GA[t * 512 + col + 1]);
            *(unsigned*)(F.Y + t * 1024 + 512 + col) = (unsigned)f2bf(o[d] * rl * siluf(g0)) | ((unsigned)f2bf(o[d + 1] * rl * siluf(g1)) << 16);
        }
    }
    __syncthreads();
}

__device__ __forceinline__ void ph5_outproj(const Params& P, Frame& F) {
    const bf16_t* Y = F.Y; const float* W = P.w_out; const float* x = P.x; float* out = P.out;
    const float* ada_b = P.ada_b; const float* modp = F.modp;
    naive_gemm(F, TOK, DM, DM,
        [=](int m, int k) { return bf2f(Y[(size_t)m * 1024 + k]); },
        [=](int k, int n) { return W[(size_t)k * 1024 + n]; },
        [=](int m, int n, float v) {
            const int b = m / SEQ; float g = ada_b[2048 + n];
#pragma unroll
            for (int kq = 0; kq < 4; ++kq) g += modp[((size_t)kq * 16 + b) * 3072 + 2048 + n];
            out[(size_t)m * 1024 + n] = x[(size_t)m * 1024 + n] + g * v;
        });
}

__global__ void __launch_bounds__(NTHREADS, 2) fwd_kernel(Params P) {
    extern __shared__ __attribute__((aligned(16))) unsigned char lds[];
    Frame F;
    F.lds = (LAS unsigned char*)lds;
    F.tid = threadIdx.x; F.lane = F.tid & 63; F.wave = __builtin_amdgcn_readfirstlane(F.tid >> 6);
    F.G = gridDim.x; { const int bx = blockIdx.x; F.vb = (F.G % 8 == 0) ? (bx % 8) * (F.G / 8) + bx / 8 : bx; }
    unsigned char* ws = P.ws;
    F.modp = (float*)(ws + WS_MODP); F.rope = (float*)(ws + WS_ROPE);
    F.XN = (bf16_t*)(ws + WS_XN); F.UP = (bf16_t*)(ws + WS_UP); F.GP = (bf16_t*)(ws + WS_GP); F.GA = (bf16_t*)(ws + WS_GA);
    F.QL = (bf16_t*)(ws + WS_QL); F.KVL = (bf16_t*)(ws + WS_KVL); F.Q = (bf16_t*)(ws + WS_Q); F.K = (bf16_t*)(ws + WS_K); F.V = (bf16_t*)(ws + WS_V); F.Y = (bf16_t*)(ws + WS_Y);
    volatile LAS unsigned* MISC = (volatile LAS unsigned*)(F.lds + MISC_OFF);
    for (int u = F.tid; u < (LDS_BYTES - LDSCTL_OFF) / 4; u += NTHREADS) ((LAS unsigned*)(F.lds + LDSCTL_OFF))[u] = 0u;
    __syncthreads();
    const int lo = P.ph_lo, hi = P.ph_hi;
    XcdBarrier bar; bar.bar = (unsigned*)(ws + WS_CTL) + CW_BAR; bar.x = 0; bar.st = nullptr;
    if (hi - lo > 1) bar = xcd_barrier_post((unsigned*)(ws + WS_CTL) + CW_BAR, MISC + 8);
#define IN(k) (lo <= (k) && (k) < hi)
#define SEAM(k) do { if (IN(k) && IN((k) + 1)) xcd_barrier(bar); } while (0)
    if (IN(0)) { ph0_mod(P, F); } SEAM(0);
    if (IN(1)) { ph1_xn(P, F); } SEAM(1);
    if (IN(2)) { ph2_inproj(P, F); } SEAM(2);
    if (IN(3)) { ph3_upproj(P, F); ph3_pool(P, F); } SEAM(3);
    if (IN(4)) { ph4_attn(P, F); } SEAM(4);
    if (IN(5)) { ph5_outproj(P, F); }
#undef IN
#undef SEAM
}

extern "C" void kernel_launch(void* const* d_in, const int* in_sizes, int n_in, void* d_out, int out_size, void* d_ws, size_t ws_size, hipStream_t stream) {
    static int grid = 0;
    if (grid == 0) {
        if (n_in != 16 || in_sizes[0] != TOK * DM || out_size != TOK * DM || ws_size < WS_END) {
            fprintf(stderr, "kernel_launch: shape mismatch: n_in %d in0 %d out %d ws %zu\n", n_in, n_in > 0 ? in_sizes[0] : -1, out_size, ws_size); grid = -1; return; }
        int dev = 0, cus = 0, per_cu = 0;
        if (hipGetDevice(&dev) != hipSuccess || hipDeviceGetAttribute(&cus, hipDeviceAttributeMultiprocessorCount, dev) != hipSuccess) { grid = -1; return; }
        if (hipFuncSetAttribute((const void*)fwd_kernel, hipFuncAttributeMaxDynamicSharedMemorySize, LDS_BYTES) != hipSuccess) { fprintf(stderr, "kernel_launch: hipFuncSetAttribute failed\n"); grid = -1; return; }
        if (hipOccupancyMaxActiveBlocksPerMultiprocessor(&per_cu, (const void*)fwd_kernel, NTHREADS, LDS_BYTES) != hipSuccess || per_cu < 1) {
            fprintf(stderr, "kernel_launch: occupancy query reports %d blocks per CU\n", per_cu); (void)hipGetLastError(); grid = -1; return; }
        grid = cus;
    }
    if (grid < 0) return;
    (void)hipMemsetAsync((char*)d_ws + WS_CTL, 0, CTL_ZERO_BYTES, stream);
    Params p{};
    p.x = (const float*)d_in[0]; p.c = (const float*)d_in[1]; p.pos = (const int*)d_in[2]; p.ada_w = (const float*)d_in[3]; p.ada_b = (const float*)d_in[4];
    p.norm_g = (const float*)d_in[5]; p.w_in = (const float*)d_in[6]; p.pool_w = (const float*)d_in[7]; p.pool_scale = (const float*)d_in[8];
    p.g_q_lat = (const float*)d_in[9]; p.w_uq = (const float*)d_in[10]; p.g_kv_lat = (const float*)d_in[11]; p.w_ukv = (const float*)d_in[12];
    p.g_qnorm = (const float*)d_in[13]; p.g_knorm = (const float*)d_in[14]; p.w_out = (const float*)d_in[15];
    p.out = (float*)d_out; p.ws = (unsigned char*)d_ws;
    if (MK_N_LAUNCHES == 1) {
        p.ph_lo = 0; p.ph_hi = N_PHASES;
        hipLaunchKernelGGL(fwd_kernel, dim3(grid), dim3(NTHREADS), LDS_BYTES, stream, p);
    } else {
        for (int k = 0; k < N_PHASES; ++k) { p.ph_lo = k; p.ph_hi = k + 1; hipLaunchKernelGGL(fwd_kernel, dim3(grid), dim3(NTHREADS), LDS_BYTES, stream, p); }
    }
    const hipError_t le = hipPeekAtLastError();
    if (le != hipSuccess) fprintf(stderr, "kernel_launch: launch failed: %s\n", hipGetErrorName(le));
}
```

```cpp
#include <hip/hip_runtime.h>
#include <cstdio>
#include <cstdint>

#ifndef MK_N_LAUNCHES
#define MK_N_LAUNCHES 1
#endif

#define GAS __attribute__((address_space(1)))
#define LAS __attribute__((address_space(3)))
typedef unsigned short bf16_t;

constexpr int DM = 1024, NB = 16, SEQ = 2048, TOK = NB * SEQ;
constexpr int NH = 8, DQK = 96, DNOPE = 64, DROPE = 32, DV = 64, QLORA = 256, KVLORA = 128, INW = 1952;
constexpr int OFF_UP = 0, OFF_GP = 512, OFF_QL = 1024, OFF_KVL = 1280, OFF_KR = 1408, OFF_GA = 1440;
constexpr float EPS = 1e-6f;
constexpr int NTHREADS = 512, NWAVES = 8;
constexpr int N_PHASES = 6;

constexpr size_t MiB = 1u << 20;
constexpr size_t WS_CTL = 0, CTL_ZERO_BYTES = 1 * MiB;
constexpr size_t WS_MODP = 1 * MiB;
constexpr size_t WS_ROPE = 2 * MiB;
constexpr size_t WS_GATE = 1 * MiB + 786432;
constexpr size_t WS_WIN = 6 * MiB;
constexpr size_t WS_WUQ = 10 * MiB;
constexpr size_t WS_WUKV = 11 * MiB;
constexpr size_t WS_WPOOL = 12 * MiB;
constexpr size_t WS_WOUT = 13 * MiB;
constexpr size_t WS_XN = 16 * MiB;
constexpr size_t WS_UP = 80 * MiB;
constexpr size_t WS_GP = 112 * MiB;
constexpr size_t WS_GA = 144 * MiB;
constexpr size_t WS_QL = 176 * MiB;
constexpr size_t WS_KVL = 192 * MiB;
constexpr size_t WS_Q = 208 * MiB;
constexpr size_t WS_K = 256 * MiB;
constexpr size_t WS_V = 304 * MiB;
constexpr size_t WS_Y = 336 * MiB;
constexpr size_t WS_END = 400 * MiB;
constexpr int CW_BAR = 4096;

constexpr int RING_BYTES = 131072;
constexpr int LDSCTL_OFF = RING_BYTES, MISC_OFF = LDSCTL_OFF + 320;
constexpr int LDS_BYTES = 147456;

__device__ const float INVF[16] = {1.0f, 0.5623413251903491f, 0.31622776601683794f, 0.1778279410038923f, 0.1f, 0.05623413251903491f, 0.03162277660168379f,
                                   0.01778279410038923f, 0.01f, 0.005623413251903491f, 0.003162277660168379f, 0.001778279410038923f, 0.001f,
                                   0.0005623413251903491f, 0.00031622776601683794f, 0.0001778279410038923f};

__device__ __forceinline__ float bf2f(bf16_t v) { return __uint_as_float(((unsigned)v) << 16); }
__device__ __forceinline__ bf16_t f2bf(float f) { unsigned u = __float_as_uint(f); return (bf16_t)((u + 0x7fffu + ((u >> 16) & 1u)) >> 16); }
__device__ __forceinline__ float siluf(float v) { return v / (1.f + __expf(-v)); }
__device__ __forceinline__ float wave_sum(float v) {
#pragma unroll
    for (int o = 1; o < 64; o <<= 1) v += __shfl_xor(v, o);
    return v;
}

struct Params {
    const float *x, *c; const int* pos; const float *ada_w, *ada_b, *norm_g, *w_in, *pool_w, *pool_scale, *g_q_lat, *w_uq, *g_kv_lat, *w_ukv, *g_qnorm, *g_knorm, *w_out;
    float* out; unsigned char* ws; int ph_lo, ph_hi;
};

#define XB_TMO      128
#define XB_XCNT(j)  (256  + 64 * (j))
#define XB_XSUB(j)  (1280 + 64 * (j))
#define XB_XGEN(j)  (2304 + 64 * (j))
#define XB_TOP      3328
#define XB_TOPGEN   3392
#define XCD_BAR_WORDS 3456
#define XB_SPIN_CAP (1u << 22)
__device__ __forceinline__ unsigned xb_ld(unsigned* p)              { return __hip_atomic_load(p, __ATOMIC_RELAXED, __HIP_MEMORY_SCOPE_AGENT); }
__device__ __forceinline__ unsigned xb_add(unsigned* p, unsigned v) { return __hip_atomic_fetch_add(p, v, __ATOMIC_RELAXED, __HIP_MEMORY_SCOPE_AGENT); }
__device__ __forceinline__ unsigned xb_xcc_id() { return (unsigned)__builtin_amdgcn_s_getreg((3 << 11) | 20) & 0xFu; }
#define XB_SPIN(cond, bar) do { unsigned _sp = 0; while (cond) { __builtin_amdgcn_s_sleep(1); \
    if ((++_sp & 255u) == 0u) { if (xb_ld(&(bar)[XB_TMO])) break; if (_sp > XB_SPIN_CAP) { atomicAdd(&(bar)[XB_TMO], 1u); break; } } } } while (0)
struct XcdBarrier { unsigned* bar; unsigned x; volatile LAS unsigned* st; };
__device__ __forceinline__ XcdBarrier xcd_barrier_post(unsigned* bar, volatile LAS unsigned* st) {
    XcdBarrier b; b.bar = bar; b.x = xb_xcc_id(); b.st = st;
    if (threadIdx.x == 0) (void)xb_add(&bar[XB_XCNT(b.x)], 1u);
    return b;
}
__device__ __forceinline__ void xcd_barrier_complete(unsigned* bar, unsigned x, unsigned& nloc, unsigned& nx) {
    const unsigned G = gridDim.x * gridDim.y * gridDim.z;
    unsigned sum, cnt, mine, sp = 0u;
    for (;;) {
        sum = 0u; cnt = 0u; mine = 0u;
#pragma unroll
        for (unsigned j = 0; j < 16; ++j) { const unsigned c = xb_ld(&bar[XB_XCNT(j)]); sum += c; cnt += (c > 0u) ? 1u : 0u; mine = (j == x) ? c : mine; }
        if (sum == G) break;
        __builtin_amdgcn_s_sleep(1);
        if ((++sp & 255u) == 0u) { if (xb_ld(&bar[XB_TMO])) break; if (sp > XB_SPIN_CAP) { atomicAdd(&bar[XB_TMO], 1u); break; } }
    }
    nloc = mine > 0u ? mine : 1u; nx = cnt > 0u ? cnt : 1u;
}
__device__ __forceinline__ void xcd_barrier(const XcdBarrier& b) {
    asm volatile("s_waitcnt vmcnt(0)" ::: "memory");
    __syncthreads();
    if (threadIdx.x == 0) {
        unsigned* bar = b.bar;
        __builtin_amdgcn_s_waitcnt(0);
        unsigned nloc = b.st[0], nx = b.st[1];
        if (nloc == 0u) { xcd_barrier_complete(bar, b.x, nloc, nx); b.st[0] = nloc; b.st[1] = nx; }
        const unsigned old = xb_add(&bar[XB_XSUB(b.x)], 1u);
        const unsigned gen = old / nloc;
        if (old + 1u == (gen + 1u) * nloc) {
            __builtin_amdgcn_fence(__ATOMIC_RELEASE, "agent");
            asm volatile("s_waitcnt vmcnt(0)" ::: "memory");
            const unsigned og = xb_add(&bar[XB_TOP], 1u);
            const unsigned tg = og / nx;
            if (og + 1u == (tg + 1u) * nx) xb_add(&bar[XB_TOPGEN], 1u);
            else XB_SPIN(xb_ld(&bar[XB_TOPGEN]) == tg, bar);
            __builtin_amdgcn_fence(__ATOMIC_ACQUIRE, "agent");
            xb_add(&bar[XB_XGEN(b.x)], 1u);
            asm volatile("s_waitcnt vmcnt(0)" ::: "memory");
        } else {
            XB_SPIN(xb_ld(&bar[XB_XGEN(b.x)]) == gen, bar);
            __builtin_amdgcn_fence(__ATOMIC_ACQUIRE, "agent");
            asm volatile("s_waitcnt vmcnt(0)" ::: "memory");
        }
    }
    __syncthreads();
}


namespace pg8 {
#define PG8_LAS __attribute__((address_space(3)))
typedef short bf16x8 __attribute__((ext_vector_type(8)));
typedef float f32x4 __attribute__((ext_vector_type(4)));
typedef unsigned u32x4 __attribute__((ext_vector_type(4)));
constexpr int BM = 256, BK = 64, HALF = 128, HTB = HALF * BK * 2, STAGE_BYTES = 8 * HTB, NXCD = 8, WGM = 8;
__host__ __device__ __forceinline__ int lds_byte(int r, int c) { const int st = (r >> 4) * 2 + (c >> 5), rr = r & 15, cc = c & 31, ob = rr * 64 + cc * 2; return st * 1024 + (ob ^ (((ob >> 9) & 1) << 5)); }
__host__ __device__ __forceinline__ void stage_rc(int b, int& R, int& C) { const int st = b / 1024, sb = b % 1024, swz = sb ^ (((sb >> 9) & 1) << 5); R = (st >> 1) * 16 + swz / 64; C = (st & 1) * 32 + (swz % 64) / 2; }
__host__ __device__ __forceinline__ int perm32(int rho) { const int n = rho >> 4, i = rho & 15; return 8 * (i >> 2) + 4 * n + (i & 3); }
struct Unit { int pm, pn; };
struct Gemm { const bf16_t* A; const bf16_t* Bt; int M, N, K; };
struct StaticOrder {
    int nM, nN, nwg, G, c;
    __host__ __device__ void init(int M, int N, int G_, int c_) { nM = M / BM; nN = N / BM; nwg = nM * nN; G = G_; c = c_; }
    __host__ __device__ bool next(int i, Unit& u) const {
        const long L = (long)i * G + c; if (L >= nwg) return false;
        int wgid = (int)L; { const int q = nwg / NXCD, r = nwg % NXCD, xcd = wgid % NXCD, off = wgid / NXCD; wgid = (xcd < r ? xcd * (q + 1) : r * (q + 1) + (xcd - r) * q) + off; }
        const int nig = WGM * nN, gid = wgid / nig, fm = gid * WGM, gsz = (nM - fm) < WGM ? (nM - fm) : WGM;
        u.pm = fm + ((wgid % nig) % gsz); u.pn = (wgid % nig) / gsz; return true;
    }
    __device__ __forceinline__ void a_ready(const Unit&) const {}
    __device__ __forceinline__ void done(const Unit&) const {}
};
__device__ __forceinline__ unsigned cvt_pk_bf16(float lo, float hi) { unsigned r; asm volatile("v_cvt_pk_bf16_f32 %0, %1, %2" : "=v"(r) : "v"(lo), "v"(hi)); return r; }

struct EpiInProj {
    static constexpr bool PERM = true, AFTER_DRAIN = false;
    bf16_t *UP, *GP, *GA, *QL, *KVL;
    __device__ __forceinline__ void operator()(const f32x4 (&acc)[2][2][4][2], const Unit& u, int wr, int wc, int fr, int fq) const {
        const int row0 = u.pm * BM + wr * 64 + fr;
        bf16_t* base; int ldc, ncols = 256;
        switch (u.pn) {
            case 0: base = UP; ldc = 512; break;       case 1: base = UP + 256; ldc = 512; break;
            case 2: base = GP; ldc = 512; break;       case 3: base = GP + 256; ldc = 512; break;
            case 4: base = GA; ldc = 512; break;       case 5: base = GA + 256; ldc = 512; break;
            case 6: base = QL; ldc = 256; break;       default: base = KVL; ldc = 160; ncols = 160; break;
        }
        const int col0 = wc * 32 + 8 * fq;
#pragma unroll
        for (int ai = 0; ai < 2; ++ai)
#pragma unroll
            for (int m = 0; m < 4; ++m) { bf16_t* rowp = base + (size_t)(row0 + ai * HALF + m * 16) * ldc + col0;
#pragma unroll
                for (int bj = 0; bj < 2; ++bj) { const f32x4 v0 = acc[ai][bj][m][0], v1 = acc[ai][bj][m][1];
                    u32x4 w; w.x = cvt_pk_bf16(v0[0], v0[1]); w.y = cvt_pk_bf16(v0[2], v0[3]); w.z = cvt_pk_bf16(v1[0], v1[1]); w.w = cvt_pk_bf16(v1[2], v1[3]);
                    if (col0 + bj * HALF < ncols) *(u32x4*)(rowp + bj * HALF) = w; } }
    }
};
struct EpiOut {
    static constexpr bool PERM = false, AFTER_DRAIN = false;
    const float* x; const float* gate; float* out;
    __device__ __forceinline__ void operator()(const f32x4 (&acc)[2][2][4][2], const Unit& u, int wr, int wc, int fr, int fq) const {
        const int col0 = u.pn * BM + wc * 32 + 4 * fq; const int b = (u.pm * BM) / SEQ;
        f32x4 gv[2][2];
#pragma unroll
        for (int bj = 0; bj < 2; ++bj)
#pragma unroll
            for (int n = 0; n < 2; ++n) gv[bj][n] = *(const f32x4*)(gate + (size_t)b * 1024 + col0 + bj * HALF + n * 16);
#pragma unroll
        for (int ai = 0; ai < 2; ++ai)
#pragma unroll
            for (int m = 0; m < 4; ++m) { const size_t off = (size_t)(u.pm * BM + ai * HALF + wr * 64 + m * 16 + fr) * 1024 + col0;
#pragma unroll
                for (int bj = 0; bj < 2; ++bj)
#pragma unroll
                    for (int n = 0; n < 2; ++n) { const f32x4 xs = *(const f32x4*)(x + off + bj * HALF + n * 16);
                        *(f32x4*)(out + off + bj * HALF + n * 16) = xs + gv[bj][n] * acc[ai][bj][m][n]; }
                if (m & 1) asm volatile("" ::: "memory"); }
    }
};

template <class Epi, class Sched, bool ALIGN_EPI = false, bool SP2 = false>
__device__ __forceinline__ void gemm_phase(PG8_LAS unsigned char* lds, const Gemm g, const Sched& S, const Epi& E) {
    const int tid = threadIdx.x, wid = __builtin_amdgcn_readfirstlane(tid >> 6), lane = tid & 63, wr = wid >> 2, wc = wid & 3, fr = lane & 15, fq = lane >> 4;
    const int K = g.K, nt = K / BK;
    unsigned voffA[2], voffB[2];
#pragma unroll
    for (int i = 0; i < 2; ++i) { int R, C; stage_rc(tid * 16 + i * 8192, R, C); const int Rb = Epi::PERM ? ((R & ~31) + perm32(R & 31)) : R;
        voffA[i] = (unsigned)(R * K + C) * 2u; voffB[i] = (unsigned)(Rb * K + C) * 2u; }
    const size_t kstep = (size_t)(BK * 2);
    const size_t hstep = (size_t)HALF * K * 2;
    const size_t tstep = 2 * hstep;
    const unsigned ldsw = (unsigned)wid * 1024u;
    const int aoff = lds_byte(wr * 64 + fr, fq * 8), boff = lds_byte(wc * 32 + fr, fq * 8);
#define PG8_SA(b, h) (((b) * 2 + (h)) * HTB)
#define PG8_SB(b, h) ((4 + (b) * 2 + (h)) * HTB)
#define PG8_STAGE(bufoff, gbase, voff) do { _Pragma("unroll") for (int _i = 0; _i < 2; ++_i) \
        __builtin_amdgcn_global_load_lds((const unsigned*)((const char*)(gbase) + (voff)[_i]), (PG8_LAS unsigned*)(lds + (bufoff) + ldsw + _i * 8192), 16, 0, 0); } while (0)
#define PG8_LDA(dst, b, h) do { _Pragma("unroll") for (int m = 0; m < 4; ++m) _Pragma("unroll") for (int k = 0; k < 2; ++k) dst[m][k] = *(const PG8_LAS bf16x8*)(lds + PG8_SA(b, h) + aoff + m * 2048 + k * 1024); } while (0)
#define PG8_LDB(dst, b, h) do { _Pragma("unroll") for (int n = 0; n < 2; ++n) _Pragma("unroll") for (int k = 0; k < 2; ++k) dst[n][k] = *(const PG8_LAS bf16x8*)(lds + PG8_SB(b, h) + boff + n * 2048 + k * 1024); } while (0)
#define PG8_MMA(ai, bj, At, Bt) do { __builtin_amdgcn_s_setprio(1); _Pragma("unroll") for (int m = 0; m < 4; ++m) _Pragma("unroll") for (int n = 0; n < 2; ++n) _Pragma("unroll") for (int k = 0; k < 2; ++k) \
        acc[ai][bj][m][n] = __builtin_amdgcn_mfma_f32_16x16x32_bf16(Bt[n][k], At[m][k], acc[ai][bj][m][n], 0, 0, 0); __builtin_amdgcn_s_setprio(0); } while (0)
#define PG8_WAIT_V(n) asm volatile("s_waitcnt vmcnt(" #n ")" ::: "memory")
#define PG8_WAIT_L(n) asm volatile("s_waitcnt lgkmcnt(" #n ")" ::: "memory")
#define PG8_BAR __builtin_amdgcn_s_barrier()
#define PG8_SCHED __builtin_amdgcn_sched_barrier(0)
    Unit cur, nxt; int ui = 0;
    if (!S.next(0, cur)) return;
    f32x4 acc[2][2][4][2];
#pragma unroll
    for (int a = 0; a < 2; ++a)
#pragma unroll
        for (int b = 0; b < 2; ++b)
#pragma unroll
            for (int m = 0; m < 4; ++m)
#pragma unroll
                for (int n = 0; n < 2; ++n) acc[a][b][m][n] = (f32x4){0.f, 0.f, 0.f, 0.f};
    bf16x8 At[4][2], B0[2][2], B1[2][2];
    const char* cA = (const char*)g.A + (size_t)cur.pm * tstep; const char* cB = (const char*)g.Bt + (size_t)cur.pn * tstep;
    S.a_ready(cur);
    if constexpr (SP2) {
        PG8_STAGE(PG8_SB(0, 0), cB, voffB); PG8_STAGE(PG8_SB(0, 1), cB + hstep, voffB); PG8_STAGE(PG8_SA(0, 0), cA, voffA); PG8_STAGE(PG8_SA(0, 1), cA + hstep, voffA);
        if (wr == 1) PG8_BAR;
        PG8_WAIT_V(2); PG8_BAR;
        PG8_STAGE(PG8_SB(1, 0), cB + kstep, voffB); PG8_STAGE(PG8_SA(1, 0), cA + kstep, voffA); PG8_STAGE(PG8_SB(1, 1), cB + hstep + kstep, voffB);
        PG8_WAIT_V(6); PG8_BAR;
    } else {
        PG8_STAGE(PG8_SB(0, 0), cB, voffB); PG8_STAGE(PG8_SA(0, 0), cA, voffA); PG8_STAGE(PG8_SB(0, 1), cB + hstep, voffB); PG8_STAGE(PG8_SA(0, 1), cA + hstep, voffA);
        if (wr == 1) PG8_BAR;
        PG8_WAIT_V(4); PG8_BAR;
        PG8_STAGE(PG8_SB(1, 0), cB + kstep, voffB); PG8_STAGE(PG8_SA(1, 0), cA + kstep, voffA); PG8_STAGE(PG8_SB(1, 1), cB + hstep + kstep, voffB);
        PG8_WAIT_V(6); PG8_BAR;
    }
    for (;;) {
        const bool has_next = S.next(ui + 1, nxt);
        const char* nA = has_next ? (const char*)g.A + (size_t)nxt.pm * tstep : cA; const char* nB = has_next ? (const char*)g.Bt + (size_t)nxt.pn * tstep : cB;
        for (int t = 0; t < nt; t += 2) {
            const bool last = (t == nt - 2);
            const char* a1 = cA + (size_t)(t + 1) * kstep;
            const char* a2 = last ? nA : cA + (size_t)(t + 2) * kstep; const char* b2 = last ? nB : cB + (size_t)(t + 2) * kstep;
            const char* a3 = a2 + kstep; const char* b3 = b2 + kstep;
            if (last && has_next) S.a_ready(nxt);
            if constexpr (SP2) {
            PG8_LDB(B0, 0, 0); PG8_LDB(B1, 0, 1); PG8_SCHED; PG8_LDA(At, 0, 0); PG8_STAGE(PG8_SA(1, 1), a1 + hstep, voffA);
            PG8_WAIT_V(8); PG8_WAIT_L(0); PG8_BAR; PG8_MMA(0, 0, At, B0); PG8_MMA(0, 1, At, B1); PG8_BAR; PG8_SCHED;
            PG8_LDA(At, 0, 1); PG8_STAGE(PG8_SB(0, 0), b2, voffB); PG8_STAGE(PG8_SB(0, 1), b2 + hstep, voffB); PG8_STAGE(PG8_SA(0, 0), a2, voffA);
            PG8_WAIT_V(8); PG8_WAIT_L(0); PG8_BAR; PG8_MMA(1, 0, At, B0); PG8_MMA(1, 1, At, B1); PG8_BAR; PG8_SCHED;
            PG8_LDB(B0, 1, 0); PG8_LDB(B1, 1, 1); PG8_SCHED; PG8_LDA(At, 1, 0); PG8_STAGE(PG8_SA(0, 1), a2 + hstep, voffA);
            PG8_WAIT_V(8); PG8_WAIT_L(0); PG8_BAR; PG8_MMA(0, 0, At, B0); PG8_MMA(0, 1, At, B1); PG8_BAR; PG8_SCHED;
            PG8_LDA(At, 1, 1); PG8_STAGE(PG8_SB(1, 0), b3, voffB); PG8_STAGE(PG8_SB(1, 1), b3 + hstep, voffB); PG8_STAGE(PG8_SA(1, 0), a3, voffA);
            PG8_WAIT_V(8); PG8_WAIT_L(0); PG8_BAR; PG8_MMA(1, 0, At, B0); PG8_MMA(1, 1, At, B1); PG8_BAR; PG8_SCHED;
            } else {
            PG8_LDB(B0, 0, 0); PG8_SCHED; PG8_LDA(At, 0, 0); PG8_STAGE(PG8_SA(1, 1), a1 + hstep, voffA);
            PG8_WAIT_L(8); PG8_BAR; PG8_WAIT_L(0); PG8_MMA(0, 0, At, B0); PG8_BAR; PG8_SCHED;
            PG8_LDB(B1, 0, 1); PG8_STAGE(PG8_SB(0, 0), b2, voffB);
            PG8_BAR; PG8_WAIT_L(0); PG8_MMA(0, 1, At, B1); PG8_BAR;
            PG8_LDA(At, 0, 1); PG8_STAGE(PG8_SA(0, 0), a2, voffA);
            PG8_BAR; PG8_WAIT_L(0); PG8_MMA(1, 0, At, B0); PG8_BAR; PG8_SCHED;
            PG8_STAGE(PG8_SB(0, 1), b2 + hstep, voffB);
            PG8_WAIT_V(6); PG8_BAR; PG8_MMA(1, 1, At, B1); PG8_BAR;
            PG8_LDB(B0, 1, 0); PG8_SCHED; PG8_LDA(At, 1, 0); PG8_STAGE(PG8_SA(0, 1), a2 + hstep, voffA);
            PG8_WAIT_L(8); PG8_BAR; PG8_WAIT_L(0); PG8_MMA(0, 0, At, B0); PG8_BAR; PG8_SCHED;
            PG8_LDB(B1, 1, 1); PG8_STAGE(PG8_SB(1, 0), b3, voffB);
            PG8_BAR; PG8_WAIT_L(0); PG8_MMA(0, 1, At, B1); PG8_BAR;
            PG8_LDA(At, 1, 1); PG8_STAGE(PG8_SA(1, 0), a3, voffA);
            PG8_BAR; PG8_WAIT_L(0); PG8_MMA(1, 0, At, B0); PG8_BAR; PG8_SCHED;
            PG8_STAGE(PG8_SB(1, 1), b3 + hstep, voffB);
            PG8_WAIT_V(6); PG8_BAR; PG8_MMA(1, 1, At, B1); PG8_BAR;
            }
        }
        if constexpr (ALIGN_EPI) { if (wr == 0) PG8_BAR; }
        if constexpr (!Epi::AFTER_DRAIN) { E(acc, cur, wr, wc, fr, fq); S.done(cur); }
        if (!has_next) break;
#pragma unroll
        for (int a = 0; a < 2; ++a)
#pragma unroll
            for (int b = 0; b < 2; ++b)
#pragma unroll
                for (int m = 0; m < 4; ++m)
#pragma unroll
                    for (int n = 0; n < 2; ++n) acc[a][b][m][n] = (f32x4){0.f, 0.f, 0.f, 0.f};
        cur = nxt; cA = nA; cB = nB; ++ui;
        if constexpr (ALIGN_EPI) { if (wr == 1) PG8_BAR; }
    }
    PG8_WAIT_V(0);
    if constexpr (!ALIGN_EPI) { if (wr == 0) PG8_BAR; }
    PG8_BAR;
#undef PG8_SA
#undef PG8_SB
#undef PG8_STAGE
#undef PG8_LDA
#undef PG8_LDB
#undef PG8_MMA
#undef PG8_WAIT_V
#undef PG8_WAIT_L
#undef PG8_BAR
#undef PG8_SCHED
}
}


namespace att {
using bf16x8 = __attribute__((ext_vector_type(8))) short;
using s16x4  = __attribute__((ext_vector_type(4))) short;
using f32x16 = __attribute__((ext_vector_type(16))) float;
using u32x4  = __attribute__((ext_vector_type(4))) unsigned;
constexpr int NW = 8, QBLK = 32, KVBLK = 64;
constexpr float SCALE = 0.10206207261596577f;
constexpr float THR = 8.f;
constexpr int SHM_V = 16384, SHM_K = 16384, SHM_ATTN = 2 * SHM_V + 2 * SHM_K + NW * 64 * 4;
#define KSWZ(row, colB) ((row) * 256 + ((colB) ^ (((row) & 7) << 4)))
#define SBAR() __builtin_amdgcn_sched_barrier(0)
__device__ __forceinline__ int crow(int r, int hi) { return (r & 3) + 8 * (r >> 2) + 4 * hi; }
__device__ __forceinline__ unsigned cvtpk(float lo, float hi) { unsigned r; asm volatile("v_cvt_pk_bf16_f32 %0, %1, %2" : "=v"(r) : "v"(lo), "v"(hi)); return r; }
__device__ __forceinline__ void partialSM(f32x16& p0, f32x16& p1, float& m_reg, float& mn, float& alpha) {
  constexpr float C = SCALE * 1.4426950408889634f;
  float pmax = p0[0]; for (int r = 1; r < 16; ++r) pmax = fmaxf(pmax, p0[r]); for (int r = 0; r < 16; ++r) pmax = fmaxf(pmax, p1[r]);
  { auto rr = __builtin_amdgcn_permlane32_swap(__float_as_uint(pmax), __float_as_uint(pmax), false, false);
    pmax = fmaxf(__uint_as_float(rr[0]), __uint_as_float(rr[1])); }
  if (__builtin_expect(__all(pmax - m_reg <= THR / SCALE), 1)) { mn = m_reg; alpha = 1.f; }
  else { mn = fmaxf(m_reg, pmax); alpha = __builtin_amdgcn_exp2f((m_reg - mn) * C); m_reg = mn; }
  float mnC = -mn * C;
  for (int r = 0; r < 16; ++r) p0[r] = fmaf(p0[r], C, mnC); for (int r = 0; r < 16; ++r) p1[r] = fmaf(p1[r], C, mnC);
  for (int r = 0; r < 16; ++r) p0[r] = __builtin_amdgcn_exp2f(p0[r]);
}
__device__ __forceinline__ void finishSM(f32x16& p0, f32x16& p1, float alpha, float& l_reg, bf16x8& pa0, bf16x8& pa1, bf16x8& pa2, bf16x8& pa3) {
  for (int r = 0; r < 16; ++r) p1[r] = __builtin_amdgcn_exp2f(p1[r]);
  float ps = 0; for (int r = 0; r < 16; ++r) ps += p0[r]; for (int r = 0; r < 16; ++r) ps += p1[r];
  { auto rr = __builtin_amdgcn_permlane32_swap(__float_as_uint(ps), __float_as_uint(ps), false, false);
    ps = __uint_as_float(rr[0]) + __uint_as_float(rr[1]); }
  l_reg = l_reg * alpha + ps;
#define PK4(P, BASE, OUT) do { unsigned a0 = cvtpk(P[BASE + 0], P[BASE + 1]), a1 = cvtpk(P[BASE + 2], P[BASE + 3]);   \
    unsigned b0 = cvtpk(P[BASE + 4], P[BASE + 5]), b1 = cvtpk(P[BASE + 6], P[BASE + 7]);                              \
    auto r0 = __builtin_amdgcn_permlane32_swap(a0, b0, false, false); auto r1 = __builtin_amdgcn_permlane32_swap(a1, b1, false, false); \
    u32x4 w = {r0[0], r1[0], r0[1], r1[1]}; OUT = *reinterpret_cast<bf16x8*>(&w); } while (0)
  PK4(p0, 0, pa0); PK4(p0, 8, pa1); PK4(p1, 0, pa2); PK4(p1, 8, pa3);
#undef PK4
}
__device__ __forceinline__ void qkt(f32x16& p0, f32x16& p1, const LAS char* Ks, const bf16x8* qr, int r32, int hi) {
  p0 = f32x16{}; p1 = f32x16{};
#pragma unroll
  for (int d0 = 0; d0 < 6; ++d0) { int cb = (d0 * 16 + hi * 8) * 2;
    bf16x8 b0 = *reinterpret_cast<const LAS bf16x8*>(Ks + KSWZ(r32, cb));
    bf16x8 b1 = *reinterpret_cast<const LAS bf16x8*>(Ks + KSWZ(32 + r32, cb));
    p0 = __builtin_amdgcn_mfma_f32_32x32x16_bf16(b0, qr[d0], p0, 0, 0, 0);
    p1 = __builtin_amdgcn_mfma_f32_32x32x16_bf16(b1, qr[d0], p1, 0, 0, 0); }
}
__device__ __forceinline__ int v_st(int k, int c) { const int kk = (k & ~0xC) | ((k & 4) << 1) | ((k & 8) >> 1); return ((kk >> 3) * 4 + (c >> 5)) * 512 + ((kk & 7) * 32 + (c & 31)) * 2; }
__device__ __forceinline__ int v_rd_base(int lane) { return ((lane & 3) << 3) | (((lane >> 2) & 3) << 6) | (((lane >> 4) & 1) << 5) | (((lane >> 5) & 1) << 8); }
constexpr int v_rd_off(int d0, int ks, int half) { return d0 * 512 + ks * 4096 + half * 2048; }
template <int OFF> __device__ __forceinline__ s16x4 tr_read(int vb) {
  s16x4 r; asm volatile("ds_read_b64_tr_b16 %0, %1 offset:%2" : "=&v"(r) : "v"(vb), "i"(OFF) : "memory"); return r;
}
template <int D0> __device__ __forceinline__ void pv_one(f32x16& od, int vb, bf16x8 pa0, bf16x8 pa1, bf16x8 pa2, bf16x8 pa3) {
  const s16x4 l0 = tr_read<v_rd_off(D0, 0, 0)>(vb), h0 = tr_read<v_rd_off(D0, 0, 1)>(vb), l1 = tr_read<v_rd_off(D0, 1, 0)>(vb), h1 = tr_read<v_rd_off(D0, 1, 1)>(vb);
  const s16x4 l2 = tr_read<v_rd_off(D0, 2, 0)>(vb), h2 = tr_read<v_rd_off(D0, 2, 1)>(vb), l3 = tr_read<v_rd_off(D0, 3, 0)>(vb), h3 = tr_read<v_rd_off(D0, 3, 1)>(vb);
  asm volatile("s_waitcnt lgkmcnt(0)" ::: "memory"); SBAR();
#define PK(L, H) (bf16x8){L[0], L[1], L[2], L[3], H[0], H[1], H[2], H[3]}
  od = __builtin_amdgcn_mfma_f32_32x32x16_bf16(pa0, PK(l0, h0), od, 0, 0, 0);
  od = __builtin_amdgcn_mfma_f32_32x32x16_bf16(pa1, PK(l1, h1), od, 0, 0, 0);
  od = __builtin_amdgcn_mfma_f32_32x32x16_bf16(pa2, PK(l2, h2), od, 0, 0, 0);
  od = __builtin_amdgcn_mfma_f32_32x32x16_bf16(pa3, PK(l3, h3), od, 0, 0, 0);
#undef PK
}
__device__ __forceinline__ void pv_d0(f32x16* o, int vb, bf16x8 pa0, bf16x8 pa1, bf16x8 pa2, bf16x8 pa3) {
  pv_one<0>(o[0], vb, pa0, pa1, pa2, pa3); pv_one<1>(o[1], vb, pa0, pa1, pa2, pa3);
}
__device__ __forceinline__ void attn_unit(const bf16_t* Qb, const bf16_t* Kh, const bf16_t* Vh, const bf16_t* GAb, bf16_t* Yb, LAS char* lds) {
  const int tid = threadIdx.x, wid = tid >> 6, lane = tid & 63, r32 = lane & 31, hi = lane >> 5;
  LAS char* V_lds = lds; LAS char* K_lds = lds + 2 * SHM_V;
  LAS float* ws = (LAS float*)(lds + 2 * SHM_V + 2 * SHM_K) + wid * 64; LAS float* li_l = ws; LAS float* al_l = ws + 32;
  float m_reg = -1e30f, l_reg = 0; f32x16 o[2] = {}; bf16x8 qr[6];
  const bf16_t* Qw = Qb + (size_t)(wid * QBLK + r32) * DQK + hi * 8;
#pragma unroll
  for (int d0 = 0; d0 < 6; ++d0) qr[d0] = *reinterpret_cast<const bf16x8*>(Qw + d0 * 16);
  const int kst0 = KSWZ(tid / 12, (tid % 12) * 16), kst1 = KSWZ((512 + tid) / 12, ((512 + tid) % 12) * 16);
  const bool k2 = __builtin_amdgcn_readfirstlane(wid) < 4;
  const int vst = v_st(tid >> 3, (tid & 7) * 8);
  const int vb0 = (int)(uintptr_t)V_lds + v_rd_base(lane);
  struct { bf16x8 k0, k1, v; } sr_[2];
#define SLOAD(i, key0) do { const bf16_t* kp_ = Kh + (size_t)(key0) * DQK; sr_[i].k0 = *reinterpret_cast<const bf16x8*>(kp_ + tid * 8); \
    if (k2) sr_[i].k1 = *reinterpret_cast<const bf16x8*>(kp_ + (512 + tid) * 8); sr_[i].v = *reinterpret_cast<const bf16x8*>(Vh + (size_t)(key0) * DV + tid * 8); } while (0)
#define SWRITE(b, i) do { *(LAS bf16x8*)(K_lds + (b) * SHM_K + kst0) = sr_[i].k0; if (k2) *(LAS bf16x8*)(K_lds + (b) * SHM_K + kst1) = sr_[i].k1; \
    *(LAS bf16x8*)(V_lds + (b) * SHM_V + vst) = sr_[i].v; } while (0)
#define RESC(a) do { if (__any((a) < 1.f)) { if (hi == 0) al_l[r32] = (a); asm volatile("s_waitcnt lgkmcnt(0)" ::: "memory"); \
    for (int d = 0; d < 2; ++d) for (int r = 0; r < 16; ++r) o[d][r] *= al_l[crow(r, hi)]; } } while (0)
  f32x16 pA0, pA1, pB0, pB1; float mnA, mnB, alA, alB; bf16x8 pa0, pa1, pa2, pa3; constexpr int NT = SEQ / KVBLK;
  constexpr int SE = 0, SO = 1;
  SLOAD(SE, 0); SWRITE(0, SE); __syncthreads();
  qkt(pA0, pA1, K_lds, qr, r32, hi); partialSM(pA0, pA1, m_reg, mnA, alA);
  SLOAD(SO, KVBLK); SLOAD(SE, 2 * KVBLK);
  SWRITE(1, SO); __syncthreads();
  for (int j = 1; j + 1 < NT; j += 2) {
    SBAR(); qkt(pB0, pB1, K_lds + SHM_K, qr, r32, hi);
    finishSM(pA0, pA1, alA, l_reg, pa0, pa1, pa2, pa3); SBAR();
    SLOAD(SO, (j + 2) * KVBLK); SBAR();
    pv_d0(o, vb0, pa0, pa1, pa2, pa3); partialSM(pB0, pB1, m_reg, mnB, alB);
    __syncthreads(); SWRITE(0, SE);
    RESC(alB); __syncthreads();
    SBAR(); qkt(pA0, pA1, K_lds, qr, r32, hi);
    finishSM(pB0, pB1, alB, l_reg, pa0, pa1, pa2, pa3); SBAR();
    if (j + 3 < NT) SLOAD(SE, (j + 3) * KVBLK); SBAR();
    pv_d0(o, vb0 + SHM_V, pa0, pa1, pa2, pa3); partialSM(pA0, pA1, m_reg, mnA, alA);
    __syncthreads(); SWRITE(1, SO);
    RESC(alA); __syncthreads();
  }
  SBAR(); qkt(pB0, pB1, K_lds + SHM_K, qr, r32, hi);
  finishSM(pA0, pA1, alA, l_reg, pa0, pa1, pa2, pa3); SBAR();
  pv_d0(o, vb0, pa0, pa1, pa2, pa3); partialSM(pB0, pB1, m_reg, mnB, alB);
  __syncthreads(); RESC(alB);
  finishSM(pB0, pB1, alB, l_reg, pa0, pa1, pa2, pa3); SBAR();
  pv_d0(o, vb0 + SHM_V, pa0, pa1, pa2, pa3);
  if (hi == 0) li_l[r32] = l_reg; asm volatile("s_waitcnt lgkmcnt(0)" ::: "memory");
  float rli[16];
#pragma unroll
  for (int r = 0; r < 16; ++r) rli[r] = __builtin_amdgcn_rcpf(li_l[crow(r, hi)]);
#pragma unroll
  for (int r = 0; r < 16; ++r) { const int orow = wid * QBLK + crow(r, hi);
#pragma unroll
    for (int d0 = 0; d0 < 2; ++d0) { const int col = d0 * 32 + r32; const float g = bf2f(GAb[(size_t)orow * 512 + col]);
      Yb[(size_t)orow * 1024 + col] = f2bf(o[d0][r] * rli[r] * siluf(g)); } }
  __syncthreads();
#undef SLOAD
#undef SWRITE
#undef RESC
}
#undef KSWZ
#undef SBAR
}

struct Frame {
    LAS unsigned char* lds;
    int tid, lane, wave, vb, G;
    float* modp; float* rope; float* gate;
    bf16_t *WIN, *WUQ, *WUKV, *WPOOL, *WOUT;
    bf16_t *XN, *UP, *GP, *GA, *QL, *KVL, *Q, *K, *V, *Y;
};
__device__ __forceinline__ float mod_val(const Params& P, const Frame& F, int b, int e) {
    float s = P.ada_b[e];
#pragma unroll
    for (int kq = 0; kq < 4; ++kq) s += F.modp[((size_t)kq * 16 + b) * 3072 + e];
    return s;
}

__device__ __forceinline__ void ph0_mod(const Params& P, Frame& F) {
    LAS float* cact = (LAS float*)F.lds;
    LAS float* red = (LAS float*)(F.lds + 65536);
    bool have = false;
    for (int item = F.vb; item < 192; item += F.G) {
        if (!have) { for (int i = F.tid; i < 16384; i += NTHREADS) cact[i] = siluf(P.c[i]); __syncthreads(); have = true; }
        const int cg = item % 48, kq = item / 48;
        const int col = cg * 64 + F.lane, r0 = kq * 256 + F.wave * 32;
        float acc[16];
#pragma unroll
        for (int b = 0; b < 16; ++b) acc[b] = 0.f;
#pragma unroll 4
        for (int r = 0; r < 32; ++r) {
            const float w = P.ada_w[(size_t)(r0 + r) * 3072 + col];
#pragma unroll
            for (int b = 0; b < 16; ++b) acc[b] += cact[b * 1024 + r0 + r] * w;
        }
#pragma unroll
        for (int b = 0; b < 16; ++b) red[(F.wave * 16 + b) * 64 + F.lane] = acc[b];
        __syncthreads();
        for (int o = F.tid; o < 1024; o += NTHREADS) {
            const int b = o >> 6, cl = o & 63; float s = 0.f;
#pragma unroll
            for (int w = 0; w < 8; ++w) s += red[(w * 16 + b) * 64 + cl];
            F.modp[((size_t)kq * 16 + b) * 3072 + cg * 64 + cl] = s;
        }
        __syncthreads();
    }
}


__device__ __forceinline__ unsigned pk2(float lo, float hi) { return (unsigned)f2bf(lo) | ((unsigned)f2bf(hi) << 16); }
__device__ __forceinline__ void p0_transpose_item(const float* W, int K, int N, int nsrc0, bf16_t* WT, int ndst0, int k0, LAS float* scr, int lane) {
    if (nsrc0 >= 0) {
#pragma unroll 8
        for (int i = 0; i < 32; ++i) { const int kk = 2 * i + (lane >> 5); scr[kk * 33 + (lane & 31)] = W[(size_t)(k0 + kk) * N + nsrc0 + (lane & 31)]; }
    } else {
#pragma unroll 8
        for (int i = 0; i < 32; ++i) { const int kk = 2 * i + (lane >> 5); scr[kk * 33 + (lane & 31)] = 0.f; }
    }
    asm volatile("s_waitcnt lgkmcnt(0)" ::: "memory");
    const int c = lane & 7;
#pragma unroll
    for (int j = 0; j < 4; ++j) { const int n = (lane >> 3) + 8 * j; const LAS float* s = scr + (8 * c) * 33 + n;
        uint4 o; o.x = pk2(s[0 * 33], s[1 * 33]); o.y = pk2(s[2 * 33], s[3 * 33]); o.z = pk2(s[4 * 33], s[5 * 33]); o.w = pk2(s[6 * 33], s[7 * 33]);
        *(uint4*)(WT + (size_t)(ndst0 + n) * K + k0 + 8 * c) = o; }
    asm volatile("s_waitcnt lgkmcnt(0)" ::: "memory");
}
__device__ __forceinline__ int win_src_col(int n) { return n < 1024 ? n : (n < 1536 ? OFF_GA + (n - 1024) : (n < 1792 ? OFF_QL + (n - 1536) : (n < 1952 ? OFF_KVL + (n - 1792) : -1))); }
__device__ __forceinline__ void ph0_weights(const Params& P, Frame& F) {
    LAS float* scr = (LAS float*)(F.lds + F.wave * 16384);
    const int NGW = F.G * NWAVES, gw = NGW - 1 - (F.vb * NWAVES + F.wave);
    constexpr int I_IN = 16 * 64, I_OUT = 16 * 32;
    for (int it = gw; it < I_IN + I_OUT; it += NGW) {
        if (it < I_IN) { const int kb = it / 64, nb = it % 64; p0_transpose_item(P.w_in, DM, INW, win_src_col(32 * nb), F.WIN, 32 * nb, 64 * kb, scr, F.lane); }
        else { const int r = it - I_IN, kb = r / 32, nb = r % 32; p0_transpose_item(P.w_out, DM, DM, 32 * nb, F.WOUT, 32 * nb, 64 * kb, scr, F.lane); }
    }
}

__device__ __forceinline__ void ph1_xn(const Params& P, Frame& F) {
    LAS float* gs = (LAS float*)F.lds; LAS float* sh = gs + 1024;
    for (int item = F.vb; item < TOK / 128; item += F.G) {
        const int row0 = item * 128, b = row0 / SEQ;
        __syncthreads();
        for (int d = F.tid; d < 1024; d += NTHREADS) { const float sc = mod_val(P, F, b, 1024 + d), sf = mod_val(P, F, b, d); gs[d] = P.norm_g[d] * (1.f + sc); sh[d] = sf; }
        if (F.tid < 64) { const int n = (item % 16) * 64 + F.tid; F.gate[(size_t)b * 1024 + n] = mod_val(P, F, b, 2048 + n); }
        __syncthreads();
        for (int i = 0; i < 16; ++i) {
            const int t = row0 + F.wave * 16 + i;
            const float4* xr = (const float4*)(P.x + (size_t)t * 1024) + F.lane;
            float4 v[4]; float ss = 0.f;
#pragma unroll
            for (int j = 0; j < 4; ++j) { v[j] = xr[64 * j]; ss += (v[j].x * v[j].x + v[j].y * v[j].y) + (v[j].z * v[j].z + v[j].w * v[j].w); }
            ss = wave_sum(ss);
            const float r = rsqrtf(ss * (1.f / 1024.f) + EPS);
#pragma unroll
            for (int j = 0; j < 4; ++j) {
                const int d = 4 * F.lane + 256 * j;
                const float o0 = (v[j].x * r) * gs[d] + sh[d], o1 = (v[j].y * r) * gs[d + 1] + sh[d + 1], o2 = (v[j].z * r) * gs[d + 2] + sh[d + 2], o3 = (v[j].w * r) * gs[d + 3] + sh[d + 3];
                uint2 pk; pk.x = (unsigned)f2bf(o0) | ((unsigned)f2bf(o1) << 16); pk.y = (unsigned)f2bf(o2) | ((unsigned)f2bf(o3) << 16);
                *(uint2*)(F.XN + (size_t)t * 1024 + d) = pk;
            }
            if (F.lane < 16) {
                const float ang = (float)P.pos[t] * INVF[F.lane];
                float sn, cs; sincosf(ang, &sn, &cs);
                F.rope[(size_t)t * 32 + F.lane] = cs; F.rope[(size_t)t * 32 + 16 + F.lane] = sn;
            }
        }
    }
}

template <class AF, class BF, class EF>
__device__ __forceinline__ void naive_gemm(Frame& F, int M, int N, int K, AF a, BF bfn, EF epi) {
    LAS float* As = (LAS float*)F.lds;
    LAS float* Bs = As + 16 * 132;
    const int tx = F.tid & 31, ty = F.tid >> 5;
    const int ntm = M / 128, ntn = (N + 127) / 128;
    for (int tile = F.vb; tile < ntm * ntn; tile += F.G) {
        const int m0 = (tile / ntn) * 128, n0 = (tile % ntn) * 128;
        float acc[8][4];
#pragma unroll
        for (int i = 0; i < 8; ++i)
#pragma unroll
            for (int j = 0; j < 4; ++j) acc[i][j] = 0.f;
        for (int k0 = 0; k0 < K; k0 += 16) {
            __syncthreads();
#pragma unroll
            for (int i = 0; i < 4; ++i) { const int e = F.tid + i * NTHREADS; As[(e & 15) * 132 + (e >> 4)] = a(m0 + (e >> 4), k0 + (e & 15)); }
#pragma unroll
            for (int i = 0; i < 4; ++i) { const int e = F.tid + i * NTHREADS; Bs[(e >> 7) * 132 + (e & 127)] = bfn(k0 + (e >> 7), n0 + (e & 127)); }
            __syncthreads();
#pragma unroll
            for (int kk = 0; kk < 16; ++kk) {
                float av[8], bv[4];
#pragma unroll
                for (int i = 0; i < 8; ++i) av[i] = As[kk * 132 + ty * 8 + i];
#pragma unroll
                for (int j = 0; j < 4; ++j) bv[j] = Bs[kk * 132 + tx * 4 + j];
#pragma unroll
                for (int i = 0; i < 8; ++i)
#pragma unroll
                    for (int j = 0; j < 4; ++j) acc[i][j] += av[i] * bv[j];
            }
        }
#pragma unroll
        for (int i = 0; i < 8; ++i)
#pragma unroll
            for (int j = 0; j < 4; ++j) epi(m0 + ty * 8 + i, n0 + tx * 4 + j, acc[i][j]);
    }
    __syncthreads();
}

__device__ __forceinline__ void ph2_inproj(const Params& P, Frame& F) {
    const bf16_t* XN = F.XN; const float* W = P.w_in;
    bf16_t *UP = F.UP, *GP = F.GP, *GA = F.GA, *QL = F.QL, *KVL = F.KVL;
    naive_gemm(F, TOK, INW, DM,
        [=](int m, int k) { return bf2f(XN[(size_t)m * 1024 + k]); },
        [=](int k, int n) { return n < INW ? W[(size_t)k * INW + n] : 0.f; },
        [=](int m, int n, float v) {
            const bf16_t h = f2bf(v);
            if (n < OFF_GP) UP[(size_t)m * 512 + n] = h;
            else if (n < OFF_QL) GP[(size_t)m * 512 + (n - OFF_GP)] = h;
            else if (n < OFF_KVL) QL[(size_t)m * 256 + (n - OFF_QL)] = h;
            else if (n < OFF_GA) KVL[(size_t)m * 160 + (n - OFF_KVL)] = h;
            else if (n < INW) GA[(size_t)m * 512 + (n - OFF_GA)] = h;
        });
}

__device__ __forceinline__ void ph3_upproj(const Params& P, Frame& F) {
    const int gw = F.vb * NWAVES + F.wave, NGW = F.G * NWAVES;
    for (int wi = gw; wi < (TOK / 64) * NH; wi += NGW) {
        const int h = wi % NH, t = (wi / NH) * 64 + F.lane, b = t / SEQ, s = t % SEQ;
        float acc[DQK];
#pragma unroll
        for (int d = 0; d < DQK; ++d) acc[d] = 0.f;
        float ssq = 0.f;
        for (int r = 0; r < QLORA; ++r) {
            float a = bf2f(F.QL[(size_t)t * 256 + r]); ssq += a * a; a *= P.g_q_lat[r];
            const float* w = P.w_uq + (size_t)r * (NH * DQK) + h * DQK;
#pragma unroll
            for (int d = 0; d < DQK; ++d) acc[d] += a * w[d];
        }
        const float rq = rsqrtf(ssq * (1.f / QLORA) + EPS);
        float s2 = 0.f;
#pragma unroll
        for (int d = 0; d < DQK; ++d) { acc[d] *= rq; s2 += acc[d] * acc[d]; }
        const float rh = rsqrtf(s2 * (1.f / DQK) + EPS);
#pragma unroll
        for (int d = 0; d < DQK; ++d) acc[d] = acc[d] * rh * P.g_qnorm[d];
#pragma unroll
        for (int i = 0; i < 16; ++i) {
            const float cs = F.rope[(size_t)t * 32 + i], sn = F.rope[(size_t)t * 32 + 16 + i];
            const float x1 = acc[64 + i], x2 = acc[80 + i];
            acc[64 + i] = x1 * cs - x2 * sn; acc[80 + i] = x2 * cs + x1 * sn;
        }
        bf16_t* qo = F.Q + ((size_t)(b * NH + h) * SEQ + s) * DQK;
#pragma unroll
        for (int d = 0; d < DQK; d += 2) *(unsigned*)(qo + d) = (unsigned)f2bf(acc[d]) | ((unsigned)f2bf(acc[d + 1]) << 16);
    }
    for (int wi = gw; wi < (TOK / 64) * NH; wi += NGW) {
        const int h = wi % NH, t = (wi / NH) * 64 + F.lane, b = t / SEQ, s = t % SEQ;
        float acc[64];
#pragma unroll
        for (int d = 0; d < 64; ++d) acc[d] = 0.f;
        float ssq = 0.f;
        for (int r = 0; r < KVLORA; ++r) {
            float a = bf2f(F.KVL[(size_t)t * 160 + r]); ssq += a * a; a *= P.g_kv_lat[r];
            const float* w = P.w_ukv + (size_t)r * (NH * 128) + h * 128;
#pragma unroll
            for (int d = 0; d < 64; ++d) acc[d] += a * w[d];
        }
        const float rkv = rsqrtf(ssq * (1.f / KVLORA) + EPS);
        float s2 = 0.f;
#pragma unroll
        for (int d = 0; d < 64; ++d) { acc[d] *= rkv; s2 += acc[d] * acc[d]; }
        float kr[32];
#pragma unroll
        for (int i = 0; i < 32; ++i) { kr[i] = bf2f(F.KVL[(size_t)t * 160 + 128 + i]); s2 += kr[i] * kr[i]; }
        const float rh = rsqrtf(s2 * (1.f / DQK) + EPS);
#pragma unroll
        for (int d = 0; d < 64; ++d) acc[d] = acc[d] * rh * P.g_knorm[d];
#pragma unroll
        for (int i = 0; i < 32; ++i) kr[i] = kr[i] * rh * P.g_knorm[64 + i];
#pragma unroll
        for (int i = 0; i < 16; ++i) {
            const float cs = F.rope[(size_t)t * 32 + i], sn = F.rope[(size_t)t * 32 + 16 + i];
            const float x1 = kr[i], x2 = kr[16 + i];
            kr[i] = x1 * cs - x2 * sn; kr[16 + i] = x2 * cs + x1 * sn;
        }
        bf16_t* ko = F.K + ((size_t)(b * NH + h) * SEQ + s) * DQK;
#pragma unroll
        for (int d = 0; d < 64; d += 2) *(unsigned*)(ko + d) = (unsigned)f2bf(acc[d]) | ((unsigned)f2bf(acc[d + 1]) << 16);
#pragma unroll
        for (int i = 0; i < 32; i += 2) *(unsigned*)(ko + 64 + i) = (unsigned)f2bf(kr[i]) | ((unsigned)f2bf(kr[i + 1]) << 16);
    }
    for (int wi = gw; wi < (TOK / 64) * NH; wi += NGW) {
        const int h = wi % NH, t = (wi / NH) * 64 + F.lane, b = t / SEQ, s = t % SEQ;
        float acc[64];
#pragma unroll
        for (int d = 0; d < 64; ++d) acc[d] = 0.f;
        float ssq = 0.f;
        for (int r = 0; r < KVLORA; ++r) {
            float a = bf2f(F.KVL[(size_t)t * 160 + r]); ssq += a * a; a *= P.g_kv_lat[r];
            const float* w = P.w_ukv + (size_t)r * (NH * 128) + h * 128 + 64;
#pragma unroll
            for (int d = 0; d < 64; ++d) acc[d] += a * w[d];
        }
        const float rkv = rsqrtf(ssq * (1.f / KVLORA) + EPS);
        bf16_t* vo = F.V + ((size_t)(b * NH + h) * SEQ + s) * DV;
#pragma unroll
        for (int d = 0; d < 64; d += 2) *(unsigned*)(vo + d) = (unsigned)f2bf(acc[d] * rkv) | ((unsigned)f2bf(acc[d + 1] * rkv) << 16);
    }
}

__device__ __forceinline__ void ph3_pool(const Params& P, Frame& F) {
    LAS float* df = (LAS float*)F.lds;
    for (int item = F.vb; item < (TOK / 32) * 4; item += F.G) {
        const int tt = item >> 2, gi = item & 3, t0 = tt * 32, b = t0 / SEQ, s0 = t0 % SEQ, half = 1 << gi;
        __syncthreads();
        for (int e = F.tid; e < 4096; e += NTHREADS) {
            const int tl = e >> 7, c = e & 127, s = s0 + tl;
            const int lo = (s - half) > 0 ? (s - half) : 0, hi = (s + half) < SEQ ? (s + half) : SEQ;
            float sum = 0.f;
            for (int sp = lo; sp < hi; ++sp) sum += bf2f(F.UP[((size_t)b * SEQ + sp) * 512 + gi * 128 + c]);
            df[e] = sum / (float)(hi - lo) - bf2f(F.UP[((size_t)b * SEQ + s) * 512 + gi * 128 + c]);
        }
        __syncthreads();
        for (int o = F.tid; o < 4096; o += NTHREADS) {
            const int tl = o >> 7, d = o & 127;
            float acc = 0.f;
            for (int c = 0; c < 128; ++c) acc += df[tl * 128 + c] * P.pool_w[((size_t)gi * 128 + c) * 128 + d];
            const int n = gi * 128 + d, t = t0 + tl;
            const float g = bf2f(F.GP[(size_t)t * 512 + n]);
            F.Y[(size_t)t * 1024 + n] = f2bf(acc * P.pool_scale[n] * siluf(g));
        }
    }
    __syncthreads();
}

__device__ __forceinline__ void ph4_attn(const Params& P, Frame& F) {
    LAS float* Ks = (LAS float*)F.lds;
    LAS float* Vs = Ks + 64 * 96;
    const float scale = 0.10206207261596577f;
    const int hf = F.tid & 1, row = F.tid >> 1;
    for (int item = F.vb; item < NB * NH * 8; item += F.G) {
        const int bh = item >> 3, qb = item & 7, s = qb * 256 + row, b = bh / NH, h = bh % NH;
        float q[48];
        { const bf16_t* qp = F.Q + ((size_t)bh * SEQ + s) * DQK + hf * 48;
#pragma unroll
          for (int d = 0; d < 48; ++d) q[d] = bf2f(qp[d]) * scale; }
        float o[32];
#pragma unroll
        for (int d = 0; d < 32; ++d) o[d] = 0.f;
        float m = -1e30f, l = 0.f;
        for (int kt = 0; kt < SEQ / 64; ++kt) {
            __syncthreads();
            { const bf16_t* kp = F.K + ((size_t)bh * SEQ + kt * 64) * DQK;
              for (int e = F.tid; e < 64 * DQK; e += NTHREADS) Ks[e] = bf2f(kp[e]);
              const bf16_t* vp = F.V + ((size_t)bh * SEQ + kt * 64) * DV;
              for (int e = F.tid; e < 64 * DV; e += NTHREADS) Vs[e] = bf2f(vp[e]); }
            __syncthreads();
#pragma unroll 1
            for (int kc = 0; kc < 8; ++kc) {
                float sc[8]; float mx = -1e30f;
#pragma unroll
                for (int j = 0; j < 8; ++j) {
                    float dot = 0.f;
#pragma unroll
                    for (int d = 0; d < 48; ++d) dot += q[d] * Ks[(kc * 8 + j) * DQK + hf * 48 + d];
                    dot += __shfl_xor(dot, 1);
                    sc[j] = dot; mx = fmaxf(mx, dot);
                }
                const float mn = fmaxf(m, mx), alpha = __expf(m - mn);
                l *= alpha;
#pragma unroll
                for (int d = 0; d < 32; ++d) o[d] *= alpha;
                m = mn;
#pragma unroll
                for (int j = 0; j < 8; ++j) {
                    const float p = __expf(sc[j] - m); l += p;
#pragma unroll
                    for (int d = 0; d < 32; ++d) o[d] += p * Vs[(kc * 8 + j) * DV + hf * 32 + d];
                }
            }
        }
        const float rl = 1.f / l; const size_t t = (size_t)b * SEQ + s;
#pragma unroll
        for (int d = 0; d < 32; d += 2) {
            const int col = h * 64 + hf * 32 + d;
            const float g0 = bf2f(F.GA[t * 512 + col]), g1 = bf2f(F.GA[t * 512 + col + 1]);
            *(unsigned*)(F.Y + t * 1024 + 512 + col) = (unsigned)f2bf(o[d] * rl * siluf(g0)) | ((unsigned)f2bf(o[d + 1] * rl * siluf(g1)) << 16);
        }
    }
    __syncthreads();
}

__device__ __forceinline__ void ph5_outproj(const Params& P, Frame& F) {
    const bf16_t* Y = F.Y; const float* W = P.w_out; const float* x = P.x; float* out = P.out;
    const float* ada_b = P.ada_b; const float* modp = F.modp;
    naive_gemm(F, TOK, DM, DM,
        [=](int m, int k) { return bf2f(Y[(size_t)m * 1024 + k]); },
        [=](int k, int n) { return W[(size_t)k * 1024 + n]; },
        [=](int m, int n, float v) {
            const int b = m / SEQ; float g = ada_b[2048 + n];
#pragma unroll
            for (int kq = 0; kq < 4; ++kq) g += modp[((size_t)kq * 16 + b) * 3072 + 2048 + n];
            out[(size_t)m * 1024 + n] = x[(size_t)m * 1024 + n] + g * v;
        });
}


namespace up {
using bf16x8 = __attribute__((ext_vector_type(8))) short;
using f32x16 = __attribute__((ext_vector_type(16))) float;
__device__ __forceinline__ float half_sum(float v) { auto rr = __builtin_amdgcn_permlane32_swap(__float_as_uint(v), __float_as_uint(v), false, false); return __uint_as_float(rr[0]) + __uint_as_float(rr[1]); }
__device__ __forceinline__ uint2 pack4(float a, float b, float c, float d) { uint2 r; r.x = att::cvtpk(a, b); r.y = att::cvtpk(c, d); return r; }
__device__ __forceinline__ float sumsq8(bf16x8 v) { float s = 0.f;
#pragma unroll
    for (int j = 0; j < 8; ++j) { const float a = bf2f((bf16_t)v[j]); s += a * a; } return s; }

__device__ __forceinline__ void p0_frag_weights(const Params& P, Frame& F) {
    const int gt = F.vb * NTHREADS + F.tid, NT = F.G * NTHREADS;
    for (int id = gt; id < 49152; id += NT) {
        float v[8]; bf16_t* dst;
        if (id < 24576) { const int l = id & 63, ks = (id >> 6) & 15, ti = id >> 10; const int n = (ti / 3) * 96 + (ti % 3) * 32 + (l & 31), k0 = ks * 16 + 8 * (l >> 5);
#pragma unroll
            for (int j = 0; j < 8; ++j) v[j] = P.g_q_lat[k0 + j] * P.w_uq[(size_t)(k0 + j) * 768 + n];
            dst = F.WUQ + (size_t)id * 8; }
        else if (id < 40960) { const int id2 = id - 24576; const int l = id2 & 63, ks = (id2 >> 6) & 7, ti = id2 >> 9; const int n = (ti >> 2) * 128 + (ti & 3) * 32 + (l & 31), k0 = ks * 16 + 8 * (l >> 5);
#pragma unroll
            for (int j = 0; j < 8; ++j) v[j] = P.g_kv_lat[k0 + j] * P.w_ukv[(size_t)(k0 + j) * 1024 + n];
            dst = F.WUKV + (size_t)id2 * 8; }
        else { const int id3 = id - 40960; const int l = id3 & 63, ks = (id3 >> 6) & 7, ti = id3 >> 9; const int gi = ti >> 2, d = (ti & 3) * 32 + (l & 31), k0 = ks * 16 + 8 * (l >> 5);
#pragma unroll
            for (int j = 0; j < 8; ++j) v[j] = P.pool_w[((size_t)gi * 128 + k0 + j) * 128 + d];
            dst = F.WPOOL + (size_t)id3 * 8; }
        uint4 o; o.x = pk2(v[0], v[1]); o.y = pk2(v[2], v[3]); o.z = pk2(v[4], v[5]); o.w = pk2(v[6], v[7]);
        *(uint4*)dst = o;
    }
}

__device__ __forceinline__ void q_job(const Params& P, Frame& F, int tg, int hq) {
    const int lane = F.lane, r32 = lane & 31, hi = lane >> 5;
    const int t = tg * 32 + r32, b = t / SEQ, s = t % SEQ;
    bf16x8 bq[16]; float ssq = 0.f;
#pragma unroll
    for (int ks = 0; ks < 16; ++ks) { bq[ks] = *reinterpret_cast<const bf16x8*>(F.QL + (size_t)t * 256 + ks * 16 + hi * 8); ssq += sumsq8(bq[ks]); }
    ssq = half_sum(ssq);
    const float rq = rsqrtf(ssq * (1.f / QLORA) + EPS);
    const float4 c0 = *(const float4*)(F.rope + (size_t)t * 32 + 4 * hi), c1 = *(const float4*)(F.rope + (size_t)t * 32 + 8 + 4 * hi);
    const float4 s0 = *(const float4*)(F.rope + (size_t)t * 32 + 16 + 4 * hi), s1 = *(const float4*)(F.rope + (size_t)t * 32 + 24 + 4 * hi);
    const float cs[8] = {c0.x, c0.y, c0.z, c0.w, c1.x, c1.y, c1.z, c1.w}, sn[8] = {s0.x, s0.y, s0.z, s0.w, s1.x, s1.y, s1.z, s1.w};
#pragma unroll 1
    for (int hh = 0; hh < 4; ++hh) {
        const int h = hq * 4 + hh;
        f32x16 acc[3] = {};
        const bf16_t* wf = F.WUQ + (size_t)(h * 3) * 16 * 512 + lane * 8;
#pragma unroll
        for (int i = 0; i < 3; ++i)
            {
#pragma unroll
              for (int ks = 0; ks < 16; ++ks) { const bf16x8 a = *reinterpret_cast<const bf16x8*>(wf + (size_t)(i * 16 + ks) * 512); acc[i] = __builtin_amdgcn_mfma_f32_32x32x16_bf16(a, bq[ks], acc[i], 0, 0, 0); if ((ks & 7) == 7) asm volatile("" ::: "memory"); } }
        float s2 = 0.f;
#pragma unroll
        for (int i = 0; i < 3; ++i)
#pragma unroll
            for (int r = 0; r < 16; ++r) { acc[i][r] *= rq; s2 += acc[i][r] * acc[i][r]; }
        s2 = half_sum(s2);
        const float rh = rsqrtf(s2 * (1.f / DQK) + EPS);
#pragma unroll
        for (int i = 0; i < 3; ++i)
#pragma unroll
            for (int rg = 0; rg < 4; ++rg) { const float4 g = *(const float4*)(P.g_qnorm + 32 * i + 8 * rg + 4 * hi);
                acc[i][4 * rg + 0] *= rh * g.x; acc[i][4 * rg + 1] *= rh * g.y; acc[i][4 * rg + 2] *= rh * g.z; acc[i][4 * rg + 3] *= rh * g.w; }
#pragma unroll
        for (int r = 0; r < 8; ++r) { const float x1 = acc[2][r], x2 = acc[2][r + 8]; acc[2][r] = x1 * cs[r] - x2 * sn[r]; acc[2][r + 8] = x2 * cs[r] + x1 * sn[r]; }
        bf16_t* qo = F.Q + ((size_t)(b * NH + h) * SEQ + s) * DQK + 4 * hi;
#pragma unroll
        for (int i = 0; i < 3; ++i)
#pragma unroll
            for (int rg = 0; rg < 4; ++rg) *(uint2*)(qo + 32 * i + 8 * rg) = pack4(acc[i][4 * rg], acc[i][4 * rg + 1], acc[i][4 * rg + 2], acc[i][4 * rg + 3]);
    }
}
__device__ __forceinline__ void kv_job(const Params& P, Frame& F, int tg, int hq) {
    const int lane = F.lane, r32 = lane & 31, hi = lane >> 5;
    const int t = tg * 32 + r32, b = t / SEQ, s = t % SEQ;
    bf16x8 bk[8]; float ssq = 0.f;
#pragma unroll
    for (int ks = 0; ks < 8; ++ks) { bk[ks] = *reinterpret_cast<const bf16x8*>(F.KVL + (size_t)t * 160 + ks * 16 + hi * 8); ssq += sumsq8(bk[ks]); }
    ssq = half_sum(ssq);
    const float rkv = rsqrtf(ssq * (1.f / KVLORA) + EPS);
    float kr[16]; float kr2 = 0.f;
#pragma unroll
    for (int rg = 0; rg < 4; ++rg) { const uint2 w = *(const uint2*)(F.KVL + (size_t)t * 160 + 128 + 8 * rg + 4 * hi);
        kr[4 * rg + 0] = __uint_as_float(w.x << 16); kr[4 * rg + 1] = __uint_as_float(w.x & 0xffff0000u); kr[4 * rg + 2] = __uint_as_float(w.y << 16); kr[4 * rg + 3] = __uint_as_float(w.y & 0xffff0000u); }
#pragma unroll
    for (int r = 0; r < 16; ++r) kr2 += kr[r] * kr[r];
    const float4 c0 = *(const float4*)(F.rope + (size_t)t * 32 + 4 * hi), c1 = *(const float4*)(F.rope + (size_t)t * 32 + 8 + 4 * hi);
    const float4 s0 = *(const float4*)(F.rope + (size_t)t * 32 + 16 + 4 * hi), s1 = *(const float4*)(F.rope + (size_t)t * 32 + 24 + 4 * hi);
    const float cs[8] = {c0.x, c0.y, c0.z, c0.w, c1.x, c1.y, c1.z, c1.w}, sn[8] = {s0.x, s0.y, s0.z, s0.w, s1.x, s1.y, s1.z, s1.w};
#pragma unroll 1
    for (int hh = 0; hh < 4; ++hh) {
        const int h = hq * 4 + hh;
        f32x16 acc[4] = {};
        const bf16_t* wf = F.WUKV + (size_t)(h * 4) * 8 * 512 + lane * 8;
#pragma unroll
        for (int i = 0; i < 4; ++i)
            {
#pragma unroll
              for (int ks = 0; ks < 8; ++ks) { const bf16x8 a = *reinterpret_cast<const bf16x8*>(wf + (size_t)(i * 8 + ks) * 512); acc[i] = __builtin_amdgcn_mfma_f32_32x32x16_bf16(a, bk[ks], acc[i], 0, 0, 0); } asm volatile("" ::: "memory"); }
        float s2 = kr2;
#pragma unroll
        for (int i = 0; i < 4; ++i)
#pragma unroll
            for (int r = 0; r < 16; ++r) { acc[i][r] *= rkv; if (i < 2) s2 += acc[i][r] * acc[i][r]; }
        s2 = half_sum(s2);
        const float rh = rsqrtf(s2 * (1.f / DQK) + EPS);
        bf16_t* ko = F.K + ((size_t)(b * NH + h) * SEQ + s) * DQK + 4 * hi;
#pragma unroll
        for (int i = 0; i < 2; ++i)
#pragma unroll
            for (int rg = 0; rg < 4; ++rg) { const float4 g = *(const float4*)(P.g_knorm + 32 * i + 8 * rg + 4 * hi);
                *(uint2*)(ko + 32 * i + 8 * rg) = pack4(acc[i][4 * rg] * rh * g.x, acc[i][4 * rg + 1] * rh * g.y, acc[i][4 * rg + 2] * rh * g.z, acc[i][4 * rg + 3] * rh * g.w); }
        float kn[16];
#pragma unroll
        for (int rg = 0; rg < 4; ++rg) { const float4 g = *(const float4*)(P.g_knorm + 64 + 8 * rg + 4 * hi);
            kn[4 * rg] = kr[4 * rg] * rh * g.x; kn[4 * rg + 1] = kr[4 * rg + 1] * rh * g.y; kn[4 * rg + 2] = kr[4 * rg + 2] * rh * g.z; kn[4 * rg + 3] = kr[4 * rg + 3] * rh * g.w; }
#pragma unroll
        for (int r = 0; r < 8; ++r) { const float x1 = kn[r], x2 = kn[r + 8]; kn[r] = x1 * cs[r] - x2 * sn[r]; kn[r + 8] = x2 * cs[r] + x1 * sn[r]; }
#pragma unroll
        for (int rg = 0; rg < 4; ++rg) *(uint2*)(ko + 64 + 8 * rg) = pack4(kn[4 * rg], kn[4 * rg + 1], kn[4 * rg + 2], kn[4 * rg + 3]);
        bf16_t* vo = F.V + ((size_t)(b * NH + h) * SEQ + s) * DV + 4 * hi;
#pragma unroll
        for (int i = 0; i < 2; ++i)
#pragma unroll
            for (int rg = 0; rg < 4; ++rg) *(uint2*)(vo + 32 * i + 8 * rg) = pack4(acc[2 + i][4 * rg], acc[2 + i][4 * rg + 1], acc[2 + i][4 * rg + 2], acc[2 + i][4 * rg + 3]);
    }
}
__device__ __forceinline__ void pool_job(const Params& P, Frame& F, int tg, int gi) {
    const int lane = F.lane, r32 = lane & 31, hi = lane >> 5;
    const int t = tg * 32 + r32, b = t / SEQ, s = t % SEQ, half = 1 << gi;
    const int lo = (s - half) > 0 ? (s - half) : 0, hi_ = (s + half) < SEQ ? (s + half) : SEQ;
    const float inv = 1.f / (float)(hi_ - lo);
    bf16x8 bd[8];
#pragma unroll
    for (int ks = 0; ks < 8; ++ks) {
        const int c0 = gi * 128 + ks * 16 + 8 * hi;
        float sum[8];
#pragma unroll
        for (int j = 0; j < 8; ++j) sum[j] = 0.f;
#pragma unroll 2
        for (int i = 0; i < 2 * half; ++i) { const int sp = s - half + i; const bool ok = (sp >= 0) && (sp < SEQ); const int spc = ok ? sp : s;
            const bf16x8 v = *reinterpret_cast<const bf16x8*>(F.UP + ((size_t)b * SEQ + spc) * 512 + c0);
#pragma unroll
            for (int j = 0; j < 8; ++j) sum[j] += ok ? bf2f((bf16_t)v[j]) : 0.f; }
        const bf16x8 own = *reinterpret_cast<const bf16x8*>(F.UP + (size_t)t * 512 + c0);
        float d[8];
#pragma unroll
        for (int j = 0; j < 8; ++j) d[j] = sum[j] * inv - bf2f((bf16_t)own[j]);
        uint4 w; w.x = att::cvtpk(d[0], d[1]); w.y = att::cvtpk(d[2], d[3]); w.z = att::cvtpk(d[4], d[5]); w.w = att::cvtpk(d[6], d[7]);
        bd[ks] = *reinterpret_cast<bf16x8*>(&w);
        asm volatile("" ::: "memory");
    }
    f32x16 acc[4] = {};
    const bf16_t* wf = F.WPOOL + (size_t)(gi * 4) * 8 * 512 + lane * 8;
#pragma unroll
    for (int i = 0; i < 4; ++i)
        {
#pragma unroll
          for (int ks = 0; ks < 8; ++ks) { const bf16x8 a = *reinterpret_cast<const bf16x8*>(wf + (size_t)(i * 8 + ks) * 512); acc[i] = __builtin_amdgcn_mfma_f32_32x32x16_bf16(a, bd[ks], acc[i], 0, 0, 0); } asm volatile("" ::: "memory"); }
#pragma unroll
    for (int i = 0; i < 4; ++i)
#pragma unroll
        for (int rg = 0; rg < 4; ++rg) { const int n = gi * 128 + 32 * i + 8 * rg + 4 * hi;
            const uint2 gw = *(const uint2*)(F.GP + (size_t)t * 512 + n); const float4 ps = *(const float4*)(P.pool_scale + n);
            const float g0 = __uint_as_float(gw.x << 16), g1 = __uint_as_float(gw.x & 0xffff0000u), g2 = __uint_as_float(gw.y << 16), g3 = __uint_as_float(gw.y & 0xffff0000u);
            *(uint2*)(F.Y + (size_t)t * 1024 + n) = pack4(acc[i][4 * rg] * ps.x * siluf(g0), acc[i][4 * rg + 1] * ps.y * siluf(g1), acc[i][4 * rg + 2] * ps.z * siluf(g2), acc[i][4 * rg + 3] * ps.w * siluf(g3)); }
}
__device__ __forceinline__ void ph3_mfma(const Params& P, Frame& F) {
    const int gw = F.vb * NWAVES + F.wave, NGW = F.G * NWAVES;
    for (int it = gw; it < 2048; it += NGW) q_job(P, F, it >> 1, it & 1);
    for (int it = gw; it < 2048; it += NGW) kv_job(P, F, it >> 1, it & 1);
    for (int it = gw; it < 2048; it += NGW) { const int tg = it >> 1; pool_job(P, F, tg, (it & 1) ? 1 : 0); pool_job(P, F, tg, (it & 1) ? 2 : 3); }
}
}

__device__ __forceinline__ void ph4_attn_mfma(const Params& P, Frame& F) {
    for (int u = F.vb; u < NB * NH * 8; u += F.G) {
        const int bh = u >> 3, qb = u & 7, b = bh / NH, h = bh % NH;
        const size_t t0 = (size_t)b * SEQ + qb * 256;
        att::attn_unit(F.Q + ((size_t)bh * SEQ + qb * 256) * DQK, F.K + (size_t)bh * SEQ * DQK, F.V + (size_t)bh * SEQ * DV,
                       F.GA + t0 * 512 + h * 64, F.Y + t0 * 1024 + 512 + h * 64, (LAS char*)F.lds);
    }
}

__global__ void __launch_bounds__(NTHREADS, 2) fwd_kernel(Params P) {
    extern __shared__ __attribute__((aligned(16))) unsigned char lds[];
    Frame F;
    F.lds = (LAS unsigned char*)lds;
    F.tid = threadIdx.x; F.lane = F.tid & 63; F.wave = __builtin_amdgcn_readfirstlane(F.tid >> 6);
    F.G = gridDim.x; { const int bx = blockIdx.x; F.vb = (F.G % 8 == 0) ? (bx % 8) * (F.G / 8) + bx / 8 : bx; }
    unsigned char* ws = P.ws;
    F.modp = (float*)(ws + WS_MODP); F.rope = (float*)(ws + WS_ROPE); F.gate = (float*)(ws + WS_GATE);
    F.WIN = (bf16_t*)(ws + WS_WIN); F.WUQ = (bf16_t*)(ws + WS_WUQ); F.WUKV = (bf16_t*)(ws + WS_WUKV); F.WPOOL = (bf16_t*)(ws + WS_WPOOL); F.WOUT = (bf16_t*)(ws + WS_WOUT);
    F.XN = (bf16_t*)(ws + WS_XN); F.UP = (bf16_t*)(ws + WS_UP); F.GP = (bf16_t*)(ws + WS_GP); F.GA = (bf16_t*)(ws + WS_GA);
    F.QL = (bf16_t*)(ws + WS_QL); F.KVL = (bf16_t*)(ws + WS_KVL); F.Q = (bf16_t*)(ws + WS_Q); F.K = (bf16_t*)(ws + WS_K); F.V = (bf16_t*)(ws + WS_V); F.Y = (bf16_t*)(ws + WS_Y);
    volatile LAS unsigned* MISC = (volatile LAS unsigned*)(F.lds + MISC_OFF);
    for (int u = F.tid; u < (LDS_BYTES - LDSCTL_OFF) / 4; u += NTHREADS) ((LAS unsigned*)(F.lds + LDSCTL_OFF))[u] = 0u;
    __syncthreads();
    const int lo = P.ph_lo, hi = P.ph_hi;
    XcdBarrier bar; bar.bar = (unsigned*)(ws + WS_CTL) + CW_BAR; bar.x = 0; bar.st = nullptr;
    if (hi - lo > 1) bar = xcd_barrier_post((unsigned*)(ws + WS_CTL) + CW_BAR, MISC + 8);
#define IN(k) (lo <= (k) && (k) < hi)
#define SEAM(k) do { if (IN(k) && IN((k) + 1)) xcd_barrier(bar); } while (0)
    if (IN(0)) { ph0_mod(P, F); ph0_weights(P, F); up::p0_frag_weights(P, F); } SEAM(0);
    if (IN(1)) { ph1_xn(P, F); } SEAM(1);
    if (IN(2)) { pg8::Gemm g{F.XN, F.WIN, TOK, 2048, DM}; pg8::StaticOrder S; S.init(TOK, 2048, F.G, (int)blockIdx.x);
        pg8::EpiInProj E{F.UP, F.GP, F.GA, F.QL, F.KVL};
        pg8::gemm_phase<pg8::EpiInProj, pg8::StaticOrder, true, true>(F.lds, g, S, E); } SEAM(2);
    if (IN(3)) { up::ph3_mfma(P, F); } SEAM(3);
    if (IN(4)) { ph4_attn_mfma(P, F); } SEAM(4);
    if (IN(5)) { pg8::Gemm g{F.Y, F.WOUT, TOK, DM, DM}; pg8::StaticOrder S; S.init(TOK, DM, F.G, (int)blockIdx.x);
        pg8::EpiOut E{P.x, F.gate, P.out};
        pg8::gemm_phase<pg8::EpiOut, pg8::StaticOrder, true, true>(F.lds, g, S, E); }
#undef IN
#undef SEAM
}

extern "C" void kernel_launch(void* const* d_in, const int* in_sizes, int n_in, void* d_out, int out_size, void* d_ws, size_t ws_size, hipStream_t stream) {
    static int grid = 0;
    if (grid == 0) {
        if (n_in != 16 || in_sizes[0] != TOK * DM || out_size != TOK * DM || ws_size < WS_END) {
            fprintf(stderr, "kernel_launch: shape mismatch: n_in %d in0 %d out %d ws %zu\n", n_in, n_in > 0 ? in_sizes[0] : -1, out_size, ws_size); grid = -1; return; }
        int dev = 0, cus = 0, per_cu = 0;
        if (hipGetDevice(&dev) != hipSuccess || hipDeviceGetAttribute(&cus, hipDeviceAttributeMultiprocessorCount, dev) != hipSuccess) { grid = -1; return; }
        if (hipFuncSetAttribute((const void*)fwd_kernel, hipFuncAttributeMaxDynamicSharedMemorySize, LDS_BYTES) != hipSuccess) { fprintf(stderr, "kernel_launch: hipFuncSetAttribute failed\n"); grid = -1; return; }
        if (hipOccupancyMaxActiveBlocksPerMultiprocessor(&per_cu, (const void*)fwd_kernel, NTHREADS, LDS_BYTES) != hipSuccess || per_cu < 1) {
            fprintf(stderr, "kernel_launch: occupancy query reports %d blocks per CU\n", per_cu); (void)hipGetLastError(); grid = -1; return; }
        grid = cus;
    }
    if (grid < 0) return;
    (void)hipMemsetAsync((char*)d_ws + WS_CTL, 0, CTL_ZERO_BYTES, stream);
    Params p{};
    p.x = (const float*)d_in[0]; p.c = (const float*)d_in[1]; p.pos = (const int*)d_in[2]; p.ada_w = (const float*)d_in[3]; p.ada_b = (const float*)d_in[4];
    p.norm_g = (const float*)d_in[5]; p.w_in = (const float*)d_in[6]; p.pool_w = (const float*)d_in[7]; p.pool_scale = (const float*)d_in[8];
    p.g_q_lat = (const float*)d_in[9]; p.w_uq = (const float*)d_in[10]; p.g_kv_lat = (const float*)d_in[11]; p.w_ukv = (const float*)d_in[12];
    p.g_qnorm = (const float*)d_in[13]; p.g_knorm = (const float*)d_in[14]; p.w_out = (const float*)d_in[15];
    p.out = (float*)d_out; p.ws = (unsigned char*)d_ws;
    if (MK_N_LAUNCHES == 1) {
        p.ph_lo = 0; p.ph_hi = N_PHASES;
        hipLaunchKernelGGL(fwd_kernel, dim3(grid), dim3(NTHREADS), LDS_BYTES, stream, p);
    } else {
        for (int k = 0; k < N_PHASES; ++k) { p.ph_lo = k; p.ph_hi = k + 1; hipLaunchKernelGGL(fwd_kernel, dim3(grid), dim3(NTHREADS), LDS_BYTES, stream, p); }
    }
    const hipError_t le = hipPeekAtLastError();
    if (le != hipSuccess) fprintf(stderr, "kernel_launch: launch failed: %s\n", hipGetErrorName(le));
}
```

```cpp
#include <hip/hip_runtime.h>
#include <cstdio>
#include <cstdint>

#ifndef MK_N_LAUNCHES
#define MK_N_LAUNCHES 1
#endif

#define GAS __attribute__((address_space(1)))
#define LAS __attribute__((address_space(3)))
typedef unsigned short bf16_t;

constexpr int DM = 1024, NB = 16, SEQ = 2048, TOK = NB * SEQ;
constexpr int NH = 8, DQK = 96, DNOPE = 64, DROPE = 32, DV = 64, QLORA = 256, KVLORA = 128, INW = 1952;
constexpr int OFF_UP = 0, OFF_GP = 512, OFF_QL = 1024, OFF_KVL = 1280, OFF_KR = 1408, OFF_GA = 1440;
constexpr float EPS = 1e-6f;
constexpr int NTHREADS = 512, NWAVES = 8;
constexpr int N_PHASES = 6;

constexpr size_t MiB = 1u << 20;
constexpr size_t WS_CTL = 0, CTL_ZERO_BYTES = 1 * MiB;
constexpr size_t WS_MODP = 1 * MiB;
constexpr size_t WS_ROPE = 2 * MiB;
constexpr size_t WS_GATE = 1 * MiB + 786432;
constexpr size_t WS_WIN = 6 * MiB;
constexpr size_t WS_WUQ = 10 * MiB;
constexpr size_t WS_WUKV = 11 * MiB;
constexpr size_t WS_WPOOL = 12 * MiB;
constexpr size_t WS_WOUT = 13 * MiB;
constexpr size_t WS_XN = 16 * MiB;
constexpr size_t WS_UP = 80 * MiB;
constexpr size_t WS_GP = 112 * MiB;
constexpr size_t WS_GA = 144 * MiB;
constexpr size_t WS_QL = 176 * MiB;
constexpr size_t WS_KVL = 192 * MiB;
constexpr size_t WS_Q = 208 * MiB;
constexpr size_t WS_K = 256 * MiB;
constexpr size_t WS_V = 304 * MiB;
constexpr size_t WS_Y = 336 * MiB;
constexpr size_t WS_END = 400 * MiB;
constexpr int CW_BAR = 4096;

constexpr int RING_BYTES = 143360;
constexpr int LDSCTL_OFF = RING_BYTES, MISC_OFF = LDSCTL_OFF + 320;
constexpr int LDS_BYTES = 147456;

__device__ const float INVF[16] = {1.0f, 0.5623413251903491f, 0.31622776601683794f, 0.1778279410038923f, 0.1f, 0.05623413251903491f, 0.03162277660168379f,
                                   0.01778279410038923f, 0.01f, 0.005623413251903491f, 0.003162277660168379f, 0.001778279410038923f, 0.001f,
                                   0.0005623413251903491f, 0.00031622776601683794f, 0.0001778279410038923f};

__device__ __forceinline__ float bf2f(bf16_t v) { return __uint_as_float(((unsigned)v) << 16); }
__device__ __forceinline__ bf16_t f2bf(float f) { unsigned u = __float_as_uint(f); return (bf16_t)((u + 0x7fffu + ((u >> 16) & 1u)) >> 16); }
__device__ __forceinline__ float siluf(float v) { return v / (1.f + __expf(-v)); }
__device__ __forceinline__ float wave_sum(float v) {
#pragma unroll
    for (int o = 1; o < 64; o <<= 1) v += __shfl_xor(v, o);
    return v;
}

struct Params {
    const float *x, *c; const int* pos; const float *ada_w, *ada_b, *norm_g, *w_in, *pool_w, *pool_scale, *g_q_lat, *w_uq, *g_kv_lat, *w_ukv, *g_qnorm, *g_knorm, *w_out;
    float* out; unsigned char* ws; int ph_lo, ph_hi;
};

#define XB_TMO      128
#define XB_XCNT(j)  (256  + 64 * (j))
#define XB_XSUB(j)  (1280 + 64 * (j))
#define XB_XGEN(j)  (2304 + 64 * (j))
#define XB_TOP      3328
#define XB_TOPGEN   3392
#define XCD_BAR_WORDS 3456
#define XB_SPIN_CAP (1u << 22)
__device__ __forceinline__ unsigned xb_ld(unsigned* p)              { return __hip_atomic_load(p, __ATOMIC_RELAXED, __HIP_MEMORY_SCOPE_AGENT); }
__device__ __forceinline__ unsigned xb_add(unsigned* p, unsigned v) { return __hip_atomic_fetch_add(p, v, __ATOMIC_RELAXED, __HIP_MEMORY_SCOPE_AGENT); }
__device__ __forceinline__ unsigned xb_xcc_id() { return (unsigned)__builtin_amdgcn_s_getreg((3 << 11) | 20) & 0xFu; }
#define XB_SPIN(cond, bar) do { unsigned _sp = 0; while (cond) { __builtin_amdgcn_s_sleep(1); \
    if ((++_sp & 255u) == 0u) { if (xb_ld(&(bar)[XB_TMO])) break; if (_sp > XB_SPIN_CAP) { atomicAdd(&(bar)[XB_TMO], 1u); break; } } } } while (0)
struct XcdBarrier { unsigned* bar; unsigned x; volatile LAS unsigned* st; };
__device__ __forceinline__ XcdBarrier xcd_barrier_post(unsigned* bar, volatile LAS unsigned* st) {
    XcdBarrier b; b.bar = bar; b.x = xb_xcc_id(); b.st = st;
    if (threadIdx.x == 0) (void)xb_add(&bar[XB_XCNT(b.x)], 1u);
    return b;
}
__device__ __forceinline__ void xcd_barrier_complete(unsigned* bar, unsigned x, unsigned& nloc, unsigned& nx) {
    const unsigned G = gridDim.x * gridDim.y * gridDim.z;
    unsigned sum, cnt, mine, sp = 0u;
    for (;;) {
        sum = 0u; cnt = 0u; mine = 0u;
#pragma unroll
        for (unsigned j = 0; j < 16; ++j) { const unsigned c = xb_ld(&bar[XB_XCNT(j)]); sum += c; cnt += (c > 0u) ? 1u : 0u; mine = (j == x) ? c : mine; }
        if (sum == G) break;
        __builtin_amdgcn_s_sleep(1);
        if ((++sp & 255u) == 0u) { if (xb_ld(&bar[XB_TMO])) break; if (sp > XB_SPIN_CAP) { atomicAdd(&bar[XB_TMO], 1u); break; } }
    }
    nloc = mine > 0u ? mine : 1u; nx = cnt > 0u ? cnt : 1u;
}
__device__ __forceinline__ void xcd_barrier(const XcdBarrier& b) {
    asm volatile("s_waitcnt vmcnt(0)" ::: "memory");
    __syncthreads();
    if (threadIdx.x == 0) {
        unsigned* bar = b.bar;
        __builtin_amdgcn_s_waitcnt(0);
        unsigned nloc = b.st[0], nx = b.st[1];
        if (nloc == 0u) { xcd_barrier_complete(bar, b.x, nloc, nx); b.st[0] = nloc; b.st[1] = nx; }
        const unsigned old = xb_add(&bar[XB_XSUB(b.x)], 1u);
        const unsigned gen = old / nloc;
        if (old + 1u == (gen + 1u) * nloc) {
            __builtin_amdgcn_fence(__ATOMIC_RELEASE, "agent");
            asm volatile("s_waitcnt vmcnt(0)" ::: "memory");
            const unsigned og = xb_add(&bar[XB_TOP], 1u);
            const unsigned tg = og / nx;
            if (og + 1u == (tg + 1u) * nx) xb_add(&bar[XB_TOPGEN], 1u);
            else XB_SPIN(xb_ld(&bar[XB_TOPGEN]) == tg, bar);
            __builtin_amdgcn_fence(__ATOMIC_ACQUIRE, "agent");
            xb_add(&bar[XB_XGEN(b.x)], 1u);
            asm volatile("s_waitcnt vmcnt(0)" ::: "memory");
        } else {
            XB_SPIN(xb_ld(&bar[XB_XGEN(b.x)]) == gen, bar);
            __builtin_amdgcn_fence(__ATOMIC_ACQUIRE, "agent");
            asm volatile("s_waitcnt vmcnt(0)" ::: "memory");
        }
    }
    __syncthreads();
}


namespace pg8 {
#define PG8_LAS __attribute__((address_space(3)))
typedef short bf16x8 __attribute__((ext_vector_type(8)));
typedef float f32x4 __attribute__((ext_vector_type(4)));
typedef unsigned u32x4 __attribute__((ext_vector_type(4)));
constexpr int BM = 256, BK = 64, HALF = 128, HTB = HALF * BK * 2, STAGE_BYTES = 8 * HTB, NXCD = 8, WGM = 8;
__host__ __device__ __forceinline__ int lds_byte(int r, int c) { const int st = (r >> 4) * 2 + (c >> 5), rr = r & 15, cc = c & 31, ob = rr * 64 + cc * 2; return st * 1024 + (ob ^ (((ob >> 9) & 1) << 5)); }
__host__ __device__ __forceinline__ void stage_rc(int b, int& R, int& C) { const int st = b / 1024, sb = b % 1024, swz = sb ^ (((sb >> 9) & 1) << 5); R = (st >> 1) * 16 + swz / 64; C = (st & 1) * 32 + (swz % 64) / 2; }
__host__ __device__ __forceinline__ int perm32(int rho) { const int n = rho >> 4, i = rho & 15; return 8 * (i >> 2) + 4 * n + (i & 3); }
struct Unit { int pm, pn; };
struct Gemm { const bf16_t* A; const bf16_t* Bt; int M, N, K; };
struct StaticOrder {
    int nM, nN, nwg, G, c;
    __host__ __device__ void init(int M, int N, int G_, int c_) { nM = M / BM; nN = N / BM; nwg = nM * nN; G = G_; c = c_; }
    __host__ __device__ bool next(int i, Unit& u) const {
        const long L = (long)i * G + c; if (L >= nwg) return false;
        int wgid = (int)L; { const int q = nwg / NXCD, r = nwg % NXCD, xcd = wgid % NXCD, off = wgid / NXCD; wgid = (xcd < r ? xcd * (q + 1) : r * (q + 1) + (xcd - r) * q) + off; }
        const int nig = WGM * nN, gid = wgid / nig, fm = gid * WGM, gsz = (nM - fm) < WGM ? (nM - fm) : WGM;
        u.pm = fm + ((wgid % nig) % gsz); u.pn = (wgid % nig) / gsz; return true;
    }
    __device__ __forceinline__ void a_ready(const Unit&) const {}
    __device__ __forceinline__ void done(const Unit&) const {}
};
__device__ __forceinline__ unsigned cvt_pk_bf16(float lo, float hi) { unsigned r; asm volatile("v_cvt_pk_bf16_f32 %0, %1, %2" : "=v"(r) : "v"(lo), "v"(hi)); return r; }

struct EpiInProj {
    static constexpr bool PERM = true, AFTER_DRAIN = false;
    bf16_t *UP, *GP, *GA, *QL, *KVL;
    __device__ __forceinline__ void operator()(const f32x4 (&acc)[2][2][4][2], const Unit& u, int wr, int wc, int fr, int fq) const {
        const int row0 = u.pm * BM + wr * 64 + fr;
        bf16_t* base; int ldc, ncols = 256;
        switch (u.pn) {
            case 0: base = UP; ldc = 512; break;       case 1: base = UP + 256; ldc = 512; break;
            case 2: base = GP; ldc = 512; break;       case 3: base = GP + 256; ldc = 512; break;
            case 4: base = GA; ldc = 512; break;       case 5: base = GA + 256; ldc = 512; break;
            case 6: base = QL; ldc = 256; break;       default: base = KVL; ldc = 160; ncols = 160; break;
        }
        const int col0 = wc * 32 + 8 * fq;
#pragma unroll
        for (int ai = 0; ai < 2; ++ai)
#pragma unroll
            for (int m = 0; m < 4; ++m) { bf16_t* rowp = base + (size_t)(row0 + ai * HALF + m * 16) * ldc + col0;
#pragma unroll
                for (int bj = 0; bj < 2; ++bj) { const f32x4 v0 = acc[ai][bj][m][0], v1 = acc[ai][bj][m][1];
                    u32x4 w; w.x = cvt_pk_bf16(v0[0], v0[1]); w.y = cvt_pk_bf16(v0[2], v0[3]); w.z = cvt_pk_bf16(v1[0], v1[1]); w.w = cvt_pk_bf16(v1[2], v1[3]);
                    if (col0 + bj * HALF < ncols) *(u32x4*)(rowp + bj * HALF) = w; } }
    }
};
struct EpiOut {
    static constexpr bool PERM = false, AFTER_DRAIN = false;
    const float* x; const float* gate; float* out;
    __device__ __forceinline__ void operator()(const f32x4 (&acc)[2][2][4][2], const Unit& u, int wr, int wc, int fr, int fq) const {
        const int col0 = u.pn * BM + wc * 32 + 4 * fq; const int b = (u.pm * BM) / SEQ;
        f32x4 gv[2][2];
#pragma unroll
        for (int bj = 0; bj < 2; ++bj)
#pragma unroll
            for (int n = 0; n < 2; ++n) gv[bj][n] = *(const f32x4*)(gate + (size_t)b * 1024 + col0 + bj * HALF + n * 16);
#pragma unroll
        for (int ai = 0; ai < 2; ++ai)
#pragma unroll
            for (int m = 0; m < 4; ++m) { const size_t off = (size_t)(u.pm * BM + ai * HALF + wr * 64 + m * 16 + fr) * 1024 + col0;
#pragma unroll
                for (int bj = 0; bj < 2; ++bj)
#pragma unroll
                    for (int n = 0; n < 2; ++n) { const f32x4 xs = *(const f32x4*)(x + off + bj * HALF + n * 16);
                        *(f32x4*)(out + off + bj * HALF + n * 16) = xs + gv[bj][n] * acc[ai][bj][m][n]; }
                if (m & 1) asm volatile("" ::: "memory"); }
    }
};

template <class Epi, class Sched, bool ALIGN_EPI = false, bool SP2 = false>
__device__ __forceinline__ void gemm_phase(PG8_LAS unsigned char* lds, const Gemm g, const Sched& S, const Epi& E) {
    const int tid = threadIdx.x, wid = __builtin_amdgcn_readfirstlane(tid >> 6), lane = tid & 63, wr = wid >> 2, wc = wid & 3, fr = lane & 15, fq = lane >> 4;
    const int K = g.K, nt = K / BK;
    unsigned voffA[2], voffB[2];
#pragma unroll
    for (int i = 0; i < 2; ++i) { int R, C; stage_rc(tid * 16 + i * 8192, R, C); const int Rb = Epi::PERM ? ((R & ~31) + perm32(R & 31)) : R;
        voffA[i] = (unsigned)(R * K + C) * 2u; voffB[i] = (unsigned)(Rb * K + C) * 2u; }
    const size_t kstep = (size_t)(BK * 2);
    const size_t hstep = (size_t)HALF * K * 2;
    const size_t tstep = 2 * hstep;
    const unsigned ldsw = (unsigned)wid * 1024u;
    const int aoff = lds_byte(wr * 64 + fr, fq * 8), boff = lds_byte(wc * 32 + fr, fq * 8);
#define PG8_SA(b, h) (((b) * 2 + (h)) * HTB)
#define PG8_SB(b, h) ((4 + (b) * 2 + (h)) * HTB)
#define PG8_STAGE(bufoff, gbase, voff) do { _Pragma("unroll") for (int _i = 0; _i < 2; ++_i) \
        __builtin_amdgcn_global_load_lds((const unsigned*)((const char*)(gbase) + (voff)[_i]), (PG8_LAS unsigned*)(lds + (bufoff) + ldsw + _i * 8192), 16, 0, 0); } while (0)
#define PG8_LDA(dst, b, h) do { _Pragma("unroll") for (int m = 0; m < 4; ++m) _Pragma("unroll") for (int k = 0; k < 2; ++k) dst[m][k] = *(const PG8_LAS bf16x8*)(lds + PG8_SA(b, h) + aoff + m * 2048 + k * 1024); } while (0)
#define PG8_LDB(dst, b, h) do { _Pragma("unroll") for (int n = 0; n < 2; ++n) _Pragma("unroll") for (int k = 0; k < 2; ++k) dst[n][k] = *(const PG8_LAS bf16x8*)(lds + PG8_SB(b, h) + boff + n * 2048 + k * 1024); } while (0)
#define PG8_MMA(ai, bj, At, Bt) do { __builtin_amdgcn_s_setprio(1); _Pragma("unroll") for (int m = 0; m < 4; ++m) _Pragma("unroll") for (int n = 0; n < 2; ++n) _Pragma("unroll") for (int k = 0; k < 2; ++k) \
        acc[ai][bj][m][n] = __builtin_amdgcn_mfma_f32_16x16x32_bf16(Bt[n][k], At[m][k], acc[ai][bj][m][n], 0, 0, 0); __builtin_amdgcn_s_setprio(0); } while (0)
#define PG8_WAIT_V(n) asm volatile("s_waitcnt vmcnt(" #n ")" ::: "memory")
#define PG8_WAIT_L(n) asm volatile("s_waitcnt lgkmcnt(" #n ")" ::: "memory")
#define PG8_BAR __builtin_amdgcn_s_barrier()
#define PG8_SCHED __builtin_amdgcn_sched_barrier(0)
    Unit cur, nxt; int ui = 0;
    if (!S.next(0, cur)) return;
    f32x4 acc[2][2][4][2];
#pragma unroll
    for (int a = 0; a < 2; ++a)
#pragma unroll
        for (int b = 0; b < 2; ++b)
#pragma unroll
            for (int m = 0; m < 4; ++m)
#pragma unroll
                for (int n = 0; n < 2; ++n) acc[a][b][m][n] = (f32x4){0.f, 0.f, 0.f, 0.f};
    bf16x8 At[4][2], B0[2][2], B1[2][2];
    const char* cA = (const char*)g.A + (size_t)cur.pm * tstep; const char* cB = (const char*)g.Bt + (size_t)cur.pn * tstep;
    S.a_ready(cur);
    if constexpr (SP2) {
        PG8_STAGE(PG8_SB(0, 0), cB, voffB); PG8_STAGE(PG8_SB(0, 1), cB + hstep, voffB); PG8_STAGE(PG8_SA(0, 0), cA, voffA); PG8_STAGE(PG8_SA(0, 1), cA + hstep, voffA);
        if (wr == 1) PG8_BAR;
        PG8_WAIT_V(2); PG8_BAR;
        PG8_STAGE(PG8_SB(1, 0), cB + kstep, voffB); PG8_STAGE(PG8_SA(1, 0), cA + kstep, voffA); PG8_STAGE(PG8_SB(1, 1), cB + hstep + kstep, voffB);
        PG8_WAIT_V(6); PG8_BAR;
    } else {
        PG8_STAGE(PG8_SB(0, 0), cB, voffB); PG8_STAGE(PG8_SA(0, 0), cA, voffA); PG8_STAGE(PG8_SB(0, 1), cB + hstep, voffB); PG8_STAGE(PG8_SA(0, 1), cA + hstep, voffA);
        if (wr == 1) PG8_BAR;
        PG8_WAIT_V(4); PG8_BAR;
        PG8_STAGE(PG8_SB(1, 0), cB + kstep, voffB); PG8_STAGE(PG8_SA(1, 0), cA + kstep, voffA); PG8_STAGE(PG8_SB(1, 1), cB + hstep + kstep, voffB);
        PG8_WAIT_V(6); PG8_BAR;
    }
    for (;;) {
        const bool has_next = S.next(ui + 1, nxt);
        const char* nA = has_next ? (const char*)g.A + (size_t)nxt.pm * tstep : cA; const char* nB = has_next ? (const char*)g.Bt + (size_t)nxt.pn * tstep : cB;
        for (int t = 0; t < nt; t += 2) {
            const bool last = (t == nt - 2);
            const char* a1 = cA + (size_t)(t + 1) * kstep;
            const char* a2 = last ? nA : cA + (size_t)(t + 2) * kstep; const char* b2 = last ? nB : cB + (size_t)(t + 2) * kstep;
            const char* a3 = a2 + kstep; const char* b3 = b2 + kstep;
            if (last && has_next) S.a_ready(nxt);
            if constexpr (SP2) {
            PG8_LDB(B0, 0, 0); PG8_LDB(B1, 0, 1); PG8_SCHED; PG8_LDA(At, 0, 0); PG8_STAGE(PG8_SA(1, 1), a1 + hstep, voffA);
            PG8_WAIT_V(8); PG8_WAIT_L(0); PG8_BAR; PG8_MMA(0, 0, At, B0); PG8_MMA(0, 1, At, B1); PG8_BAR; PG8_SCHED;
            PG8_LDA(At, 0, 1); PG8_STAGE(PG8_SB(0, 0), b2, voffB); PG8_STAGE(PG8_SB(0, 1), b2 + hstep, voffB); PG8_STAGE(PG8_SA(0, 0), a2, voffA);
            PG8_WAIT_V(8); PG8_WAIT_L(0); PG8_BAR; PG8_MMA(1, 0, At, B0); PG8_MMA(1, 1, At, B1); PG8_BAR; PG8_SCHED;
            PG8_LDB(B0, 1, 0); PG8_LDB(B1, 1, 1); PG8_SCHED; PG8_LDA(At, 1, 0); PG8_STAGE(PG8_SA(0, 1), a2 + hstep, voffA);
            PG8_WAIT_V(8); PG8_WAIT_L(0); PG8_BAR; PG8_MMA(0, 0, At, B0); PG8_MMA(0, 1, At, B1); PG8_BAR; PG8_SCHED;
            PG8_LDA(At, 1, 1); PG8_STAGE(PG8_SB(1, 0), b3, voffB); PG8_STAGE(PG8_SB(1, 1), b3 + hstep, voffB); PG8_STAGE(PG8_SA(1, 0), a3, voffA);
            PG8_WAIT_V(8); PG8_WAIT_L(0); PG8_BAR; PG8_MMA(1, 0, At, B0); PG8_MMA(1, 1, At, B1); PG8_BAR; PG8_SCHED;
            } else {
            PG8_LDB(B0, 0, 0); PG8_SCHED; PG8_LDA(At, 0, 0); PG8_STAGE(PG8_SA(1, 1), a1 + hstep, voffA);
            PG8_WAIT_L(8); PG8_BAR; PG8_WAIT_L(0); PG8_MMA(0, 0, At, B0); PG8_BAR; PG8_SCHED;
            PG8_LDB(B1, 0, 1); PG8_STAGE(PG8_SB(0, 0), b2, voffB);
            PG8_BAR; PG8_WAIT_L(0); PG8_MMA(0, 1, At, B1); PG8_BAR;
            PG8_LDA(At, 0, 1); PG8_STAGE(PG8_SA(0, 0), a2, voffA);
            PG8_BAR; PG8_WAIT_L(0); PG8_MMA(1, 0, At, B0); PG8_BAR; PG8_SCHED;
            PG8_STAGE(PG8_SB(0, 1), b2 + hstep, voffB);
            PG8_WAIT_V(6); PG8_BAR; PG8_MMA(1, 1, At, B1); PG8_BAR;
            PG8_LDB(B0, 1, 0); PG8_SCHED; PG8_LDA(At, 1, 0); PG8_STAGE(PG8_SA(0, 1), a2 + hstep, voffA);
            PG8_WAIT_L(8); PG8_BAR; PG8_WAIT_L(0); PG8_MMA(0, 0, At, B0); PG8_BAR; PG8_SCHED;
            PG8_LDB(B1, 1, 1); PG8_STAGE(PG8_SB(1, 0), b3, voffB);
            PG8_BAR; PG8_WAIT_L(0); PG8_MMA(0, 1, At, B1); PG8_BAR;
            PG8_LDA(At, 1, 1); PG8_STAGE(PG8_SA(1, 0), a3, voffA);
            PG8_BAR; PG8_WAIT_L(0); PG8_MMA(1, 0, At, B0); PG8_BAR; PG8_SCHED;
            PG8_STAGE(PG8_SB(1, 1), b3 + hstep, voffB);
            PG8_WAIT_V(6); PG8_BAR; PG8_MMA(1, 1, At, B1); PG8_BAR;
            }
        }
        if constexpr (ALIGN_EPI) { if (wr == 0) PG8_BAR; }
        if constexpr (!Epi::AFTER_DRAIN) { E(acc, cur, wr, wc, fr, fq); S.done(cur); }
        if (!has_next) break;
#pragma unroll
        for (int a = 0; a < 2; ++a)
#pragma unroll
            for (int b = 0; b < 2; ++b)
#pragma unroll
                for (int m = 0; m < 4; ++m)
#pragma unroll
                    for (int n = 0; n < 2; ++n) acc[a][b][m][n] = (f32x4){0.f, 0.f, 0.f, 0.f};
        cur = nxt; cA = nA; cB = nB; ++ui;
        if constexpr (ALIGN_EPI) { if (wr == 1) PG8_BAR; }
    }
    PG8_WAIT_V(0);
    if constexpr (!ALIGN_EPI) { if (wr == 0) PG8_BAR; }
    PG8_BAR;
#undef PG8_SA
#undef PG8_SB
#undef PG8_STAGE
#undef PG8_LDA
#undef PG8_LDB
#undef PG8_MMA
#undef PG8_WAIT_V
#undef PG8_WAIT_L
#undef PG8_BAR
#undef PG8_SCHED
}
}


namespace att {
using bf16x8 = __attribute__((ext_vector_type(8))) short;
using s16x4  = __attribute__((ext_vector_type(4))) short;
using f32x16 = __attribute__((ext_vector_type(16))) float;
using u32x4  = __attribute__((ext_vector_type(4))) unsigned;
constexpr int NW = 8, QBLK = 32, KVBLK = 64;
constexpr float SCALE = 0.10206207261596577f;
constexpr float THR = 8.f;
constexpr int SHM_V = 16384, SHM_K = 16384, SHM_ATTN = 2 * SHM_V + 2 * SHM_K + NW * 64 * 4;
#define KSWZ(row, colB) ((row) * 256 + ((colB) ^ (((row) & 7) << 4)))
#define SBAR() __builtin_amdgcn_sched_barrier(0)
__device__ __forceinline__ int crow(int r, int hi) { return (r & 3) + 8 * (r >> 2) + 4 * hi; }
__device__ __forceinline__ unsigned cvtpk(float lo, float hi) { unsigned r; asm volatile("v_cvt_pk_bf16_f32 %0, %1, %2" : "=v"(r) : "v"(lo), "v"(hi)); return r; }
__device__ __forceinline__ void partialSM(f32x16& p0, f32x16& p1, float& m_reg, float& mn, float& alpha) {
  constexpr float C = SCALE * 1.4426950408889634f;
  float pmax = p0[0]; for (int r = 1; r < 16; ++r) pmax = fmaxf(pmax, p0[r]); for (int r = 0; r < 16; ++r) pmax = fmaxf(pmax, p1[r]);
  { auto rr = __builtin_amdgcn_permlane32_swap(__float_as_uint(pmax), __float_as_uint(pmax), false, false);
    pmax = fmaxf(__uint_as_float(rr[0]), __uint_as_float(rr[1])); }
  if (__builtin_expect(__all(pmax - m_reg <= THR / SCALE), 1)) { mn = m_reg; alpha = 1.f; }
  else { mn = fmaxf(m_reg, pmax); alpha = __builtin_amdgcn_exp2f((m_reg - mn) * C); m_reg = mn; }
  float mnC = -mn * C;
  for (int r = 0; r < 16; ++r) p0[r] = fmaf(p0[r], C, mnC); for (int r = 0; r < 16; ++r) p1[r] = fmaf(p1[r], C, mnC);
  for (int r = 0; r < 16; ++r) p0[r] = __builtin_amdgcn_exp2f(p0[r]);
}
__device__ __forceinline__ void finishSM(f32x16& p0, f32x16& p1, float alpha, float& l_reg, bf16x8& pa0, bf16x8& pa1, bf16x8& pa2, bf16x8& pa3) {
  for (int r = 0; r < 16; ++r) p1[r] = __builtin_amdgcn_exp2f(p1[r]);
  float ps = 0; for (int r = 0; r < 16; ++r) ps += p0[r]; for (int r = 0; r < 16; ++r) ps += p1[r];
  { auto rr = __builtin_amdgcn_permlane32_swap(__float_as_uint(ps), __float_as_uint(ps), false, false);
    ps = __uint_as_float(rr[0]) + __uint_as_float(rr[1]); }
  l_reg = l_reg * alpha + ps;
#define PK4(P, BASE, OUT) do { unsigned a0 = cvtpk(P[BASE + 0], P[BASE + 1]), a1 = cvtpk(P[BASE + 2], P[BASE + 3]);   \
    unsigned b0 = cvtpk(P[BASE + 4], P[BASE + 5]), b1 = cvtpk(P[BASE + 6], P[BASE + 7]);                              \
    auto r0 = __builtin_amdgcn_permlane32_swap(a0, b0, false, false); auto r1 = __builtin_amdgcn_permlane32_swap(a1, b1, false, false); \
    u32x4 w = {r0[0], r1[0], r0[1], r1[1]}; OUT = *reinterpret_cast<bf16x8*>(&w); } while (0)
  PK4(p0, 0, pa0); PK4(p0, 8, pa1); PK4(p1, 0, pa2); PK4(p1, 8, pa3);
#undef PK4
}
__device__ __forceinline__ void qkt(f32x16& p0, f32x16& p1, const LAS char* Ks, const bf16x8* qr, int r32, int hi) {
  p0 = f32x16{}; p1 = f32x16{};
#pragma unroll
  for (int d0 = 0; d0 < 6; ++d0) { int cb = (d0 * 16 + hi * 8) * 2;
    bf16x8 b0 = *reinterpret_cast<const LAS bf16x8*>(Ks + KSWZ(r32, cb));
    bf16x8 b1 = *reinterpret_cast<const LAS bf16x8*>(Ks + KSWZ(32 + r32, cb));
    p0 = __builtin_amdgcn_mfma_f32_32x32x16_bf16(b0, qr[d0], p0, 0, 0, 0);
    p1 = __builtin_amdgcn_mfma_f32_32x32x16_bf16(b1, qr[d0], p1, 0, 0, 0); }
}
__device__ __forceinline__ int v_st(int k, int c) { const int kk = (k & ~0xC) | ((k & 4) << 1) | ((k & 8) >> 1); return ((kk >> 3) * 4 + (c >> 5)) * 512 + ((kk & 7) * 32 + (c & 31)) * 2; }
__device__ __forceinline__ int v_rd_base(int lane) { return ((lane & 3) << 3) | (((lane >> 2) & 3) << 6) | (((lane >> 4) & 1) << 5) | (((lane >> 5) & 1) << 8); }
constexpr int v_rd_off(int d0, int ks, int half) { return d0 * 512 + ks * 4096 + half * 2048; }
template <int OFF> __device__ __forceinline__ s16x4 tr_read(int vb) {
  s16x4 r; asm volatile("ds_read_b64_tr_b16 %0, %1 offset:%2" : "=&v"(r) : "v"(vb), "i"(OFF) : "memory"); return r;
}
template <int D0> __device__ __forceinline__ void pv_one(f32x16& od, int vb, bf16x8 pa0, bf16x8 pa1, bf16x8 pa2, bf16x8 pa3) {
  const s16x4 l0 = tr_read<v_rd_off(D0, 0, 0)>(vb), h0 = tr_read<v_rd_off(D0, 0, 1)>(vb), l1 = tr_read<v_rd_off(D0, 1, 0)>(vb), h1 = tr_read<v_rd_off(D0, 1, 1)>(vb);
  const s16x4 l2 = tr_read<v_rd_off(D0, 2, 0)>(vb), h2 = tr_read<v_rd_off(D0, 2, 1)>(vb), l3 = tr_read<v_rd_off(D0, 3, 0)>(vb), h3 = tr_read<v_rd_off(D0, 3, 1)>(vb);
  asm volatile("s_waitcnt lgkmcnt(0)" ::: "memory"); SBAR();
#define PK(L, H) (bf16x8){L[0], L[1], L[2], L[3], H[0], H[1], H[2], H[3]}
  od = __builtin_amdgcn_mfma_f32_32x32x16_bf16(pa0, PK(l0, h0), od, 0, 0, 0);
  od = __builtin_amdgcn_mfma_f32_32x32x16_bf16(pa1, PK(l1, h1), od, 0, 0, 0);
  od = __builtin_amdgcn_mfma_f32_32x32x16_bf16(pa2, PK(l2, h2), od, 0, 0, 0);
  od = __builtin_amdgcn_mfma_f32_32x32x16_bf16(pa3, PK(l3, h3), od, 0, 0, 0);
#undef PK
}
__device__ __forceinline__ void pv_d0(f32x16* o, int vb, bf16x8 pa0, bf16x8 pa1, bf16x8 pa2, bf16x8 pa3) {
  pv_one<0>(o[0], vb, pa0, pa1, pa2, pa3); pv_one<1>(o[1], vb, pa0, pa1, pa2, pa3);
}
__device__ __forceinline__ void attn_unit(const bf16_t* Qb, const bf16_t* Kh, const bf16_t* Vh, const bf16_t* GAb, bf16_t* Yb, LAS char* lds) {
  const int tid = threadIdx.x, wid = tid >> 6, lane = tid & 63, r32 = lane & 31, hi = lane >> 5;
  LAS char* V_lds = lds; LAS char* K_lds = lds + 2 * SHM_V;
  LAS float* ws = (LAS float*)(lds + 2 * SHM_V + 2 * SHM_K) + wid * 64; LAS float* li_l = ws; LAS float* al_l = ws + 32;
  float m_reg = -1e30f, l_reg = 0; f32x16 o[2] = {}; bf16x8 qr[6];
  const bf16_t* Qw = Qb + (size_t)(wid * QBLK + r32) * DQK + hi * 8;
#pragma unroll
  for (int d0 = 0; d0 < 6; ++d0) qr[d0] = *reinterpret_cast<const bf16x8*>(Qw + d0 * 16);
  const int kst0 = KSWZ(tid / 12, (tid % 12) * 16), kst1 = KSWZ((512 + tid) / 12, ((512 + tid) % 12) * 16);
  const bool k2 = __builtin_amdgcn_readfirstlane(wid) < 4;
  const int vst = v_st(tid >> 3, (tid & 7) * 8);
  const int vb0 = (int)(uintptr_t)V_lds + v_rd_base(lane);
  struct { bf16x8 k0, k1, v; } sr_[2];
#define SLOAD(i, key0) do { const bf16_t* kp_ = Kh + (size_t)(key0) * DQK; sr_[i].k0 = *reinterpret_cast<const bf16x8*>(kp_ + tid * 8); \
    if (k2) sr_[i].k1 = *reinterpret_cast<const bf16x8*>(kp_ + (512 + tid) * 8); sr_[i].v = *reinterpret_cast<const bf16x8*>(Vh + (size_t)(key0) * DV + tid * 8); } while (0)
#define SWRITE(b, i) do { *(LAS bf16x8*)(K_lds + (b) * SHM_K + kst0) = sr_[i].k0; if (k2) *(LAS bf16x8*)(K_lds + (b) * SHM_K + kst1) = sr_[i].k1; \
    *(LAS bf16x8*)(V_lds + (b) * SHM_V + vst) = sr_[i].v; } while (0)
#define RESC(a) do { if (__any((a) < 1.f)) { if (hi == 0) al_l[r32] = (a); asm volatile("s_waitcnt lgkmcnt(0)" ::: "memory"); \
    for (int d = 0; d < 2; ++d) for (int r = 0; r < 16; ++r) o[d][r] *= al_l[crow(r, hi)]; } } while (0)
  f32x16 pA0, pA1, pB0, pB1; float mnA, mnB, alA, alB; bf16x8 pa0, pa1, pa2, pa3; constexpr int NT = SEQ / KVBLK;
  constexpr int SE = 0, SO = 1;
  SLOAD(SE, 0); SWRITE(0, SE); __syncthreads();
  qkt(pA0, pA1, K_lds, qr, r32, hi); partialSM(pA0, pA1, m_reg, mnA, alA);
  SLOAD(SO, KVBLK); SLOAD(SE, 2 * KVBLK);
  SWRITE(1, SO); __syncthreads();
  for (int j = 1; j + 1 < NT; j += 2) {
    SBAR(); qkt(pB0, pB1, K_lds + SHM_K, qr, r32, hi);
    finishSM(pA0, pA1, alA, l_reg, pa0, pa1, pa2, pa3); SBAR();
    SLOAD(SO, (j + 2) * KVBLK); SBAR();
    pv_d0(o, vb0, pa0, pa1, pa2, pa3); partialSM(pB0, pB1, m_reg, mnB, alB);
    __syncthreads(); SWRITE(0, SE);
    RESC(alB); __syncthreads();
    SBAR(); qkt(pA0, pA1, K_lds, qr, r32, hi);
    finishSM(pB0, pB1, alB, l_reg, pa0, pa1, pa2, pa3); SBAR();
    if (j + 3 < NT) SLOAD(SE, (j + 3) * KVBLK); SBAR();
    pv_d0(o, vb0 + SHM_V, pa0, pa1, pa2, pa3); partialSM(pA0, pA1, m_reg, mnA, alA);
    __syncthreads(); SWRITE(1, SO);
    RESC(alA); __syncthreads();
  }
  SBAR(); qkt(pB0, pB1, K_lds + SHM_K, qr, r32, hi);
  finishSM(pA0, pA1, alA, l_reg, pa0, pa1, pa2, pa3); SBAR();
  pv_d0(o, vb0, pa0, pa1, pa2, pa3); partialSM(pB0, pB1, m_reg, mnB, alB);
  __syncthreads(); RESC(alB);
  finishSM(pB0, pB1, alB, l_reg, pa0, pa1, pa2, pa3); SBAR();
  pv_d0(o, vb0 + SHM_V, pa0, pa1, pa2, pa3);
  if (hi == 0) li_l[r32] = l_reg; asm volatile("s_waitcnt lgkmcnt(0)" ::: "memory");
  float rli[16];
#pragma unroll
  for (int r = 0; r < 16; ++r) rli[r] = __builtin_amdgcn_rcpf(li_l[crow(r, hi)]);
#pragma unroll
  for (int r = 0; r < 16; ++r) { const int orow = wid * QBLK + crow(r, hi);
#pragma unroll
    for (int d0 = 0; d0 < 2; ++d0) { const int col = d0 * 32 + r32; const float g = bf2f(GAb[(size_t)orow * 512 + col]);
      Yb[(size_t)orow * 1024 + col] = f2bf(o[d0][r] * rli[r] * siluf(g)); } }
  __syncthreads();
#undef SLOAD
#undef SWRITE
#undef RESC
}
#undef KSWZ
#undef SBAR
}

struct Frame {
    LAS unsigned char* lds;
    int tid, lane, wave, vb, G;
    float* modp; float* rope; float* gate;
    bf16_t *WIN, *WUQ, *WUKV, *WPOOL, *WOUT;
    bf16_t *XN, *UP, *GP, *GA, *QL, *KVL, *Q, *K, *V, *Y;
};
__device__ __forceinline__ float mod_val(const Params& P, const Frame& F, int b, int e) {
    float s = P.ada_b[e];
#pragma unroll
    for (int kq = 0; kq < 4; ++kq) s += F.modp[((size_t)kq * 16 + b) * 3072 + e];
    return s;
}

__device__ __forceinline__ void ph0_mod(const Params& P, Frame& F) {
    LAS float* cact = (LAS float*)F.lds;
    LAS float* red = (LAS float*)(F.lds + 65536);
    bool have = false;
    for (int item = F.vb; item < 192; item += F.G) {
        if (!have) { for (int i = F.tid; i < 16384; i += NTHREADS) cact[i] = siluf(P.c[i]); __syncthreads(); have = true; }
        const int cg = item % 48, kq = item / 48;
        const int col = cg * 64 + F.lane, r0 = kq * 256 + F.wave * 32;
        float acc[16];
#pragma unroll
        for (int b = 0; b < 16; ++b) acc[b] = 0.f;
#pragma unroll 4
        for (int r = 0; r < 32; ++r) {
            const float w = P.ada_w[(size_t)(r0 + r) * 3072 + col];
#pragma unroll
            for (int b = 0; b < 16; ++b) acc[b] += cact[b * 1024 + r0 + r] * w;
        }
#pragma unroll
        for (int b = 0; b < 16; ++b) red[(F.wave * 16 + b) * 64 + F.lane] = acc[b];
        __syncthreads();
        for (int o = F.tid; o < 1024; o += NTHREADS) {
            const int b = o >> 6, cl = o & 63; float s = 0.f;
#pragma unroll
            for (int w = 0; w < 8; ++w) s += red[(w * 16 + b) * 64 + cl];
            F.modp[((size_t)kq * 16 + b) * 3072 + cg * 64 + cl] = s;
        }
        __syncthreads();
    }
}


__device__ __forceinline__ unsigned pk2(float lo, float hi) { return (unsigned)f2bf(lo) | ((unsigned)f2bf(hi) << 16); }
__device__ __forceinline__ void p0_transpose_item(const float* W, int K, int N, int nsrc0, bf16_t* WT, int ndst0, int k0, LAS float* scr, int lane) {
    if (nsrc0 >= 0) {
#pragma unroll 8
        for (int i = 0; i < 32; ++i) { const int kk = 2 * i + (lane >> 5); scr[kk * 33 + (lane & 31)] = W[(size_t)(k0 + kk) * N + nsrc0 + (lane & 31)]; }
    } else {
#pragma unroll 8
        for (int i = 0; i < 32; ++i) { const int kk = 2 * i + (lane >> 5); scr[kk * 33 + (lane & 31)] = 0.f; }
    }
    asm volatile("s_waitcnt lgkmcnt(0)" ::: "memory");
    const int c = lane & 7;
#pragma unroll
    for (int j = 0; j < 4; ++j) { const int n = (lane >> 3) + 8 * j; const LAS float* s = scr + (8 * c) * 33 + n;
        uint4 o; o.x = pk2(s[0 * 33], s[1 * 33]); o.y = pk2(s[2 * 33], s[3 * 33]); o.z = pk2(s[4 * 33], s[5 * 33]); o.w = pk2(s[6 * 33], s[7 * 33]);
        *(uint4*)(WT + (size_t)(ndst0 + n) * K + k0 + 8 * c) = o; }
    asm volatile("s_waitcnt lgkmcnt(0)" ::: "memory");
}
__device__ __forceinline__ int win_src_col(int n) { return n < 1024 ? n : (n < 1536 ? OFF_GA + (n - 1024) : (n < 1792 ? OFF_QL + (n - 1536) : (n < 1952 ? OFF_KVL + (n - 1792) : -1))); }
__device__ __forceinline__ void ph0_weights(const Params& P, Frame& F) {
    LAS float* scr = (LAS float*)(F.lds + F.wave * 16384);
    const int NGW = F.G * NWAVES, gw = NGW - 1 - (F.vb * NWAVES + F.wave);
    constexpr int I_IN = 16 * 64, I_OUT = 16 * 32;
    for (int it = gw; it < I_IN + I_OUT; it += NGW) {
        if (it < I_IN) { const int kb = it / 64, nb = it % 64; p0_transpose_item(P.w_in, DM, INW, win_src_col(32 * nb), F.WIN, 32 * nb, 64 * kb, scr, F.lane); }
        else { const int r = it - I_IN, kb = r / 32, nb = r % 32; p0_transpose_item(P.w_out, DM, DM, 32 * nb, F.WOUT, 32 * nb, 64 * kb, scr, F.lane); }
    }
}

__device__ __forceinline__ void ph1_xn(const Params& P, Frame& F) {
    LAS float* gs = (LAS float*)F.lds; LAS float* sh = gs + 1024;
    for (int item = F.vb; item < TOK / 128; item += F.G) {
        const int row0 = item * 128, b = row0 / SEQ;
        __syncthreads();
        for (int d = F.tid; d < 1024; d += NTHREADS) { const float sc = mod_val(P, F, b, 1024 + d), sf = mod_val(P, F, b, d); gs[d] = P.norm_g[d] * (1.f + sc); sh[d] = sf; }
        if (F.tid < 64) { const int n = (item % 16) * 64 + F.tid; F.gate[(size_t)b * 1024 + n] = mod_val(P, F, b, 2048 + n); }
        __syncthreads();
        for (int i = 0; i < 16; ++i) {
            const int t = row0 + F.wave * 16 + i;
            const float4* xr = (const float4*)(P.x + (size_t)t * 1024) + F.lane;
            float4 v[4]; float ss = 0.f;
#pragma unroll
            for (int j = 0; j < 4; ++j) { v[j] = xr[64 * j]; ss += (v[j].x * v[j].x + v[j].y * v[j].y) + (v[j].z * v[j].z + v[j].w * v[j].w); }
            ss = wave_sum(ss);
            const float r = rsqrtf(ss * (1.f / 1024.f) + EPS);
#pragma unroll
            for (int j = 0; j < 4; ++j) {
                const int d = 4 * F.lane + 256 * j;
                const float o0 = (v[j].x * r) * gs[d] + sh[d], o1 = (v[j].y * r) * gs[d + 1] + sh[d + 1], o2 = (v[j].z * r) * gs[d + 2] + sh[d + 2], o3 = (v[j].w * r) * gs[d + 3] + sh[d + 3];
                uint2 pk; pk.x = (unsigned)f2bf(o0) | ((unsigned)f2bf(o1) << 16); pk.y = (unsigned)f2bf(o2) | ((unsigned)f2bf(o3) << 16);
                *(uint2*)(F.XN + (size_t)t * 1024 + d) = pk;
            }
            if (F.lane < 16) {
                const float ang = (float)P.pos[t] * INVF[F.lane];
                float sn, cs; sincosf(ang, &sn, &cs);
                F.rope[(size_t)t * 32 + F.lane] = cs; F.rope[(size_t)t * 32 + 16 + F.lane] = sn;
            }
        }
    }
}

template <class AF, class BF, class EF>
__device__ __forceinline__ void naive_gemm(Frame& F, int M, int N, int K, AF a, BF bfn, EF epi) {
    LAS float* As = (LAS float*)F.lds;
    LAS float* Bs = As + 16 * 132;
    const int tx = F.tid & 31, ty = F.tid >> 5;
    const int ntm = M / 128, ntn = (N + 127) / 128;
    for (int tile = F.vb; tile < ntm * ntn; tile += F.G) {
        const int m0 = (tile / ntn) * 128, n0 = (tile % ntn) * 128;
        float acc[8][4];
#pragma unroll
        for (int i = 0; i < 8; ++i)
#pragma unroll
            for (int j = 0; j < 4; ++j) acc[i][j] = 0.f;
        for (int k0 = 0; k0 < K; k0 += 16) {
            __syncthreads();
#pragma unroll
            for (int i = 0; i < 4; ++i) { const int e = F.tid + i * NTHREADS; As[(e & 15) * 132 + (e >> 4)] = a(m0 + (e >> 4), k0 + (e & 15)); }
#pragma unroll
            for (int i = 0; i < 4; ++i) { const int e = F.tid + i * NTHREADS; Bs[(e >> 7) * 132 + (e & 127)] = bfn(k0 + (e >> 7), n0 + (e & 127)); }
            __syncthreads();
#pragma unroll
            for (int kk = 0; kk < 16; ++kk) {
                float av[8], bv[4];
#pragma unroll
                for (int i = 0; i < 8; ++i) av[i] = As[kk * 132 + ty * 8 + i];
#pragma unroll
                for (int j = 0; j < 4; ++j) bv[j] = Bs[kk * 132 + tx * 4 + j];
#pragma unroll
                for (int i = 0; i < 8; ++i)
#pragma unroll
                    for (int j = 0; j < 4; ++j) acc[i][j] += av[i] * bv[j];
            }
        }
#pragma unroll
        for (int i = 0; i < 8; ++i)
#pragma unroll
            for (int j = 0; j < 4; ++j) epi(m0 + ty * 8 + i, n0 + tx * 4 + j, acc[i][j]);
    }
    __syncthreads();
}

__device__ __forceinline__ void ph2_inproj(const Params& P, Frame& F) {
    const bf16_t* XN = F.XN; const float* W = P.w_in;
    bf16_t *UP = F.UP, *GP = F.GP, *GA = F.GA, *QL = F.QL, *KVL = F.KVL;
    naive_gemm(F, TOK, INW, DM,
        [=](int m, int k) { return bf2f(XN[(size_t)m * 1024 + k]); },
        [=](int k, int n) { return n < INW ? W[(size_t)k * INW + n] : 0.f; },
        [=](int m, int n, float v) {
            const bf16_t h = f2bf(v);
            if (n < OFF_GP) UP[(size_t)m * 512 + n] = h;
            else if (n < OFF_QL) GP[(size_t)m * 512 + (n - OFF_GP)] = h;
            else if (n < OFF_KVL) QL[(size_t)m * 256 + (n - OFF_QL)] = h;
            else if (n < OFF_GA) KVL[(size_t)m * 160 + (n - OFF_KVL)] = h;
            else if (n < INW) GA[(size_t)m * 512 + (n - OFF_GA)] = h;
        });
}

__device__ __forceinline__ void ph3_upproj(const Params& P, Frame& F) {
    const int gw = F.vb * NWAVES + F.wave, NGW = F.G * NWAVES;
    for (int wi = gw; wi < (TOK / 64) * NH; wi += NGW) {
        const int h = wi % NH, t = (wi / NH) * 64 + F.lane, b = t / SEQ, s = t % SEQ;
        float acc[DQK];
#pragma unroll
        for (int d = 0; d < DQK; ++d) acc[d] = 0.f;
        float ssq = 0.f;
        for (int r = 0; r < QLORA; ++r) {
            float a = bf2f(F.QL[(size_t)t * 256 + r]); ssq += a * a; a *= P.g_q_lat[r];
            const float* w = P.w_uq + (size_t)r * (NH * DQK) + h * DQK;
#pragma unroll
            for (int d = 0; d < DQK; ++d) acc[d] += a * w[d];
        }
        const float rq = rsqrtf(ssq * (1.f / QLORA) + EPS);
        float s2 = 0.f;
#pragma unroll
        for (int d = 0; d < DQK; ++d) { acc[d] *= rq; s2 += acc[d] * acc[d]; }
        const float rh = rsqrtf(s2 * (1.f / DQK) + EPS);
#pragma unroll
        for (int d = 0; d < DQK; ++d) acc[d] = acc[d] * rh * P.g_qnorm[d];
#pragma unroll
        for (int i = 0; i < 16; ++i) {
            const float cs = F.rope[(size_t)t * 32 + i], sn = F.rope[(size_t)t * 32 + 16 + i];
            const float x1 = acc[64 + i], x2 = acc[80 + i];
            acc[64 + i] = x1 * cs - x2 * sn; acc[80 + i] = x2 * cs + x1 * sn;
        }
        bf16_t* qo = F.Q + ((size_t)(b * NH + h) * SEQ + s) * DQK;
#pragma unroll
        for (int d = 0; d < DQK; d += 2) *(unsigned*)(qo + d) = (unsigned)f2bf(acc[d]) | ((unsigned)f2bf(acc[d + 1]) << 16);
    }
    for (int wi = gw; wi < (TOK / 64) * NH; wi += NGW) {
        const int h = wi % NH, t = (wi / NH) * 64 + F.lane, b = t / SEQ, s = t % SEQ;
        float acc[64];
#pragma unroll
        for (int d = 0; d < 64; ++d) acc[d] = 0.f;
        float ssq = 0.f;
        for (int r = 0; r < KVLORA; ++r) {
            float a = bf2f(F.KVL[(size_t)t * 160 + r]); ssq += a * a; a *= P.g_kv_lat[r];
            const float* w = P.w_ukv + (size_t)r * (NH * 128) + h * 128;
#pragma unroll
            for (int d = 0; d < 64; ++d) acc[d] += a * w[d];
        }
        const float rkv = rsqrtf(ssq * (1.f / KVLORA) + EPS);
        float s2 = 0.f;
#pragma unroll
        for (int d = 0; d < 64; ++d) { acc[d] *= rkv; s2 += acc[d] * acc[d]; }
        float kr[32];
#pragma unroll
        for (int i = 0; i < 32; ++i) { kr[i] = bf2f(F.KVL[(size_t)t * 160 + 128 + i]); s2 += kr[i] * kr[i]; }
        const float rh = rsqrtf(s2 * (1.f / DQK) + EPS);
#pragma unroll
        for (int d = 0; d < 64; ++d) acc[d] = acc[d] * rh * P.g_knorm[d];
#pragma unroll
        for (int i = 0; i < 32; ++i) kr[i] = kr[i] * rh * P.g_knorm[64 + i];
#pragma unroll
        for (int i = 0; i < 16; ++i) {
            const float cs = F.rope[(size_t)t * 32 + i], sn = F.rope[(size_t)t * 32 + 16 + i];
            const float x1 = kr[i], x2 = kr[16 + i];
            kr[i] = x1 * cs - x2 * sn; kr[16 + i] = x2 * cs + x1 * sn;
        }
        bf16_t* ko = F.K + ((size_t)(b * NH + h) * SEQ + s) * DQK;
#pragma unroll
        for (int d = 0; d < 64; d += 2) *(unsigned*)(ko + d) = (unsigned)f2bf(acc[d]) | ((unsigned)f2bf(acc[d + 1]) << 16);
#pragma unroll
        for (int i = 0; i < 32; i += 2) *(unsigned*)(ko + 64 + i) = (unsigned)f2bf(kr[i]) | ((unsigned)f2bf(kr[i + 1]) << 16);
    }
    for (int wi = gw; wi < (TOK / 64) * NH; wi += NGW) {
        const int h = wi % NH, t = (wi / NH) * 64 + F.lane, b = t / SEQ, s = t % SEQ;
        float acc[64];
#pragma unroll
        for (int d = 0; d < 64; ++d) acc[d] = 0.f;
        float ssq = 0.f;
        for (int r = 0; r < KVLORA; ++r) {
            float a = bf2f(F.KVL[(size_t)t * 160 + r]); ssq += a * a; a *= P.g_kv_lat[r];
            const float* w = P.w_ukv + (size_t)r * (NH * 128) + h * 128 + 64;
#pragma unroll
            for (int d = 0; d < 64; ++d) acc[d] += a * w[d];
        }
        const float rkv = rsqrtf(ssq * (1.f / KVLORA) + EPS);
        bf16_t* vo = F.V + ((size_t)(b * NH + h) * SEQ + s) * DV;
#pragma unroll
        for (int d = 0; d < 64; d += 2) *(unsigned*)(vo + d) = (unsigned)f2bf(acc[d] * rkv) | ((unsigned)f2bf(acc[d + 1] * rkv) << 16);
    }
}

__device__ __forceinline__ void ph3_pool(const Params& P, Frame& F) {
    LAS float* df = (LAS float*)F.lds;
    for (int item = F.vb; item < (TOK / 32) * 4; item += F.G) {
        const int tt = item >> 2, gi = item & 3, t0 = tt * 32, b = t0 / SEQ, s0 = t0 % SEQ, half = 1 << gi;
        __syncthreads();
        for (int e = F.tid; e < 4096; e += NTHREADS) {
            const int tl = e >> 7, c = e & 127, s = s0 + tl;
            const int lo = (s - half) > 0 ? (s - half) : 0, hi = (s + half) < SEQ ? (s + half) : SEQ;
            float sum = 0.f;
            for (int sp = lo; sp < hi; ++sp) sum += bf2f(F.UP[((size_t)b * SEQ + sp) * 512 + gi * 128 + c]);
            df[e] = sum / (float)(hi - lo) - bf2f(F.UP[((size_t)b * SEQ + s) * 512 + gi * 128 + c]);
        }
        __syncthreads();
        for (int o = F.tid; o < 4096; o += NTHREADS) {
            const int tl = o >> 7, d = o & 127;
            float acc = 0.f;
            for (int c = 0; c < 128; ++c) acc += df[tl * 128 + c] * P.pool_w[((size_t)gi * 128 + c) * 128 + d];
            const int n = gi * 128 + d, t = t0 + tl;
            const float g = bf2f(F.GP[(size_t)t * 512 + n]);
            F.Y[(size_t)t * 1024 + n] = f2bf(acc * P.pool_scale[n] * siluf(g));
        }
    }
    __syncthreads();
}

__device__ __forceinline__ void ph4_attn(const Params& P, Frame& F) {
    LAS float* Ks = (LAS float*)F.lds;
    LAS float* Vs = Ks + 64 * 96;
    const float scale = 0.10206207261596577f;
    const int hf = F.tid & 1, row = F.tid >> 1;
    for (int item = F.vb; item < NB * NH * 8; item += F.G) {
        const int bh = item >> 3, qb = item & 7, s = qb * 256 + row, b = bh / NH, h = bh % NH;
        float q[48];
        { const bf16_t* qp = F.Q + ((size_t)bh * SEQ + s) * DQK + hf * 48;
#pragma unroll
          for (int d = 0; d < 48; ++d) q[d] = bf2f(qp[d]) * scale; }
        float o[32];
#pragma unroll
        for (int d = 0; d < 32; ++d) o[d] = 0.f;
        float m = -1e30f, l = 0.f;
        for (int kt = 0; kt < SEQ / 64; ++kt) {
            __syncthreads();
            { const bf16_t* kp = F.K + ((size_t)bh * SEQ + kt * 64) * DQK;
              for (int e = F.tid; e < 64 * DQK; e += NTHREADS) Ks[e] = bf2f(kp[e]);
              const bf16_t* vp = F.V + ((size_t)bh * SEQ + kt * 64) * DV;
              for (int e = F.tid; e < 64 * DV; e += NTHREADS) Vs[e] = bf2f(vp[e]); }
            __syncthreads();
#pragma unroll 1
            for (int kc = 0; kc < 8; ++kc) {
                float sc[8]; float mx = -1e30f;
#pragma unroll
                for (int j = 0; j < 8; ++j) {
                    float dot = 0.f;
#pragma unroll
                    for (int d = 0; d < 48; ++d) dot += q[d] * Ks[(kc * 8 + j) * DQK + hf * 48 + d];
                    dot += __shfl_xor(dot, 1);
                    sc[j] = dot; mx = fmaxf(mx, dot);
                }
                const float mn = fmaxf(m, mx), alpha = __expf(m - mn);
                l *= alpha;
#pragma unroll
                for (int d = 0; d < 32; ++d) o[d] *= alpha;
                m = mn;
#pragma unroll
                for (int j = 0; j < 8; ++j) {
                    const float p = __expf(sc[j] - m); l += p;
#pragma unroll
                    for (int d = 0; d < 32; ++d) o[d] += p * Vs[(kc * 8 + j) * DV + hf * 32 + d];
                }
            }
        }
        const float rl = 1.f / l; const size_t t = (size_t)b * SEQ + s;
#pragma unroll
        for (int d = 0; d < 32; d += 2) {
            const int col = h * 64 + hf * 32 + d;
            const float g0 = bf2f(F.GA[t * 512 + col]), g1 = bf2f(F.GA[t * 512 + col + 1]);
            *(unsigned*)(F.Y + t * 1024 + 512 + col) = (unsigned)f2bf(o[d] * rl * siluf(g0)) | ((unsigned)f2bf(o[d + 1] * rl * siluf(g1)) << 16);
        }
    }
    __syncthreads();
}

__device__ __forceinline__ void ph5_outproj(const Params& P, Frame& F) {
    const bf16_t* Y = F.Y; const float* W = P.w_out; const float* x = P.x; float* out = P.out;
    const float* ada_b = P.ada_b; const float* modp = F.modp;
    naive_gemm(F, TOK, DM, DM,
        [=](int m, int k) { return bf2f(Y[(size_t)m * 1024 + k]); },
        [=](int k, int n) { return W[(size_t)k * 1024 + n]; },
        [=](int m, int n, float v) {
            const int b = m / SEQ; float g = ada_b[2048 + n];
#pragma unroll
            for (int kq = 0; kq < 4; ++kq) g += modp[((size_t)kq * 16 + b) * 3072 + 2048 + n];
            out[(size_t)m * 1024 + n] = x[(size_t)m * 1024 + n] + g * v;
        });
}


namespace up {
using bf16x8 = __attribute__((ext_vector_type(8))) short;
using f32x16 = __attribute__((ext_vector_type(16))) float;
__device__ __forceinline__ float half_sum(float v) { auto rr = __builtin_amdgcn_permlane32_swap(__float_as_uint(v), __float_as_uint(v), false, false); return __uint_as_float(rr[0]) + __uint_as_float(rr[1]); }
__device__ __forceinline__ uint2 pack4(float a, float b, float c, float d) { uint2 r; r.x = att::cvtpk(a, b); r.y = att::cvtpk(c, d); return r; }
__device__ __forceinline__ float sumsq8(bf16x8 v) { float s = 0.f;
#pragma unroll
    for (int j = 0; j < 8; ++j) { const float a = bf2f((bf16_t)v[j]); s += a * a; } return s; }

__device__ __forceinline__ void p0_frag_weights(const Params& P, Frame& F) {
    const int gt = F.vb * NTHREADS + F.tid, NT = F.G * NTHREADS;
    for (int id = gt; id < 49152; id += NT) {
        float v[8]; bf16_t* dst;
        if (id < 24576) { const int l = id & 63, ks = (id >> 6) & 15, ti = id >> 10; const int n = (ti / 3) * 96 + (ti % 3) * 32 + (l & 31), k0 = ks * 16 + 8 * (l >> 5);
#pragma unroll
            for (int j = 0; j < 8; ++j) v[j] = P.g_q_lat[k0 + j] * P.w_uq[(size_t)(k0 + j) * 768 + n];
            dst = F.WUQ + (size_t)id * 8; }
        else if (id < 40960) { const int id2 = id - 24576; const int l = id2 & 63, ks = (id2 >> 6) & 7, ti = id2 >> 9; const int n = (ti >> 2) * 128 + (ti & 3) * 32 + (l & 31), k0 = ks * 16 + 8 * (l >> 5);
#pragma unroll
            for (int j = 0; j < 8; ++j) v[j] = P.g_kv_lat[k0 + j] * P.w_ukv[(size_t)(k0 + j) * 1024 + n];
            dst = F.WUKV + (size_t)id2 * 8; }
        else { const int id3 = id - 40960; const int l = id3 & 63, ks = (id3 >> 6) & 7, ti = id3 >> 9; const int gi = ti >> 2, d = (ti & 3) * 32 + (l & 31), k0 = ks * 16 + 8 * (l >> 5);
#pragma unroll
            for (int j = 0; j < 8; ++j) v[j] = P.pool_w[((size_t)gi * 128 + k0 + j) * 128 + d];
            dst = F.WPOOL + (size_t)id3 * 8; }
        uint4 o; o.x = pk2(v[0], v[1]); o.y = pk2(v[2], v[3]); o.z = pk2(v[4], v[5]); o.w = pk2(v[6], v[7]);
        *(uint4*)dst = o;
    }
}

__device__ __forceinline__ void q_job(const Params& P, Frame& F, int tg, int hq) {
    const int lane = F.lane, r32 = lane & 31, hi = lane >> 5;
    const int t = tg * 32 + r32, b = t / SEQ, s = t % SEQ;
    bf16x8 bq[16]; float ssq = 0.f;
#pragma unroll
    for (int ks = 0; ks < 16; ++ks) { bq[ks] = *reinterpret_cast<const bf16x8*>(F.QL + (size_t)t * 256 + ks * 16 + hi * 8); ssq += sumsq8(bq[ks]); }
    ssq = half_sum(ssq);
    const float rq = rsqrtf(ssq * (1.f / QLORA) + EPS);
    const float4 c0 = *(const float4*)(F.rope + (size_t)t * 32 + 4 * hi), c1 = *(const float4*)(F.rope + (size_t)t * 32 + 8 + 4 * hi);
    const float4 s0 = *(const float4*)(F.rope + (size_t)t * 32 + 16 + 4 * hi), s1 = *(const float4*)(F.rope + (size_t)t * 32 + 24 + 4 * hi);
    const float cs[8] = {c0.x, c0.y, c0.z, c0.w, c1.x, c1.y, c1.z, c1.w}, sn[8] = {s0.x, s0.y, s0.z, s0.w, s1.x, s1.y, s1.z, s1.w};
#pragma unroll 1
    for (int hh = 0; hh < 4; ++hh) {
        const int h = hq * 4 + hh;
        f32x16 acc[3] = {};
        const bf16_t* wf = F.WUQ + (size_t)(h * 3) * 16 * 512 + lane * 8;
#pragma unroll
        for (int i = 0; i < 3; ++i)
            {
#pragma unroll
              for (int ks = 0; ks < 16; ++ks) { const bf16x8 a = *reinterpret_cast<const bf16x8*>(wf + (size_t)(i * 16 + ks) * 512); acc[i] = __builtin_amdgcn_mfma_f32_32x32x16_bf16(a, bq[ks], acc[i], 0, 0, 0); if ((ks & 7) == 7) asm volatile("" ::: "memory"); } }
        float s2 = 0.f;
#pragma unroll
        for (int i = 0; i < 3; ++i)
#pragma unroll
            for (int r = 0; r < 16; ++r) { acc[i][r] *= rq; s2 += acc[i][r] * acc[i][r]; }
        s2 = half_sum(s2);
        const float rh = rsqrtf(s2 * (1.f / DQK) + EPS);
#pragma unroll
        for (int i = 0; i < 3; ++i)
#pragma unroll
            for (int rg = 0; rg < 4; ++rg) { const float4 g = *(const float4*)(P.g_qnorm + 32 * i + 8 * rg + 4 * hi);
                acc[i][4 * rg + 0] *= rh * g.x; acc[i][4 * rg + 1] *= rh * g.y; acc[i][4 * rg + 2] *= rh * g.z; acc[i][4 * rg + 3] *= rh * g.w; }
#pragma unroll
        for (int r = 0; r < 8; ++r) { const float x1 = acc[2][r], x2 = acc[2][r + 8]; acc[2][r] = x1 * cs[r] - x2 * sn[r]; acc[2][r + 8] = x2 * cs[r] + x1 * sn[r]; }
        bf16_t* qo = F.Q + ((size_t)(b * NH + h) * SEQ + s) * DQK + 4 * hi;
#pragma unroll
        for (int i = 0; i < 3; ++i)
#pragma unroll
            for (int rg = 0; rg < 4; ++rg) *(uint2*)(qo + 32 * i + 8 * rg) = pack4(acc[i][4 * rg], acc[i][4 * rg + 1], acc[i][4 * rg + 2], acc[i][4 * rg + 3]);
    }
}
__device__ __forceinline__ void kv_job(const Params& P, Frame& F, int tg, int hq) {
    const int lane = F.lane, r32 = lane & 31, hi = lane >> 5;
    const int t = tg * 32 + r32, b = t / SEQ, s = t % SEQ;
    bf16x8 bk[8]; float ssq = 0.f;
#pragma unroll
    for (int ks = 0; ks < 8; ++ks) { bk[ks] = *reinterpret_cast<const bf16x8*>(F.KVL + (size_t)t * 160 + ks * 16 + hi * 8); ssq += sumsq8(bk[ks]); }
    ssq = half_sum(ssq);
    const float rkv = rsqrtf(ssq * (1.f / KVLORA) + EPS);
    float kr[16]; float kr2 = 0.f;
#pragma unroll
    for (int rg = 0; rg < 4; ++rg) { const uint2 w = *(const uint2*)(F.KVL + (size_t)t * 160 + 128 + 8 * rg + 4 * hi);
        kr[4 * rg + 0] = __uint_as_float(w.x << 16); kr[4 * rg + 1] = __uint_as_float(w.x & 0xffff0000u); kr[4 * rg + 2] = __uint_as_float(w.y << 16); kr[4 * rg + 3] = __uint_as_float(w.y & 0xffff0000u); }
#pragma unroll
    for (int r = 0; r < 16; ++r) kr2 += kr[r] * kr[r];
    const float4 c0 = *(const float4*)(F.rope + (size_t)t * 32 + 4 * hi), c1 = *(const float4*)(F.rope + (size_t)t * 32 + 8 + 4 * hi);
    const float4 s0 = *(const float4*)(F.rope + (size_t)t * 32 + 16 + 4 * hi), s1 = *(const float4*)(F.rope + (size_t)t * 32 + 24 + 4 * hi);
    const float cs[8] = {c0.x, c0.y, c0.z, c0.w, c1.x, c1.y, c1.z, c1.w}, sn[8] = {s0.x, s0.y, s0.z, s0.w, s1.x, s1.y, s1.z, s1.w};
#pragma unroll 1
    for (int hh = 0; hh < 4; ++hh) {
        const int h = hq * 4 + hh;
        f32x16 acc[4] = {};
        const bf16_t* wf = F.WUKV + (size_t)(h * 4) * 8 * 512 + lane * 8;
#pragma unroll
        for (int i = 0; i < 4; ++i)
            {
#pragma unroll
              for (int ks = 0; ks < 8; ++ks) { const bf16x8 a = *reinterpret_cast<const bf16x8*>(wf + (size_t)(i * 8 + ks) * 512); acc[i] = __builtin_amdgcn_mfma_f32_32x32x16_bf16(a, bk[ks], acc[i], 0, 0, 0); } asm volatile("" ::: "memory"); }
        float s2 = kr2;
#pragma unroll
        for (int i = 0; i < 4; ++i)
#pragma unroll
            for (int r = 0; r < 16; ++r) { acc[i][r] *= rkv; if (i < 2) s2 += acc[i][r] * acc[i][r]; }
        s2 = half_sum(s2);
        const float rh = rsqrtf(s2 * (1.f / DQK) + EPS);
        bf16_t* ko = F.K + ((size_t)(b * NH + h) * SEQ + s) * DQK + 4 * hi;
#pragma unroll
        for (int i = 0; i < 2; ++i)
#pragma unroll
            for (int rg = 0; rg < 4; ++rg) { const float4 g = *(const float4*)(P.g_knorm + 32 * i + 8 * rg + 4 * hi);
                *(uint2*)(ko + 32 * i + 8 * rg) = pack4(acc[i][4 * rg] * rh * g.x, acc[i][4 * rg + 1] * rh * g.y, acc[i][4 * rg + 2] * rh * g.z, acc[i][4 * rg + 3] * rh * g.w); }
        float kn[16];
#pragma unroll
        for (int rg = 0; rg < 4; ++rg) { const float4 g = *(const float4*)(P.g_knorm + 64 + 8 * rg + 4 * hi);
            kn[4 * rg] = kr[4 * rg] * rh * g.x; kn[4 * rg + 1] = kr[4 * rg + 1] * rh * g.y; kn[4 * rg + 2] = kr[4 * rg + 2] * rh * g.z; kn[4 * rg + 3] = kr[4 * rg + 3] * rh * g.w; }
#pragma unroll
        for (int r = 0; r < 8; ++r) { const float x1 = kn[r], x2 = kn[r + 8]; kn[r] = x1 * cs[r] - x2 * sn[r]; kn[r + 8] = x2 * cs[r] + x1 * sn[r]; }
#pragma unroll
        for (int rg = 0; rg < 4; ++rg) *(uint2*)(ko + 64 + 8 * rg) = pack4(kn[4 * rg], kn[4 * rg + 1], kn[4 * rg + 2], kn[4 * rg + 3]);
        bf16_t* vo = F.V + ((size_t)(b * NH + h) * SEQ + s) * DV + 4 * hi;
#pragma unroll
        for (int i = 0; i < 2; ++i)
#pragma unroll
            for (int rg = 0; rg < 4; ++rg) *(uint2*)(vo + 32 * i + 8 * rg) = pack4(acc[2 + i][4 * rg], acc[2 + i][4 * rg + 1], acc[2 + i][4 * rg + 2], acc[2 + i][4 * rg + 3]);
    }
}
__device__ __forceinline__ void pool_job(const Params& P, Frame& F, int tg, int gi) {
    const int lane = F.lane, r32 = lane & 31, hi = lane >> 5;
    const int t = tg * 32 + r32, b = t / SEQ, s = t % SEQ, half = 1 << gi;
    const int lo = (s - half) > 0 ? (s - half) : 0, hi_ = (s + half) < SEQ ? (s + half) : SEQ;
    const float inv = 1.f / (float)(hi_ - lo);
    bf16x8 bd[8];
#pragma unroll
    for (int ks = 0; ks < 8; ++ks) {
        const int c0 = gi * 128 + ks * 16 + 8 * hi;
        float sum[8];
#pragma unroll
        for (int j = 0; j < 8; ++j) sum[j] = 0.f;
#pragma unroll 2
        for (int i = 0; i < 2 * half; ++i) { const int sp = s - half + i; const bool ok = (sp >= 0) && (sp < SEQ); const int spc = ok ? sp : s;
            const bf16x8 v = *reinterpret_cast<const bf16x8*>(F.UP + ((size_t)b * SEQ + spc) * 512 + c0);
#pragma unroll
            for (int j = 0; j < 8; ++j) sum[j] += ok ? bf2f((bf16_t)v[j]) : 0.f; }
        const bf16x8 own = *reinterpret_cast<const bf16x8*>(F.UP + (size_t)t * 512 + c0);
        float d[8];
#pragma unroll
        for (int j = 0; j < 8; ++j) d[j] = sum[j] * inv - bf2f((bf16_t)own[j]);
        uint4 w; w.x = att::cvtpk(d[0], d[1]); w.y = att::cvtpk(d[2], d[3]); w.z = att::cvtpk(d[4], d[5]); w.w = att::cvtpk(d[6], d[7]);
        bd[ks] = *reinterpret_cast<bf16x8*>(&w);
        asm volatile("" ::: "memory");
    }
    f32x16 acc[4] = {};
    const bf16_t* wf = F.WPOOL + (size_t)(gi * 4) * 8 * 512 + lane * 8;
#pragma unroll
    for (int i = 0; i < 4; ++i)
        {
#pragma unroll
          for (int ks = 0; ks < 8; ++ks) { const bf16x8 a = *reinterpret_cast<const bf16x8*>(wf + (size_t)(i * 8 + ks) * 512); acc[i] = __builtin_amdgcn_mfma_f32_32x32x16_bf16(a, bd[ks], acc[i], 0, 0, 0); } asm volatile("" ::: "memory"); }
#pragma unroll
    for (int i = 0; i < 4; ++i)
#pragma unroll
        for (int rg = 0; rg < 4; ++rg) { const int n = gi * 128 + 32 * i + 8 * rg + 4 * hi;
            const uint2 gw = *(const uint2*)(F.GP + (size_t)t * 512 + n); const float4 ps = *(const float4*)(P.pool_scale + n);
            const float g0 = __uint_as_float(gw.x << 16), g1 = __uint_as_float(gw.x & 0xffff0000u), g2 = __uint_as_float(gw.y << 16), g3 = __uint_as_float(gw.y & 0xffff0000u);
            *(uint2*)(F.Y + (size_t)t * 1024 + n) = pack4(acc[i][4 * rg] * ps.x * siluf(g0), acc[i][4 * rg + 1] * ps.y * siluf(g1), acc[i][4 * rg + 2] * ps.z * siluf(g2), acc[i][4 * rg + 3] * ps.w * siluf(g3)); }
}
__device__ __forceinline__ void ph3_mfma(const Params& P, Frame& F) {
    const int gw = F.vb * NWAVES + F.wave, NGW = F.G * NWAVES;
    for (int it = gw; it < 2048; it += NGW) q_job(P, F, it >> 1, it & 1);
    for (int it = gw; it < 2048; it += NGW) kv_job(P, F, it >> 1, it & 1);
    for (int it = gw; it < 2048; it += NGW) { const int tg = it >> 1; pool_job(P, F, tg, (it & 1) ? 1 : 0); pool_job(P, F, tg, (it & 1) ? 2 : 3); }
}
}


namespace up2 {
using up::bf16x8; using up::f32x16; using up::half_sum; using up::sumsq8;
typedef unsigned u32x4 __attribute__((ext_vector_type(4)));
typedef unsigned u32x2 __attribute__((ext_vector_type(2)));
__device__ __forceinline__ u32x2 pack4(float a, float b, float c, float d) { u32x2 r; r.x = att::cvtpk(a, b); r.y = att::cvtpk(c, d); return r; }
constexpr int STG_OFF = 69632, STG_WAVE = 8704;
template <int CH, int RS> __device__ __forceinline__ void tile_store(LAS char* stg, char* gbase, int gpitch, int lane) {
    asm volatile("s_waitcnt lgkmcnt(0)" : "+v"(lane) :: "memory");
#pragma unroll
    for (int j = 0; j < CH / 2; ++j) { const int id = lane + 64 * j, row = id / CH, c = id % CH;
        const u32x4 v = *(const LAS u32x4*)(stg + row * RS + c * 16);
        *(u32x4*)(gbase + (size_t)row * gpitch + c * 16) = v; }
}
__device__ __forceinline__ void wdma(const bf16_t* tile, int npieces8, LAS char* wbuf, int wave, int lane) {
    asm volatile("" : "+v"(lane));
#pragma unroll
    for (int j = 0; j < 6; ++j) if (j < npieces8) { const int p = wave + 8 * j;
        __builtin_amdgcn_global_load_lds((const unsigned*)((const char*)tile + p * 1024 + lane * 16), (LAS unsigned*)(wbuf + p * 1024), 16, 0, 0); }
}
__device__ __forceinline__ void up_unit(const Params& P, Frame& F, int tb, int hh) {
    const int lane = F.lane, wave = F.wave, r32 = lane & 31, hi = lane >> 5;
    const int tw0 = tb * 256 + wave * 32, t = tw0 + r32, b = tw0 / SEQ, sw0 = tw0 % SEQ;
    LAS char* wbuf = (LAS char*)F.lds; LAS char* stg = (LAS char*)F.lds + STG_OFF + wave * STG_WAVE;
#define LOAD_ROPE() int tl_ = t; asm volatile("" : "+v"(tl_) :: "memory"); const float* rp_ = F.rope + (size_t)tl_ * 32 + 4 * hi; \
    const float4 c0 = *(const float4*)(rp_), c1 = *(const float4*)(rp_ + 8), s0 = *(const float4*)(rp_ + 16), s1 = *(const float4*)(rp_ + 24); \
    const float cs[8] = {c0.x, c0.y, c0.z, c0.w, c1.x, c1.y, c1.z, c1.w}, sn[8] = {s0.x, s0.y, s0.z, s0.w, s1.x, s1.y, s1.z, s1.w};
    __syncthreads();
    wdma(F.WUQ + (size_t)(hh * 4) * 24576, 6, wbuf, wave, lane);
    {
        bf16x8 bq[16]; float ssq = 0.f;
#pragma unroll
        for (int ks = 0; ks < 16; ++ks) { bq[ks] = *reinterpret_cast<const bf16x8*>(F.QL + (size_t)t * 256 + ks * 16 + hi * 8); ssq += sumsq8(bq[ks]); }
        ssq = half_sum(ssq);
        const float rq = rsqrtf(ssq * (1.f / QLORA) + EPS);
#pragma unroll 1
        for (int hq = 0; hq < 4; ++hq) {
            const int h = hh * 4 + hq;
            asm volatile("s_waitcnt vmcnt(0)" ::: "memory"); __syncthreads();
            f32x16 acc[3] = {};
#pragma unroll
            for (int i = 0; i < 3; ++i)
#pragma unroll
                for (int ks = 0; ks < 16; ++ks) { const bf16x8 a = *(const LAS bf16x8*)(wbuf + ((i * 16 + ks) * 64 + lane) * 16); acc[i] = __builtin_amdgcn_mfma_f32_32x32x16_bf16(a, bq[ks], acc[i], 0, 0, 0); if ((ks & 3) == 3) asm volatile("" ::: "memory"); }
            __syncthreads();
            if (hq < 3) wdma(F.WUQ + (size_t)(h + 1) * 24576, 6, wbuf, wave, lane); else wdma(F.WUKV + (size_t)(hh * 4) * 16384, 4, wbuf, wave, lane);
            const float* gqn = P.g_qnorm; asm volatile("" : "+s"(gqn) :: "memory");
            float s2 = 0.f;
#pragma unroll
            for (int i = 0; i < 3; ++i)
#pragma unroll
                for (int r = 0; r < 16; ++r) { acc[i][r] *= rq; s2 += acc[i][r] * acc[i][r]; }
            s2 = half_sum(s2);
            const float rh = rsqrtf(s2 * (1.f / DQK) + EPS);
#pragma unroll
            for (int i = 0; i < 3; ++i) {
#pragma unroll
                for (int rg = 0; rg < 4; ++rg) { const float4 g = *(const float4*)(gqn + 32 * i + 8 * rg + 4 * hi);
                    acc[i][4 * rg + 0] *= rh * g.x; acc[i][4 * rg + 1] *= rh * g.y; acc[i][4 * rg + 2] *= rh * g.z; acc[i][4 * rg + 3] *= rh * g.w; }
                if (i == 2) { LOAD_ROPE();
#pragma unroll
                    for (int r = 0; r < 8; ++r) { const float x1 = acc[2][r], x2 = acc[2][r + 8]; acc[2][r] = x1 * cs[r] - x2 * sn[r]; acc[2][r + 8] = x2 * cs[r] + x1 * sn[r]; } }
#pragma unroll
                for (int rg = 0; rg < 4; ++rg) *(LAS u32x2*)(stg + r32 * 208 + (32 * i + 8 * rg + 4 * hi) * 2) = pack4(acc[i][4 * rg], acc[i][4 * rg + 1], acc[i][4 * rg + 2], acc[i][4 * rg + 3]);
                asm volatile("" ::: "memory");
            }
            tile_store<12, 208>(stg, (char*)(F.Q + ((size_t)(b * NH + h) * SEQ + sw0) * DQK), DQK * 2, lane);
        }
    }
    {
        bf16x8 bk[8]; float ssq = 0.f;
        int t2 = t; asm volatile("" : "+v"(t2) :: "memory");
#pragma unroll
        for (int ks = 0; ks < 8; ++ks) { bk[ks] = *reinterpret_cast<const bf16x8*>(F.KVL + (size_t)t2 * 160 + ks * 16 + hi * 8); ssq += sumsq8(bk[ks]); }
        ssq = half_sum(ssq);
        const float rkv = rsqrtf(ssq * (1.f / KVLORA) + EPS);
        float kr[16]; float kr2 = 0.f;
#pragma unroll
        for (int rg = 0; rg < 4; ++rg) { const uint2 w = *(const uint2*)(F.KVL + (size_t)t2 * 160 + 128 + 8 * rg + 4 * hi);
            kr[4 * rg + 0] = __uint_as_float(w.x << 16); kr[4 * rg + 1] = __uint_as_float(w.x & 0xffff0000u); kr[4 * rg + 2] = __uint_as_float(w.y << 16); kr[4 * rg + 3] = __uint_as_float(w.y & 0xffff0000u); }
#pragma unroll
        for (int r = 0; r < 16; ++r) kr2 += kr[r] * kr[r];
#pragma unroll 1
        for (int hq = 0; hq < 4; ++hq) {
            const int h = hh * 4 + hq;
            asm volatile("s_waitcnt vmcnt(0)" ::: "memory"); __syncthreads();
            f32x16 acc[4] = {};
#pragma unroll
            for (int i = 0; i < 4; ++i)
#pragma unroll
                for (int ks = 0; ks < 8; ++ks) { const bf16x8 a = *(const LAS bf16x8*)(wbuf + ((i * 8 + ks) * 64 + lane) * 16); acc[i] = __builtin_amdgcn_mfma_f32_32x32x16_bf16(a, bk[ks], acc[i], 0, 0, 0); if ((ks & 3) == 3) asm volatile("" ::: "memory"); }
            __syncthreads();
            if (hq < 3) wdma(F.WUKV + (size_t)(h + 1) * 16384, 4, wbuf, wave, lane);
            const float* gkn = P.g_knorm; asm volatile("" : "+s"(gkn) :: "memory");
            float s2 = kr2;
#pragma unroll
            for (int i = 0; i < 4; ++i)
#pragma unroll
                for (int r = 0; r < 16; ++r) { acc[i][r] *= rkv; if (i < 2) s2 += acc[i][r] * acc[i][r]; }
            s2 = half_sum(s2);
            const float rh = rsqrtf(s2 * (1.f / DQK) + EPS);
#pragma unroll
            for (int i = 0; i < 2; ++i) {
#pragma unroll
                for (int rg = 0; rg < 4; ++rg) { const float4 g = *(const float4*)(gkn + 32 * i + 8 * rg + 4 * hi);
                    *(LAS u32x2*)(stg + r32 * 208 + (32 * i + 8 * rg + 4 * hi) * 2) = pack4(acc[i][4 * rg] * rh * g.x, acc[i][4 * rg + 1] * rh * g.y, acc[i][4 * rg + 2] * rh * g.z, acc[i][4 * rg + 3] * rh * g.w); }
                asm volatile("" ::: "memory"); }
            { float kn[16];
#pragma unroll
            for (int rg = 0; rg < 4; ++rg) { const float4 g = *(const float4*)(gkn + 64 + 8 * rg + 4 * hi);
                kn[4 * rg] = kr[4 * rg] * rh * g.x; kn[4 * rg + 1] = kr[4 * rg + 1] * rh * g.y; kn[4 * rg + 2] = kr[4 * rg + 2] * rh * g.z; kn[4 * rg + 3] = kr[4 * rg + 3] * rh * g.w; }
            { LOAD_ROPE();
#pragma unroll
            for (int r = 0; r < 8; ++r) { const float x1 = kn[r], x2 = kn[r + 8]; kn[r] = x1 * cs[r] - x2 * sn[r]; kn[r + 8] = x2 * cs[r] + x1 * sn[r]; } }
#pragma unroll
            for (int rg = 0; rg < 4; ++rg) *(LAS u32x2*)(stg + r32 * 208 + (64 + 8 * rg + 4 * hi) * 2) = pack4(kn[4 * rg], kn[4 * rg + 1], kn[4 * rg + 2], kn[4 * rg + 3]); }
            tile_store<12, 208>(stg, (char*)(F.K + ((size_t)(b * NH + h) * SEQ + sw0) * DQK), DQK * 2, lane);
#pragma unroll
            for (int i = 0; i < 2; ++i)
#pragma unroll
                for (int rg = 0; rg < 4; ++rg) *(LAS u32x2*)(stg + r32 * 144 + (32 * i + 8 * rg + 4 * hi) * 2) = pack4(acc[2 + i][4 * rg], acc[2 + i][4 * rg + 1], acc[2 + i][4 * rg + 2], acc[2 + i][4 * rg + 3]);
            tile_store<8, 144>(stg, (char*)(F.V + ((size_t)(b * NH + h) * SEQ + sw0) * DV), DV * 2, lane);
        }
    }
#undef LOAD_ROPE
}
__device__ __forceinline__ void pool_unit(const Params& P, Frame& F, int tb, int pr) {
    const int tid = F.tid, lane = F.lane, wave = F.wave, r32 = lane & 31, hi = lane >> 5;
    const int t0 = tb * 256, b = t0 / SEQ, s0 = t0 % SEQ, tw0 = t0 + wave * 32, t = tw0 + r32, s = s0 + wave * 32 + r32;
    LAS char* ut = (LAS char*)F.lds; LAS char* stg = (LAS char*)F.lds + STG_OFF + wave * STG_WAVE;
#pragma unroll 1
    for (int gsel = 0; gsel < 2; ++gsel) {
        const int gi = pr ? (gsel ? 2 : 1) : (gsel ? 3 : 0), half = 1 << gi, nrows = 256 + 2 * half;
        __syncthreads();
        for (int id = tid; id < nrows * 16; id += NTHREADS) { const int lr = id >> 4, c = id & 15, srow = s0 - half + lr;
            if (srow >= 0 && srow < SEQ) { const u32x4 v = *(const u32x4*)(F.UP + ((size_t)b * SEQ + srow) * 512 + gi * 128 + c * 8);
                *(LAS u32x4*)(ut + lr * 256 + ((c ^ (lr & 15)) << 4)) = v; } }
#pragma unroll
        for (int j = 0; j < 8; ++j) { const int id = lane + 64 * j, row = id >> 4, c = id & 15;
            *(LAS u32x4*)(stg + row * 272 + c * 16) = *(const u32x4*)(F.GP + (size_t)(tw0 + row) * 512 + gi * 128 + c * 8); }
        __syncthreads();
        const int lrow = wave * 32 + r32 + half;
        const int lo = (s - half) > 0 ? (s - half) : 0, hi_ = (s + half) < SEQ ? (s + half) : SEQ;
        const float inv = 1.f / (float)(hi_ - lo);
        bf16x8 bd[8];
#pragma unroll
        for (int ks = 0; ks < 8; ++ks) {
            const int chunk = ks * 2 + hi;
            float sum[8];
#pragma unroll
            for (int j = 0; j < 8; ++j) sum[j] = 0.f;
#pragma unroll 2
            for (int i = 0; i < 2 * half; ++i) { const int sp = s - half + i, lr = lrow - half + i; const bool ok = (sp >= 0) && (sp < SEQ);
                const bf16x8 v = *(const LAS bf16x8*)(ut + lr * 256 + ((chunk ^ (lr & 15)) << 4));
#pragma unroll
                for (int j = 0; j < 8; ++j) sum[j] += ok ? bf2f((bf16_t)v[j]) : 0.f; }
            const bf16x8 own = *(const LAS bf16x8*)(ut + lrow * 256 + ((chunk ^ (lrow & 15)) << 4));
            float d[8];
#pragma unroll
            for (int j = 0; j < 8; ++j) d[j] = sum[j] * inv - bf2f((bf16_t)own[j]);
            u32x4 w; w.x = att::cvtpk(d[0], d[1]); w.y = att::cvtpk(d[2], d[3]); w.z = att::cvtpk(d[4], d[5]); w.w = att::cvtpk(d[6], d[7]);
            bd[ks] = *reinterpret_cast<bf16x8*>(&w);
        }
        f32x16 acc[4] = {};
        const bf16_t* wf = F.WPOOL + (size_t)(gi * 4) * 8 * 512 + lane * 8;
#pragma unroll
        for (int i = 0; i < 4; ++i) {
#pragma unroll
            for (int ks = 0; ks < 8; ++ks) { const bf16x8 a = *reinterpret_cast<const bf16x8*>(wf + (size_t)(i * 8 + ks) * 512); acc[i] = __builtin_amdgcn_mfma_f32_32x32x16_bf16(a, bd[ks], acc[i], 0, 0, 0); }
            asm volatile("" ::: "memory"); }
#pragma unroll
        for (int i = 0; i < 4; ++i)
#pragma unroll
            for (int rg = 0; rg < 4; ++rg) { const int nl = 32 * i + 8 * rg + 4 * hi;
                LAS u32x2* sp = (LAS u32x2*)(stg + r32 * 272 + nl * 2);
                const u32x2 gw = *sp; const float4 ps = *(const float4*)(P.pool_scale + gi * 128 + nl);
                const float g0 = __uint_as_float(gw.x << 16), g1 = __uint_as_float(gw.x & 0xffff0000u), g2 = __uint_as_float(gw.y << 16), g3 = __uint_as_float(gw.y & 0xffff0000u);
                *sp = pack4(acc[i][4 * rg] * ps.x * siluf(g0), acc[i][4 * rg + 1] * ps.y * siluf(g1), acc[i][4 * rg + 2] * ps.z * siluf(g2), acc[i][4 * rg + 3] * ps.w * siluf(g3)); }
        tile_store<16, 272>(stg, (char*)(F.Y + (size_t)tw0 * 1024 + gi * 128), 2048, lane);
    }
}
__device__ __forceinline__ void ph3_v2(const Params& P, Frame& F) {
    for (int u = F.vb; u < 256; u += F.G) up_unit(P, F, u >> 1, u & 1);
    for (int u = F.vb; u < 256; u += F.G) pool_unit(P, F, u >> 1, u & 1);
    __syncthreads();
}
}

__device__ __forceinline__ void ph4_attn_mfma(const Params& P, Frame& F) {
    for (int u = F.vb; u < NB * NH * 8; u += F.G) {
        const int bh = u >> 3, qb = u & 7, b = bh / NH, h = bh % NH;
        const size_t t0 = (size_t)b * SEQ + qb * 256;
        att::attn_unit(F.Q + ((size_t)bh * SEQ + qb * 256) * DQK, F.K + (size_t)bh * SEQ * DQK, F.V + (size_t)bh * SEQ * DV,
                       F.GA + t0 * 512 + h * 64, F.Y + t0 * 1024 + 512 + h * 64, (LAS char*)F.lds);
    }
}

__global__ void __launch_bounds__(NTHREADS, 2) fwd_kernel(Params P) {
    extern __shared__ __attribute__((aligned(16))) unsigned char lds[];
    Frame F;
    F.lds = (LAS unsigned char*)lds;
    F.tid = threadIdx.x; F.lane = F.tid & 63; F.wave = __builtin_amdgcn_readfirstlane(F.tid >> 6);
    F.G = gridDim.x; { const int bx = blockIdx.x; F.vb = (F.G % 8 == 0) ? (bx % 8) * (F.G / 8) + bx / 8 : bx; }
    unsigned char* ws = P.ws;
    F.modp = (float*)(ws + WS_MODP); F.rope = (float*)(ws + WS_ROPE); F.gate = (float*)(ws + WS_GATE);
    F.WIN = (bf16_t*)(ws + WS_WIN); F.WUQ = (bf16_t*)(ws + WS_WUQ); F.WUKV = (bf16_t*)(ws + WS_WUKV); F.WPOOL = (bf16_t*)(ws + WS_WPOOL); F.WOUT = (bf16_t*)(ws + WS_WOUT);
    F.XN = (bf16_t*)(ws + WS_XN); F.UP = (bf16_t*)(ws + WS_UP); F.GP = (bf16_t*)(ws + WS_GP); F.GA = (bf16_t*)(ws + WS_GA);
    F.QL = (bf16_t*)(ws + WS_QL); F.KVL = (bf16_t*)(ws + WS_KVL); F.Q = (bf16_t*)(ws + WS_Q); F.K = (bf16_t*)(ws + WS_K); F.V = (bf16_t*)(ws + WS_V); F.Y = (bf16_t*)(ws + WS_Y);
    volatile LAS unsigned* MISC = (volatile LAS unsigned*)(F.lds + MISC_OFF);
    for (int u = F.tid; u < (LDS_BYTES - LDSCTL_OFF) / 4; u += NTHREADS) ((LAS unsigned*)(F.lds + LDSCTL_OFF))[u] = 0u;
    __syncthreads();
    const int lo = P.ph_lo, hi = P.ph_hi;
    XcdBarrier bar; bar.bar = (unsigned*)(ws + WS_CTL) + CW_BAR; bar.x = 0; bar.st = nullptr;
    if (hi - lo > 1) bar = xcd_barrier_post((unsigned*)(ws + WS_CTL) + CW_BAR, MISC + 8);
#define IN(k) (lo <= (k) && (k) < hi)
#define SEAM(k) do { if (IN(k) && IN((k) + 1)) xcd_barrier(bar); } while (0)
    if (IN(0)) { ph0_mod(P, F); ph0_weights(P, F); up::p0_frag_weights(P, F); } SEAM(0);
    if (IN(1)) { ph1_xn(P, F); } SEAM(1);
    if (IN(2)) { pg8::Gemm g{F.XN, F.WIN, TOK, 2048, DM}; pg8::StaticOrder S; S.init(TOK, 2048, F.G, (int)blockIdx.x);
        pg8::EpiInProj E{F.UP, F.GP, F.GA, F.QL, F.KVL};
        pg8::gemm_phase<pg8::EpiInProj, pg8::StaticOrder, true, true>(F.lds, g, S, E); } SEAM(2);
    if (IN(3)) { up2::ph3_v2(P, F); } SEAM(3);
    if (IN(4)) { ph4_attn_mfma(P, F); } SEAM(4);
    if (IN(5)) { pg8::Gemm g{F.Y, F.WOUT, TOK, DM, DM}; pg8::StaticOrder S; S.init(TOK, DM, F.G, (int)blockIdx.x);
        pg8::EpiOut E{P.x, F.gate, P.out};
        pg8::gemm_phase<pg8::EpiOut, pg8::StaticOrder, true, true>(F.lds, g, S, E); }
#undef IN
#undef SEAM
}

extern "C" void kernel_launch(void* const* d_in, const int* in_sizes, int n_in, void* d_out, int out_size, void* d_ws, size_t ws_size, hipStream_t stream) {
    static int grid = 0;
    if (grid == 0) {
        if (n_in != 16 || in_sizes[0] != TOK * DM || out_size != TOK * DM || ws_size < WS_END) {
            fprintf(stderr, "kernel_launch: shape mismatch: n_in %d in0 %d out %d ws %zu\n", n_in, n_in > 0 ? in_sizes[0] : -1, out_size, ws_size); grid = -1; return; }
        int dev = 0, cus = 0, per_cu = 0;
        if (hipGetDevice(&dev) != hipSuccess || hipDeviceGetAttribute(&cus, hipDeviceAttributeMultiprocessorCount, dev) != hipSuccess) { grid = -1; return; }
        if (hipFuncSetAttribute((const void*)fwd_kernel, hipFuncAttributeMaxDynamicSharedMemorySize, LDS_BYTES) != hipSuccess) { fprintf(stderr, "kernel_launch: hipFuncSetAttribute failed\n"); grid = -1; return; }
        if (hipOccupancyMaxActiveBlocksPerMultiprocessor(&per_cu, (const void*)fwd_kernel, NTHREADS, LDS_BYTES) != hipSuccess || per_cu < 1) {
            fprintf(stderr, "kernel_launch: occupancy query reports %d blocks per CU\n", per_cu); (void)hipGetLastError(); grid = -1; return; }
        grid = cus;
    }
    if (grid < 0) return;
    (void)hipMemsetAsync((char*)d_ws + WS_CTL, 0, CTL_ZERO_BYTES, stream);
    Params p{};
    p.x = (const float*)d_in[0]; p.c = (const float*)d_in[1]; p.pos = (const int*)d_in[2]; p.ada_w = (const float*)d_in[3]; p.ada_b = (const float*)d_in[4];
    p.norm_g = (const float*)d_in[5]; p.w_in = (const float*)d_in[6]; p.pool_w = (const float*)d_in[7]; p.pool_scale = (const float*)d_in[8];
    p.g_q_lat = (const float*)d_in[9]; p.w_uq = (const float*)d_in[10]; p.g_kv_lat = (const float*)d_in[11]; p.w_ukv = (const float*)d_in[12];
    p.g_qnorm = (const float*)d_in[13]; p.g_knorm = (const float*)d_in[14]; p.w_out = (const float*)d_in[15];
    p.out = (float*)d_out; p.ws = (unsigned char*)d_ws;
    if (MK_N_LAUNCHES == 1) {
        p.ph_lo = 0; p.ph_hi = N_PHASES;
        hipLaunchKernelGGL(fwd_kernel, dim3(grid), dim3(NTHREADS), LDS_BYTES, stream, p);
    } else {
        for (int k = 0; k < N_PHASES; ++k) { p.ph_lo = k; p.ph_hi = k + 1; hipLaunchKernelGGL(fwd_kernel, dim3(grid), dim3(NTHREADS), LDS_BYTES, stream, p); }
    }
    const hipError_t le = hipPeekAtLastError();
    if (le != hipSuccess) fprintf(stderr, "kernel_launch: launch failed: %s\n", hipGetErrorName(le));
}
```

```cpp
#include <hip/hip_runtime.h>
#include <cstdio>
#include <cstdint>

#ifndef PROBE_DUP
#define PROBE_DUP -1
#endif
#ifndef MK_N_LAUNCHES
#define MK_N_LAUNCHES 1
#endif

#define GAS __attribute__((address_space(1)))
#define LAS __attribute__((address_space(3)))
typedef unsigned short bf16_t;

constexpr int DM = 1024, NB = 16, SEQ = 2048, TOK = NB * SEQ;
constexpr int NH = 8, DQK = 96, DNOPE = 64, DROPE = 32, DV = 64, QLORA = 256, KVLORA = 128, INW = 1952;
constexpr int OFF_UP = 0, OFF_GP = 512, OFF_QL = 1024, OFF_KVL = 1280, OFF_KR = 1408, OFF_GA = 1440;
constexpr float EPS = 1e-6f;
constexpr float CQ = 0.10206207261596577f * 1.4426950408889634f;
constexpr int NTHREADS = 512, NWAVES = 8;
constexpr int N_PHASES = 6;

constexpr size_t MiB = 1u << 20;
constexpr size_t WS_CTL = 0, CTL_ZERO_BYTES = 1 * MiB;
constexpr size_t WS_MODP = 1 * MiB;
constexpr size_t WS_ROPE = 2 * MiB;
constexpr size_t WS_GATE = 1 * MiB + 786432;
constexpr size_t WS_WIN = 6 * MiB;
constexpr size_t WS_WUQ = 10 * MiB;
constexpr size_t WS_WUKV = 11 * MiB;
constexpr size_t WS_WPOOL = 12 * MiB;
constexpr size_t WS_WOUT = 13 * MiB;
constexpr size_t WS_XN = 16 * MiB;
constexpr size_t WS_UP = 80 * MiB;
constexpr size_t WS_GP = 112 * MiB;
constexpr size_t WS_GA = 144 * MiB;
constexpr size_t WS_QL = 176 * MiB;
constexpr size_t WS_KVL = 192 * MiB;
constexpr size_t WS_Q = 208 * MiB;
constexpr size_t WS_K = 256 * MiB;
constexpr size_t WS_V = 304 * MiB;
constexpr size_t WS_Y = 336 * MiB;
constexpr size_t WS_END = 400 * MiB;
constexpr int CW_BAR = 4096;

constexpr int RING_BYTES = 143360;
constexpr int LDSCTL_OFF = RING_BYTES, MISC_OFF = LDSCTL_OFF + 320;
constexpr int LDS_BYTES = 147456;

__device__ const float INVF[16] = {1.0f, 0.5623413251903491f, 0.31622776601683794f, 0.1778279410038923f, 0.1f, 0.05623413251903491f, 0.03162277660168379f,
                                   0.01778279410038923f, 0.01f, 0.005623413251903491f, 0.003162277660168379f, 0.001778279410038923f, 0.001f,
                                   0.0005623413251903491f, 0.00031622776601683794f, 0.0001778279410038923f};

__device__ __forceinline__ float bf2f(bf16_t v) { return __uint_as_float(((unsigned)v) << 16); }
__device__ __forceinline__ bf16_t f2bf(float f) { unsigned u = __float_as_uint(f); return (bf16_t)((u + 0x7fffu + ((u >> 16) & 1u)) >> 16); }
__device__ __forceinline__ float siluf(float v) { return v / (1.f + __expf(-v)); }
__device__ __forceinline__ float wave_sum(float v) {
#pragma unroll
    for (int o = 1; o < 64; o <<= 1) v += __shfl_xor(v, o);
    return v;
}

struct Params {
    const float *x, *c; const int* pos; const float *ada_w, *ada_b, *norm_g, *w_in, *pool_w, *pool_scale, *g_q_lat, *w_uq, *g_kv_lat, *w_ukv, *g_qnorm, *g_knorm, *w_out;
    float* out; unsigned char* ws; int ph_lo, ph_hi, li, pad;
};

#define XB_TMO      128
#define XB_XCNT(j)  (256  + 64 * (j))
#define XB_XSUB(j)  (1280 + 64 * (j))
#define XB_XGEN(j)  (2304 + 64 * (j))
#define XB_TOP      3328
#define XB_TOPGEN   3392
#define XCD_BAR_WORDS 3456
#define XB_SPIN_CAP (1u << 22)
__device__ __forceinline__ unsigned xb_ld(unsigned* p)              { return __hip_atomic_load(p, __ATOMIC_RELAXED, __HIP_MEMORY_SCOPE_AGENT); }
__device__ __forceinline__ unsigned xb_add(unsigned* p, unsigned v) { return __hip_atomic_fetch_add(p, v, __ATOMIC_RELAXED, __HIP_MEMORY_SCOPE_AGENT); }
__device__ __forceinline__ unsigned xb_xcc_id() { return (unsigned)__builtin_amdgcn_s_getreg((3 << 11) | 20) & 0xFu; }
#define XB_SPIN(cond, bar) do { unsigned _sp = 0; while (cond) { __builtin_amdgcn_s_sleep(1); \
    if ((++_sp & 255u) == 0u) { if (xb_ld(&(bar)[XB_TMO])) break; if (_sp > XB_SPIN_CAP) { atomicAdd(&(bar)[XB_TMO], 1u); break; } } } } while (0)
struct XcdBarrier { unsigned* bar; unsigned x; volatile LAS unsigned* st; };
__device__ __forceinline__ XcdBarrier xcd_barrier_post(unsigned* bar, volatile LAS unsigned* st) {
    XcdBarrier b; b.bar = bar; b.x = xb_xcc_id(); b.st = st;
    if (threadIdx.x == 0) (void)xb_add(&bar[XB_XCNT(b.x)], 1u);
    return b;
}
__device__ __forceinline__ void xcd_barrier_complete(unsigned* bar, unsigned x, unsigned& nloc, unsigned& nx) {
    const unsigned G = gridDim.x * gridDim.y * gridDim.z;
    unsigned sum, cnt, mine, sp = 0u;
    for (;;) {
        sum = 0u; cnt = 0u; mine = 0u;
#pragma unroll
        for (unsigned j = 0; j < 16; ++j) { const unsigned c = xb_ld(&bar[XB_XCNT(j)]); sum += c; cnt += (c > 0u) ? 1u : 0u; mine = (j == x) ? c : mine; }
        if (sum == G) break;
        __builtin_amdgcn_s_sleep(1);
        if ((++sp & 255u) == 0u) { if (xb_ld(&bar[XB_TMO])) break; if (sp > XB_SPIN_CAP) { atomicAdd(&bar[XB_TMO], 1u); break; } }
    }
    nloc = mine > 0u ? mine : 1u; nx = cnt > 0u ? cnt : 1u;
}
__device__ __forceinline__ void xcd_barrier(const XcdBarrier& b) {
    asm volatile("s_waitcnt vmcnt(0)" ::: "memory");
    __syncthreads();
    if (threadIdx.x == 0) {
        unsigned* bar = b.bar;
        __builtin_amdgcn_s_waitcnt(0);
        unsigned nloc = b.st[0], nx = b.st[1];
        if (nloc == 0u) { xcd_barrier_complete(bar, b.x, nloc, nx); b.st[0] = nloc; b.st[1] = nx; }
        const unsigned old = xb_add(&bar[XB_XSUB(b.x)], 1u);
        const unsigned gen = old / nloc;
        if (old + 1u == (gen + 1u) * nloc) {
            __builtin_amdgcn_fence(__ATOMIC_RELEASE, "agent");
            asm volatile("s_waitcnt vmcnt(0)" ::: "memory");
            const unsigned og = xb_add(&bar[XB_TOP], 1u);
            const unsigned tg = og / nx;
            if (og + 1u == (tg + 1u) * nx) xb_add(&bar[XB_TOPGEN], 1u);
            else XB_SPIN(xb_ld(&bar[XB_TOPGEN]) == tg, bar);
            __builtin_amdgcn_fence(__ATOMIC_ACQUIRE, "agent");
            xb_add(&bar[XB_XGEN(b.x)], 1u);
            asm volatile("s_waitcnt vmcnt(0)" ::: "memory");
        } else {
            XB_SPIN(xb_ld(&bar[XB_XGEN(b.x)]) == gen, bar);
            __builtin_amdgcn_fence(__ATOMIC_ACQUIRE, "agent");
            asm volatile("s_waitcnt vmcnt(0)" ::: "memory");
        }
    }
    __syncthreads();
}


namespace pg8 {
#define PG8_LAS __attribute__((address_space(3)))
typedef short bf16x8 __attribute__((ext_vector_type(8)));
typedef float f32x4 __attribute__((ext_vector_type(4)));
typedef unsigned u32x4 __attribute__((ext_vector_type(4)));
constexpr int BM = 256, BK = 64, HALF = 128, HTB = HALF * BK * 2, STAGE_BYTES = 8 * HTB, NXCD = 8, WGM = 8;
__host__ __device__ __forceinline__ int lds_byte(int r, int c) { const int st = (r >> 4) * 2 + (c >> 5), rr = r & 15, cc = c & 31, ob = rr * 64 + cc * 2; return st * 1024 + (ob ^ (((ob >> 9) & 1) << 5)); }
__host__ __device__ __forceinline__ void stage_rc(int b, int& R, int& C) { const int st = b / 1024, sb = b % 1024, swz = sb ^ (((sb >> 9) & 1) << 5); R = (st >> 1) * 16 + swz / 64; C = (st & 1) * 32 + (swz % 64) / 2; }
__host__ __device__ __forceinline__ int perm32(int rho) { const int n = rho >> 4, i = rho & 15; return 8 * (i >> 2) + 4 * n + (i & 3); }
struct Unit { int pm, pn; };
struct Gemm { const bf16_t* A; const bf16_t* Bt; int M, N, K; };
struct StaticOrder {
    int nM, nN, nwg, G, c;
    __host__ __device__ void init(int M, int N, int G_, int c_) { nM = M / BM; nN = N / BM; nwg = nM * nN; G = G_; c = c_; }
    __host__ __device__ bool next(int i, Unit& u) const {
        const long L = (long)i * G + c; if (L >= nwg) return false;
        int wgid = (int)L; { const int q = nwg / NXCD, r = nwg % NXCD, xcd = wgid % NXCD, off = wgid / NXCD; wgid = (xcd < r ? xcd * (q + 1) : r * (q + 1) + (xcd - r) * q) + off; }
        const int nig = WGM * nN, gid = wgid / nig, fm = gid * WGM, gsz = (nM - fm) < WGM ? (nM - fm) : WGM;
        u.pm = fm + ((wgid % nig) % gsz); u.pn = (wgid % nig) / gsz; return true;
    }
    __device__ __forceinline__ void a_ready(const Unit&) const {}
    __device__ __forceinline__ void done(const Unit&) const {}
};
__device__ __forceinline__ unsigned cvt_pk_bf16(float lo, float hi) { unsigned r; asm volatile("v_cvt_pk_bf16_f32 %0, %1, %2" : "=v"(r) : "v"(lo), "v"(hi)); return r; }

struct EpiInProj {
    static constexpr bool PERM = true, AFTER_DRAIN = false;
    bf16_t *UP, *GP, *GA, *QL, *KVL;
    __device__ __forceinline__ void operator()(const f32x4 (&acc)[2][2][4][2], const Unit& u, int wr, int wc, int fr, int fq) const {
        const int row0 = u.pm * BM + wr * 64 + fr;
        bf16_t* base; int ldc, ncols = 256;
        switch (u.pn) {
            case 0: base = UP; ldc = 512; break;       case 1: base = UP + 256; ldc = 512; break;
            case 2: base = GP; ldc = 512; break;       case 3: base = GP + 256; ldc = 512; break;
            case 4: base = GA; ldc = 512; break;       case 5: base = GA + 256; ldc = 512; break;
            case 6: base = QL; ldc = 256; break;       default: base = KVL; ldc = 160; ncols = 160; break;
        }
        const int col0 = wc * 32 + 8 * fq;
#pragma unroll
        for (int ai = 0; ai < 2; ++ai)
#pragma unroll
            for (int m = 0; m < 4; ++m) { bf16_t* rowp = base + (size_t)(row0 + ai * HALF + m * 16) * ldc + col0;
#pragma unroll
                for (int bj = 0; bj < 2; ++bj) { const f32x4 v0 = acc[ai][bj][m][0], v1 = acc[ai][bj][m][1];
                    u32x4 w; w.x = cvt_pk_bf16(v0[0], v0[1]); w.y = cvt_pk_bf16(v0[2], v0[3]); w.z = cvt_pk_bf16(v1[0], v1[1]); w.w = cvt_pk_bf16(v1[2], v1[3]);
                    if (col0 + bj * HALF < ncols) *(u32x4*)(rowp + bj * HALF) = w; } }
    }
};
struct EpiOut {
    static constexpr bool PERM = false, AFTER_DRAIN = false;
    const float* x; const float* gate; float* out;
    __device__ __forceinline__ void operator()(const f32x4 (&acc)[2][2][4][2], const Unit& u, int wr, int wc, int fr, int fq) const {
        const int col0 = u.pn * BM + wc * 32 + 4 * fq; const int b = (u.pm * BM) / SEQ;
        f32x4 gv[2][2];
#pragma unroll
        for (int bj = 0; bj < 2; ++bj)
#pragma unroll
            for (int n = 0; n < 2; ++n) gv[bj][n] = *(const f32x4*)(gate + (size_t)b * 1024 + col0 + bj * HALF + n * 16);
#pragma unroll
        for (int ai = 0; ai < 2; ++ai)
#pragma unroll
            for (int m = 0; m < 4; ++m) { const size_t off = (size_t)(u.pm * BM + ai * HALF + wr * 64 + m * 16 + fr) * 1024 + col0;
#pragma unroll
                for (int bj = 0; bj < 2; ++bj)
#pragma unroll
                    for (int n = 0; n < 2; ++n) { const f32x4 xs = *(const f32x4*)(x + off + bj * HALF + n * 16);
                        *(f32x4*)(out + off + bj * HALF + n * 16) = xs + gv[bj][n] * acc[ai][bj][m][n]; }
                if (m & 1) asm volatile("" ::: "memory"); }
    }
};

template <class Epi, class Sched, bool ALIGN_EPI = false, bool SP2 = false>
__device__ __forceinline__ void gemm_phase(PG8_LAS unsigned char* lds, const Gemm g, const Sched& S, const Epi& E) {
    const int tid = threadIdx.x, wid = __builtin_amdgcn_readfirstlane(tid >> 6), lane = tid & 63, wr = wid >> 2, wc = wid & 3, fr = lane & 15, fq = lane >> 4;
    const int K = g.K, nt = K / BK;
    unsigned voffA[2], voffB[2];
#pragma unroll
    for (int i = 0; i < 2; ++i) { int R, C; stage_rc(tid * 16 + i * 8192, R, C); const int Rb = Epi::PERM ? ((R & ~31) + perm32(R & 31)) : R;
        voffA[i] = (unsigned)(R * K + C) * 2u; voffB[i] = (unsigned)(Rb * K + C) * 2u; }
    const size_t kstep = (size_t)(BK * 2);
    const size_t hstep = (size_t)HALF * K * 2;
    const size_t tstep = 2 * hstep;
    const unsigned ldsw = (unsigned)wid * 1024u;
    const int aoff = lds_byte(wr * 64 + fr, fq * 8), boff = lds_byte(wc * 32 + fr, fq * 8);
#define PG8_SA(b, h) (((b) * 2 + (h)) * HTB)
#define PG8_SB(b, h) ((4 + (b) * 2 + (h)) * HTB)
#define PG8_STAGE(bufoff, gbase, voff) do { _Pragma("unroll") for (int _i = 0; _i < 2; ++_i) \
        __builtin_amdgcn_global_load_lds((const unsigned*)((const char*)(gbase) + (voff)[_i]), (PG8_LAS unsigned*)(lds + (bufoff) + ldsw + _i * 8192), 16, 0, 0); } while (0)
#define PG8_LDA(dst, b, h) do { _Pragma("unroll") for (int m = 0; m < 4; ++m) _Pragma("unroll") for (int k = 0; k < 2; ++k) dst[m][k] = *(const PG8_LAS bf16x8*)(lds + PG8_SA(b, h) + aoff + m * 2048 + k * 1024); } while (0)
#define PG8_LDB(dst, b, h) do { _Pragma("unroll") for (int n = 0; n < 2; ++n) _Pragma("unroll") for (int k = 0; k < 2; ++k) dst[n][k] = *(const PG8_LAS bf16x8*)(lds + PG8_SB(b, h) + boff + n * 2048 + k * 1024); } while (0)
#define PG8_MMA(ai, bj, At, Bt) do { __builtin_amdgcn_s_setprio(1); _Pragma("unroll") for (int m = 0; m < 4; ++m) _Pragma("unroll") for (int n = 0; n < 2; ++n) _Pragma("unroll") for (int k = 0; k < 2; ++k) \
        acc[ai][bj][m][n] = __builtin_amdgcn_mfma_f32_16x16x32_bf16(Bt[n][k], At[m][k], acc[ai][bj][m][n], 0, 0, 0); __builtin_amdgcn_s_setprio(0); } while (0)
#define PG8_WAIT_V(n) asm volatile("s_waitcnt vmcnt(" #n ")" ::: "memory")
#define PG8_WAIT_L(n) asm volatile("s_waitcnt lgkmcnt(" #n ")" ::: "memory")
#define PG8_BAR __builtin_amdgcn_s_barrier()
#define PG8_SCHED __builtin_amdgcn_sched_barrier(0)
    Unit cur, nxt; int ui = 0;
    if (!S.next(0, cur)) return;
    f32x4 acc[2][2][4][2];
#pragma unroll
    for (int a = 0; a < 2; ++a)
#pragma unroll
        for (int b = 0; b < 2; ++b)
#pragma unroll
            for (int m = 0; m < 4; ++m)
#pragma unroll
                for (int n = 0; n < 2; ++n) acc[a][b][m][n] = (f32x4){0.f, 0.f, 0.f, 0.f};
    bf16x8 At[4][2], B0[2][2], B1[2][2];
    const char* cA = (const char*)g.A + (size_t)cur.pm * tstep; const char* cB = (const char*)g.Bt + (size_t)cur.pn * tstep;
    S.a_ready(cur);
    if constexpr (SP2) {
        PG8_STAGE(PG8_SB(0, 0), cB, voffB); PG8_STAGE(PG8_SB(0, 1), cB + hstep, voffB); PG8_STAGE(PG8_SA(0, 0), cA, voffA); PG8_STAGE(PG8_SA(0, 1), cA + hstep, voffA);
        if (wr == 1) PG8_BAR;
        PG8_WAIT_V(2); PG8_BAR;
        PG8_STAGE(PG8_SB(1, 0), cB + kstep, voffB); PG8_STAGE(PG8_SA(1, 0), cA + kstep, voffA); PG8_STAGE(PG8_SB(1, 1), cB + hstep + kstep, voffB);
        PG8_WAIT_V(6); PG8_BAR;
    } else {
        PG8_STAGE(PG8_SB(0, 0), cB, voffB); PG8_STAGE(PG8_SA(0, 0), cA, voffA); PG8_STAGE(PG8_SB(0, 1), cB + hstep, voffB); PG8_STAGE(PG8_SA(0, 1), cA + hstep, voffA);
        if (wr == 1) PG8_BAR;
        PG8_WAIT_V(4); PG8_BAR;
        PG8_STAGE(PG8_SB(1, 0), cB + kstep, voffB); PG8_STAGE(PG8_SA(1, 0), cA + kstep, voffA); PG8_STAGE(PG8_SB(1, 1), cB + hstep + kstep, voffB);
        PG8_WAIT_V(6); PG8_BAR;
    }
    for (;;) {
        const bool has_next = S.next(ui + 1, nxt);
        const char* nA = has_next ? (const char*)g.A + (size_t)nxt.pm * tstep : cA; const char* nB = has_next ? (const char*)g.Bt + (size_t)nxt.pn * tstep : cB;
        for (int t = 0; t < nt; t += 2) {
            const bool last = (t == nt - 2);
            const char* a1 = cA + (size_t)(t + 1) * kstep;
            const char* a2 = last ? nA : cA + (size_t)(t + 2) * kstep; const char* b2 = last ? nB : cB + (size_t)(t + 2) * kstep;
            const char* a3 = a2 + kstep; const char* b3 = b2 + kstep;
            if (last && has_next) S.a_ready(nxt);
            if constexpr (SP2) {
            PG8_LDB(B0, 0, 0); PG8_LDB(B1, 0, 1); PG8_SCHED; PG8_LDA(At, 0, 0); PG8_STAGE(PG8_SA(1, 1), a1 + hstep, voffA);
            PG8_WAIT_V(8); PG8_WAIT_L(0); PG8_BAR; PG8_MMA(0, 0, At, B0); PG8_MMA(0, 1, At, B1); PG8_BAR; PG8_SCHED;
            PG8_LDA(At, 0, 1); PG8_STAGE(PG8_SB(0, 0), b2, voffB); PG8_STAGE(PG8_SB(0, 1), b2 + hstep, voffB); PG8_STAGE(PG8_SA(0, 0), a2, voffA);
            PG8_WAIT_V(8); PG8_WAIT_L(0); PG8_BAR; PG8_MMA(1, 0, At, B0); PG8_MMA(1, 1, At, B1); PG8_BAR; PG8_SCHED;
            PG8_LDB(B0, 1, 0); PG8_LDB(B1, 1, 1); PG8_SCHED; PG8_LDA(At, 1, 0); PG8_STAGE(PG8_SA(0, 1), a2 + hstep, voffA);
            PG8_WAIT_V(8); PG8_WAIT_L(0); PG8_BAR; PG8_MMA(0, 0, At, B0); PG8_MMA(0, 1, At, B1); PG8_BAR; PG8_SCHED;
            PG8_LDA(At, 1, 1); PG8_STAGE(PG8_SB(1, 0), b3, voffB); PG8_STAGE(PG8_SB(1, 1), b3 + hstep, voffB); PG8_STAGE(PG8_SA(1, 0), a3, voffA);
            PG8_WAIT_V(8); PG8_WAIT_L(0); PG8_BAR; PG8_MMA(1, 0, At, B0); PG8_MMA(1, 1, At, B1); PG8_BAR; PG8_SCHED;
            } else {
            PG8_LDB(B0, 0, 0); PG8_SCHED; PG8_LDA(At, 0, 0); PG8_STAGE(PG8_SA(1, 1), a1 + hstep, voffA);
            PG8_WAIT_L(8); PG8_BAR; PG8_WAIT_L(0); PG8_MMA(0, 0, At, B0); PG8_BAR; PG8_SCHED;
            PG8_LDB(B1, 0, 1); PG8_STAGE(PG8_SB(0, 0), b2, voffB);
            PG8_BAR; PG8_WAIT_L(0); PG8_MMA(0, 1, At, B1); PG8_BAR;
            PG8_LDA(At, 0, 1); PG8_STAGE(PG8_SA(0, 0), a2, voffA);
            PG8_BAR; PG8_WAIT_L(0); PG8_MMA(1, 0, At, B0); PG8_BAR; PG8_SCHED;
            PG8_STAGE(PG8_SB(0, 1), b2 + hstep, voffB);
            PG8_WAIT_V(6); PG8_BAR; PG8_MMA(1, 1, At, B1); PG8_BAR;
            PG8_LDB(B0, 1, 0); PG8_SCHED; PG8_LDA(At, 1, 0); PG8_STAGE(PG8_SA(0, 1), a2 + hstep, voffA);
            PG8_WAIT_L(8); PG8_BAR; PG8_WAIT_L(0); PG8_MMA(0, 0, At, B0); PG8_BAR; PG8_SCHED;
            PG8_LDB(B1, 1, 1); PG8_STAGE(PG8_SB(1, 0), b3, voffB);
            PG8_BAR; PG8_WAIT_L(0); PG8_MMA(0, 1, At, B1); PG8_BAR;
            PG8_LDA(At, 1, 1); PG8_STAGE(PG8_SA(1, 0), a3, voffA);
            PG8_BAR; PG8_WAIT_L(0); PG8_MMA(1, 0, At, B0); PG8_BAR; PG8_SCHED;
            PG8_STAGE(PG8_SB(1, 1), b3 + hstep, voffB);
            PG8_WAIT_V(6); PG8_BAR; PG8_MMA(1, 1, At, B1); PG8_BAR;
            }
        }
        if constexpr (ALIGN_EPI) { if (wr == 0) PG8_BAR; }
        if constexpr (!Epi::AFTER_DRAIN) { E(acc, cur, wr, wc, fr, fq); S.done(cur); }
        if (!has_next) break;
#pragma unroll
        for (int a = 0; a < 2; ++a)
#pragma unroll
            for (int b = 0; b < 2; ++b)
#pragma unroll
                for (int m = 0; m < 4; ++m)
#pragma unroll
                    for (int n = 0; n < 2; ++n) acc[a][b][m][n] = (f32x4){0.f, 0.f, 0.f, 0.f};
        cur = nxt; cA = nA; cB = nB; ++ui;
        if constexpr (ALIGN_EPI) { if (wr == 1) PG8_BAR; }
    }
    PG8_WAIT_V(0);
    if constexpr (!ALIGN_EPI) { if (wr == 0) PG8_BAR; }
    PG8_BAR;
#undef PG8_SA
#undef PG8_SB
#undef PG8_STAGE
#undef PG8_LDA
#undef PG8_LDB
#undef PG8_MMA
#undef PG8_WAIT_V
#undef PG8_WAIT_L
#undef PG8_BAR
#undef PG8_SCHED
}
}


namespace att {
using bf16x8 = __attribute__((ext_vector_type(8))) short;
using s16x4  = __attribute__((ext_vector_type(4))) short;
using f32x16 = __attribute__((ext_vector_type(16))) float;
using u32x4  = __attribute__((ext_vector_type(4))) unsigned;
constexpr int NW = 8, QBLK = 32, KVBLK = 64;
constexpr float SCALE = 0.10206207261596577f;
constexpr float THR = 8.f;
constexpr int SHM_V = 16384, SHM_K = 16384, SHM_ATTN = 2 * SHM_V + 2 * SHM_K + NW * 64 * 4;
#define KSWZ(row, colB) ((row) * 256 + ((colB) ^ (((row) & 15) << 4)))
#define SBAR() __builtin_amdgcn_sched_barrier(0)
__device__ __forceinline__ int crow(int r, int hi) { return (r & 3) + 8 * (r >> 2) + 4 * hi; }
__device__ __forceinline__ unsigned cvtpk(float lo, float hi) { unsigned r; asm volatile("v_cvt_pk_bf16_f32 %0, %1, %2" : "=v"(r) : "v"(lo), "v"(hi)); return r; }
__device__ __forceinline__ void partialSM(f32x16& p0, f32x16& p1, float& m_reg, float& mn, float& alpha) {
  constexpr float C = 1.f;
  float pmax = p0[0]; for (int r = 1; r < 16; ++r) pmax = fmaxf(pmax, p0[r]); for (int r = 0; r < 16; ++r) pmax = fmaxf(pmax, p1[r]);
  { auto rr = __builtin_amdgcn_permlane32_swap(__float_as_uint(pmax), __float_as_uint(pmax), false, false);
    pmax = fmaxf(__uint_as_float(rr[0]), __uint_as_float(rr[1])); }
  if (__builtin_expect(__all(pmax - m_reg <= THR * 1.4426950408889634f), 1)) { mn = m_reg; alpha = 1.f; }
  else { mn = fmaxf(m_reg, pmax); alpha = __builtin_amdgcn_exp2f((m_reg - mn) * C); m_reg = mn; }
  float mnC = -mn * C;
  for (int r = 0; r < 16; ++r) p0[r] = fmaf(p0[r], C, mnC); for (int r = 0; r < 16; ++r) p1[r] = fmaf(p1[r], C, mnC);
  for (int r = 0; r < 16; ++r) p0[r] = __builtin_amdgcn_exp2f(p0[r]);
}
__device__ __forceinline__ void finishSM(f32x16& p0, f32x16& p1, float alpha, float& l_reg, bf16x8& pa0, bf16x8& pa1, bf16x8& pa2, bf16x8& pa3) {
  for (int r = 0; r < 16; ++r) p1[r] = __builtin_amdgcn_exp2f(p1[r]);
  float ps = 0; for (int r = 0; r < 16; ++r) ps += p0[r]; for (int r = 0; r < 16; ++r) ps += p1[r];
  { auto rr = __builtin_amdgcn_permlane32_swap(__float_as_uint(ps), __float_as_uint(ps), false, false);
    ps = __uint_as_float(rr[0]) + __uint_as_float(rr[1]); }
  l_reg = l_reg * alpha + ps;
#define PK4(P, BASE, OUT) do { unsigned a0 = cvtpk(P[BASE + 0], P[BASE + 1]), a1 = cvtpk(P[BASE + 2], P[BASE + 3]);   \
    unsigned b0 = cvtpk(P[BASE + 4], P[BASE + 5]), b1 = cvtpk(P[BASE + 6], P[BASE + 7]);                              \
    auto r0 = __builtin_amdgcn_permlane32_swap(a0, b0, false, false); auto r1 = __builtin_amdgcn_permlane32_swap(a1, b1, false, false); \
    u32x4 w = {r0[0], r1[0], r0[1], r1[1]}; OUT = *reinterpret_cast<bf16x8*>(&w); } while (0)
  PK4(p0, 0, pa0); PK4(p0, 8, pa1); PK4(p1, 0, pa2); PK4(p1, 8, pa3);
#undef PK4
}
__device__ __forceinline__ void qkt(f32x16& p0, f32x16& p1, const LAS char* Ks, const bf16x8* qr, int r32, int hi) {
  p0 = f32x16{}; p1 = f32x16{};
#pragma unroll
  for (int d0 = 0; d0 < 6; ++d0) { int cb = (d0 * 16 + hi * 8) * 2;
    bf16x8 b0 = *reinterpret_cast<const LAS bf16x8*>(Ks + KSWZ(r32, cb));
    bf16x8 b1 = *reinterpret_cast<const LAS bf16x8*>(Ks + KSWZ(32 + r32, cb));
    p0 = __builtin_amdgcn_mfma_f32_32x32x16_bf16(b0, qr[d0], p0, 0, 0, 0);
    p1 = __builtin_amdgcn_mfma_f32_32x32x16_bf16(b1, qr[d0], p1, 0, 0, 0); }
}
__device__ __forceinline__ int v_st(int k, int c) { const int kk = (k & ~0xC) | ((k & 4) << 1) | ((k & 8) >> 1); return ((kk >> 3) * 4 + (c >> 5)) * 512 + ((kk & 7) * 32 + (c & 31)) * 2; }
__device__ __forceinline__ int v_rd_base(int lane) { return ((lane & 3) << 3) | (((lane >> 2) & 3) << 6) | (((lane >> 4) & 1) << 5) | (((lane >> 5) & 1) << 8); }
constexpr int v_rd_off(int d0, int ks, int half) { return d0 * 512 + ks * 4096 + half * 2048; }
template <int OFF> __device__ __forceinline__ s16x4 tr_read(int vb) {
  s16x4 r; asm volatile("ds_read_b64_tr_b16 %0, %1 offset:%2" : "=&v"(r) : "v"(vb), "i"(OFF) : "memory"); return r;
}
template <int D0> __device__ __forceinline__ void pv_one(f32x16& od, int vb, bf16x8 pa0, bf16x8 pa1, bf16x8 pa2, bf16x8 pa3) {
  const s16x4 l0 = tr_read<v_rd_off(D0, 0, 0)>(vb), h0 = tr_read<v_rd_off(D0, 0, 1)>(vb), l1 = tr_read<v_rd_off(D0, 1, 0)>(vb), h1 = tr_read<v_rd_off(D0, 1, 1)>(vb);
  const s16x4 l2 = tr_read<v_rd_off(D0, 2, 0)>(vb), h2 = tr_read<v_rd_off(D0, 2, 1)>(vb), l3 = tr_read<v_rd_off(D0, 3, 0)>(vb), h3 = tr_read<v_rd_off(D0, 3, 1)>(vb);
  asm volatile("s_waitcnt lgkmcnt(0)" ::: "memory"); SBAR();
#define PK(L, H) (bf16x8){L[0], L[1], L[2], L[3], H[0], H[1], H[2], H[3]}
  od = __builtin_amdgcn_mfma_f32_32x32x16_bf16(pa0, PK(l0, h0), od, 0, 0, 0);
  od = __builtin_amdgcn_mfma_f32_32x32x16_bf16(pa1, PK(l1, h1), od, 0, 0, 0);
  od = __builtin_amdgcn_mfma_f32_32x32x16_bf16(pa2, PK(l2, h2), od, 0, 0, 0);
  od = __builtin_amdgcn_mfma_f32_32x32x16_bf16(pa3, PK(l3, h3), od, 0, 0, 0);
#undef PK
}
__device__ __forceinline__ void pv_d0(f32x16* o, int vb, bf16x8 pa0, bf16x8 pa1, bf16x8 pa2, bf16x8 pa3) {
  pv_one<0>(o[0], vb, pa0, pa1, pa2, pa3); pv_one<1>(o[1], vb, pa0, pa1, pa2, pa3);
}
__device__ __forceinline__ void attn_unit(const bf16_t* Qb, const bf16_t* Kh, const bf16_t* Vh, const bf16_t* GAb, bf16_t* Yb, LAS char* lds) {
  const int tid = threadIdx.x, wid = tid >> 6, lane = tid & 63, r32 = lane & 31, hi = lane >> 5;
  LAS char* V_lds = lds; LAS char* K_lds = lds + 2 * SHM_V;
  LAS float* ws = (LAS float*)(lds + 2 * SHM_V + 2 * SHM_K) + wid * 64; LAS float* li_l = ws; LAS float* al_l = ws + 32;
  float m_reg = -1e30f, l_reg = 0; f32x16 o[2] = {}; bf16x8 qr[6];
  const bf16_t* Qw = Qb + (size_t)(wid * QBLK + r32) * DQK + hi * 8;
#pragma unroll
  for (int d0 = 0; d0 < 6; ++d0) qr[d0] = *reinterpret_cast<const bf16x8*>(Qw + d0 * 16);
  const int kst0 = KSWZ(tid / 12, (tid % 12) * 16), kst1 = KSWZ((512 + tid) / 12, ((512 + tid) % 12) * 16);
  const bool k2 = __builtin_amdgcn_readfirstlane(wid) < 4;
  const int vst = v_st(tid >> 3, (tid & 7) * 8);
  const int vb0 = (int)(uintptr_t)V_lds + v_rd_base(lane);
  struct { bf16x8 k0, k1, v; } sr_[2];
#define SLOAD(i, key0) do { const bf16_t* kp_ = Kh + (size_t)(key0) * DQK; sr_[i].k0 = *reinterpret_cast<const bf16x8*>(kp_ + tid * 8); \
    if (k2) sr_[i].k1 = *reinterpret_cast<const bf16x8*>(kp_ + (512 + tid) * 8); sr_[i].v = *reinterpret_cast<const bf16x8*>(Vh + (size_t)(key0) * DV + tid * 8); } while (0)
#define SWRITE(b, i) do { *(LAS bf16x8*)(K_lds + (b) * SHM_K + kst0) = sr_[i].k0; if (k2) *(LAS bf16x8*)(K_lds + (b) * SHM_K + kst1) = sr_[i].k1; \
    *(LAS bf16x8*)(V_lds + (b) * SHM_V + vst) = sr_[i].v; } while (0)
#define RESC(a) do { if (__any((a) < 1.f)) { if (hi == 0) al_l[r32] = (a); asm volatile("s_waitcnt lgkmcnt(0)" ::: "memory"); \
    for (int d = 0; d < 2; ++d) for (int r = 0; r < 16; ++r) o[d][r] *= al_l[crow(r, hi)]; } } while (0)
  f32x16 pA0, pA1, pB0, pB1; float mnA, mnB, alA, alB; bf16x8 pa0, pa1, pa2, pa3; constexpr int NT = SEQ / KVBLK;
  constexpr int SE = 0, SO = 1;
  SLOAD(SE, 0); SWRITE(0, SE); __syncthreads();
  qkt(pA0, pA1, K_lds, qr, r32, hi); partialSM(pA0, pA1, m_reg, mnA, alA);
  SLOAD(SO, KVBLK); SLOAD(SE, 2 * KVBLK);
  SWRITE(1, SO); __syncthreads();
  for (int j = 1; j + 1 < NT; j += 2) {
    SBAR(); qkt(pB0, pB1, K_lds + SHM_K, qr, r32, hi);
    finishSM(pA0, pA1, alA, l_reg, pa0, pa1, pa2, pa3); SBAR();
    SLOAD(SO, (j + 2) * KVBLK); SBAR();
    pv_d0(o, vb0, pa0, pa1, pa2, pa3); partialSM(pB0, pB1, m_reg, mnB, alB);
    __syncthreads(); SWRITE(0, SE);
    RESC(alB); __syncthreads();
    SBAR(); qkt(pA0, pA1, K_lds, qr, r32, hi);
    finishSM(pB0, pB1, alB, l_reg, pa0, pa1, pa2, pa3); SBAR();
    if (j + 3 < NT) SLOAD(SE, (j + 3) * KVBLK); SBAR();
    pv_d0(o, vb0 + SHM_V, pa0, pa1, pa2, pa3); partialSM(pA0, pA1, m_reg, mnA, alA);
    __syncthreads(); SWRITE(1, SO);
    RESC(alA); __syncthreads();
  }
  SBAR(); qkt(pB0, pB1, K_lds + SHM_K, qr, r32, hi);
  finishSM(pA0, pA1, alA, l_reg, pa0, pa1, pa2, pa3); SBAR();
  pv_d0(o, vb0, pa0, pa1, pa2, pa3); partialSM(pB0, pB1, m_reg, mnB, alB);
  __syncthreads(); RESC(alB);
  finishSM(pB0, pB1, alB, l_reg, pa0, pa1, pa2, pa3); SBAR();
  pv_d0(o, vb0 + SHM_V, pa0, pa1, pa2, pa3);
  if (hi == 0) li_l[r32] = l_reg; asm volatile("s_waitcnt lgkmcnt(0)" ::: "memory");
  float rli[16];
#pragma unroll
  for (int r = 0; r < 16; ++r) rli[r] = __builtin_amdgcn_rcpf(li_l[crow(r, hi)]);
#pragma unroll
  for (int r = 0; r < 16; ++r) { const int orow = wid * QBLK + crow(r, hi);
#pragma unroll
    for (int d0 = 0; d0 < 2; ++d0) { const int col = d0 * 32 + r32; const float g = bf2f(GAb[(size_t)orow * 512 + col]);
      Yb[(size_t)orow * 1024 + col] = f2bf(o[d0][r] * rli[r] * siluf(g)); } }
  __syncthreads();
#undef SLOAD
#undef SWRITE
#undef RESC
}

constexpr int DST = 5, DSTB = 24576, DV_OFF = 16384;
template <int D0> __device__ __forceinline__ void pv_one_c(f32x16& od, int vb, bf16x8 pa0, bf16x8 pa1, bf16x8 pa2, bf16x8 pa3) {
  const s16x4 l0 = tr_read<D0 * 512 + 0>(vb), h0 = tr_read<D0 * 512 + 1024>(vb), l1 = tr_read<D0 * 512 + 2048>(vb), h1 = tr_read<D0 * 512 + 3072>(vb);
  const s16x4 l2 = tr_read<D0 * 512 + 4096>(vb), h2 = tr_read<D0 * 512 + 5120>(vb), l3 = tr_read<D0 * 512 + 6144>(vb), h3 = tr_read<D0 * 512 + 7168>(vb);
  asm volatile("s_waitcnt lgkmcnt(0)" ::: "memory"); SBAR();
#define PK(L, H) (bf16x8){L[0], L[1], L[2], L[3], H[0], H[1], H[2], H[3]}
  od = __builtin_amdgcn_mfma_f32_32x32x16_bf16(pa0, PK(l0, h0), od, 0, 0, 0);
  od = __builtin_amdgcn_mfma_f32_32x32x16_bf16(pa1, PK(l1, h1), od, 0, 0, 0);
  od = __builtin_amdgcn_mfma_f32_32x32x16_bf16(pa2, PK(l2, h2), od, 0, 0, 0);
  od = __builtin_amdgcn_mfma_f32_32x32x16_bf16(pa3, PK(l3, h3), od, 0, 0, 0);
#undef PK
}
__device__ __forceinline__ void attn_unit_fast(const bf16_t* Qb, const bf16_t* Kh, const bf16_t* Vh, const bf16_t* GAb, bf16_t* Yb, LAS char* lds) {
  const int tid = threadIdx.x, wid = __builtin_amdgcn_readfirstlane(tid >> 6), lane = tid & 63, r32 = lane & 31, hi = lane >> 5;
  LAS float* li_l = (LAS float*)(lds + DST * DSTB) + wid * 64;
  bf16x8 qr[6];
  const bf16_t* Qw = Qb + (size_t)(wid * QBLK + r32) * DQK + hi * 8;
#pragma unroll
  for (int d0 = 0; d0 < 6; ++d0) qr[d0] = *reinterpret_cast<const bf16x8*>(Qw + d0 * 16);
  asm volatile("" : "+v"(qr[0]), "+v"(qr[1]), "+v"(qr[2]), "+v"(qr[3]), "+v"(qr[4]), "+v"(qr[5]));
  const f32x16 zero16 = {};
  f32x16 o[2] = {}; float l_acc = 0.f;
  unsigned koff0, koff1, voff;
  { const int row0 = 8 * wid + (lane >> 4), row1 = row0 + 4, ph = lane & 15; const int lg0 = ph ^ (row0 & 15), lg1 = ph ^ (row1 & 15);
    koff0 = (unsigned)(row0 * 192 + (lg0 < 12 ? lg0 : 0) * 16); koff1 = (unsigned)(row1 * 192 + (lg1 < 12 ? lg1 : 0) * 16);
    const int st = 2 * wid + (lane >> 5), s = lane & 31, k = (st >> 1) * 8 + (s >> 2), c = (st & 1) * 32 + 8 * (s & 3); voff = (unsigned)(k * 128 + c * 2); }
#define DMA_TILE(t, sb) do { const char* kt_ = (const char*)Kh + (size_t)(t) * (KVBLK * DQK * 2); const char* vt_ = (const char*)Vh + (size_t)(t) * (KVBLK * DV * 2); \
    __builtin_amdgcn_global_load_lds((const unsigned*)(kt_ + koff0), (LAS unsigned*)(lds + (sb) + (2 * wid) * 1024), 16, 0, 0); \
    __builtin_amdgcn_global_load_lds((const unsigned*)(kt_ + koff1), (LAS unsigned*)(lds + (sb) + (2 * wid + 1) * 1024), 16, 0, 0); \
    __builtin_amdgcn_global_load_lds((const unsigned*)(vt_ + voff), (LAS unsigned*)(lds + (sb) + DV_OFF + wid * 1024), 16, 0, 0); } while (0)
  const int vb0 = (int)(uintptr_t)lds + DV_OFF + v_rd_base(lane);
  constexpr int NT = SEQ / KVBLK;
  f32x16 pA0, pA1, pB0, pB1; bf16x8 pa0, pa1, pa2, pa3;
#define FQKT(P0, P1, off) do { const LAS char* Ks = lds + (off); \
    _Pragma("unroll") for (int d0 = 0; d0 < 6; ++d0) { const int cb = (d0 * 16 + hi * 8) * 2; \
      const bf16x8 b0 = *reinterpret_cast<const LAS bf16x8*>(Ks + KSWZ(r32, cb)); \
      const bf16x8 b1 = *reinterpret_cast<const LAS bf16x8*>(Ks + KSWZ(32 + r32, cb)); \
      P0 = __builtin_amdgcn_mfma_f32_32x32x16_bf16(b0, qr[d0], d0 == 0 ? zero16 : P0, 0, 0, 0); \
      P1 = __builtin_amdgcn_mfma_f32_32x32x16_bf16(b1, qr[d0], d0 == 0 ? zero16 : P1, 0, 0, 0); \
      if (d0 & 1) asm volatile("" ::: "memory"); } } while (0)
#define FSOFT(P0, P1) do { \
    _Pragma("unroll") for (int r = 0; r < 16; ++r) P0[r] = __builtin_amdgcn_exp2f(P0[r]); \
    _Pragma("unroll") for (int r = 0; r < 16; ++r) P1[r] = __builtin_amdgcn_exp2f(P1[r]); \
    { float s_ = 0.f; _Pragma("unroll") for (int r = 0; r < 16; ++r) s_ += P0[r]; _Pragma("unroll") for (int r = 0; r < 16; ++r) s_ += P1[r]; l_acc += s_; } \
    { u32x4 w0 = {cvtpk(P0[0], P0[1]), cvtpk(P0[2], P0[3]), cvtpk(P0[4], P0[5]), cvtpk(P0[6], P0[7])}; pa0 = *reinterpret_cast<bf16x8*>(&w0); \
      u32x4 w1 = {cvtpk(P0[8], P0[9]), cvtpk(P0[10], P0[11]), cvtpk(P0[12], P0[13]), cvtpk(P0[14], P0[15])}; pa1 = *reinterpret_cast<bf16x8*>(&w1); \
      u32x4 w2 = {cvtpk(P1[0], P1[1]), cvtpk(P1[2], P1[3]), cvtpk(P1[4], P1[5]), cvtpk(P1[6], P1[7])}; pa2 = *reinterpret_cast<bf16x8*>(&w2); \
      u32x4 w3 = {cvtpk(P1[8], P1[9]), cvtpk(P1[10], P1[11]), cvtpk(P1[12], P1[13]), cvtpk(P1[14], P1[15])}; pa3 = *reinterpret_cast<bf16x8*>(&w3); } } while (0)
#define WAITBAR(N) asm volatile("s_waitcnt vmcnt(" #N ") lgkmcnt(0)\n\ts_barrier" ::: "memory")
  DMA_TILE(0, 0); DMA_TILE(1, DSTB); DMA_TILE(2, 2 * DSTB); DMA_TILE(3, 3 * DSTB);
  WAITBAR(6);
  FQKT(pA0, pA1, 0);
  int s_cur = 0, s_n1 = DSTB, s_n4 = 4 * DSTB;
#define ADV(x) ((x) == (DST - 1) * DSTB ? 0 : (x) + DSTB)
#define FSTEP(PC0, PC1, PN0, PN1, jj, L, Q, VM) do { \
    if (L) DMA_TILE((jj) + 4, s_n4); \
    SBAR(); \
    if (Q) FQKT(PN0, PN1, s_n1); \
    FSOFT(PC0, PC1); \
    SBAR(); \
    pv_one_c<0>(o[0], vb0 + s_cur, pa0, pa1, pa2, pa3); pv_one_c<1>(o[1], vb0 + s_cur, pa0, pa1, pa2, pa3); \
    WAITBAR(VM); \
    s_cur = s_n1; s_n1 = ADV(s_n1); s_n4 = ADV(s_n4); } while (0)
#pragma unroll 1
  for (int j = 0; j + 4 < NT; j += 2) { FSTEP(pA0, pA1, pB0, pB1, j, true, true, 6); FSTEP(pB0, pB1, pA0, pA1, j + 1, true, true, 6); }
  FSTEP(pA0, pA1, pB0, pB1, NT - 4, false, true, 3); FSTEP(pB0, pB1, pA0, pA1, NT - 3, false, true, 0);
  FSTEP(pA0, pA1, pB0, pB1, NT - 2, false, true, 0); FSTEP(pB0, pB1, pA0, pA1, NT - 1, false, false, 0);
#undef FQKT
#undef FSOFT
#undef FSTEP
#undef ADV
#undef WAITBAR
#undef DMA_TILE
  { auto rr = __builtin_amdgcn_permlane32_swap(__float_as_uint(l_acc), __float_as_uint(l_acc), false, false); l_acc = __uint_as_float(rr[0]) + __uint_as_float(rr[1]); }
  if (hi == 0) li_l[r32] = l_acc; asm volatile("s_waitcnt lgkmcnt(0)" ::: "memory");
  { int l2 = lane; asm volatile("" : "+v"(l2) :: "memory");
    const int r32b = l2 & 31, hib = l2 >> 5;
#pragma unroll
    for (int r = 0; r < 16; ++r) { const int orow = wid * QBLK + crow(r, hib); const float rl = __builtin_amdgcn_rcpf(li_l[crow(r, hib)]);
#pragma unroll
      for (int d0 = 0; d0 < 2; ++d0) { const int col = d0 * 32 + r32b; const float g = bf2f(GAb[(size_t)orow * 512 + col]);
        Yb[(size_t)orow * 1024 + col] = f2bf(o[d0][r] * rl * siluf(g)); } } }
  __syncthreads();
}
#undef KSWZ
#undef SBAR
}

struct Frame {
    LAS unsigned char* lds;
    int tid, lane, wave, vb, G;
    float* modp; float* rope; float* gate;
    bf16_t *WIN, *WUQ, *WUKV, *WPOOL, *WOUT;
    bf16_t *XN, *UP, *GP, *GA, *QL, *KVL, *Q, *K, *V, *Y;
};
__device__ __forceinline__ float mod_val(const Params& P, const Frame& F, int b, int e) {
    float s = P.ada_b[e];
#pragma unroll
    for (int kq = 0; kq < 4; ++kq) s += F.modp[((size_t)kq * 16 + b) * 3072 + e];
    return s;
}

__device__ __forceinline__ void ph0_mod(const Params& P, Frame& F) {
    LAS float* cact = (LAS float*)F.lds;
    LAS float* red = (LAS float*)(F.lds + 65536);
    bool have = false;
    for (int item = F.vb; item < 192; item += F.G) {
        if (!have) { for (int i = F.tid; i < 16384; i += NTHREADS) cact[i] = siluf(P.c[i]); __syncthreads(); have = true; }
        const int cg = item % 48, kq = item / 48;
        const int col = cg * 64 + F.lane, r0 = kq * 256 + F.wave * 32;
        float acc[16];
#pragma unroll
        for (int b = 0; b < 16; ++b) acc[b] = 0.f;
#pragma unroll 4
        for (int r = 0; r < 32; ++r) {
            const float w = P.ada_w[(size_t)(r0 + r) * 3072 + col];
#pragma unroll
            for (int b = 0; b < 16; ++b) acc[b] += cact[b * 1024 + r0 + r] * w;
        }
#pragma unroll
        for (int b = 0; b < 16; ++b) red[(F.wave * 16 + b) * 64 + F.lane] = acc[b];
        __syncthreads();
        for (int o = F.tid; o < 1024; o += NTHREADS) {
            const int b = o >> 6, cl = o & 63; float s = 0.f;
#pragma unroll
            for (int w = 0; w < 8; ++w) s += red[(w * 16 + b) * 64 + cl];
            F.modp[((size_t)kq * 16 + b) * 3072 + cg * 64 + cl] = s;
        }
        __syncthreads();
    }
}


__device__ __forceinline__ unsigned pk2(float lo, float hi) { return (unsigned)f2bf(lo) | ((unsigned)f2bf(hi) << 16); }
__device__ __forceinline__ void p0_transpose_item(const float* W, int K, int N, int nsrc0, bf16_t* WT, int ndst0, int k0, LAS float* scr, int lane) {
    if (nsrc0 >= 0) {
#pragma unroll 8
        for (int i = 0; i < 32; ++i) { const int kk = 2 * i + (lane >> 5); scr[kk * 33 + (lane & 31)] = W[(size_t)(k0 + kk) * N + nsrc0 + (lane & 31)]; }
    } else {
#pragma unroll 8
        for (int i = 0; i < 32; ++i) { const int kk = 2 * i + (lane >> 5); scr[kk * 33 + (lane & 31)] = 0.f; }
    }
    asm volatile("s_waitcnt lgkmcnt(0)" ::: "memory");
    const int c = lane & 7;
#pragma unroll
    for (int j = 0; j < 4; ++j) { const int n = (lane >> 3) + 8 * j; const LAS float* s = scr + (8 * c) * 33 + n;
        uint4 o; o.x = pk2(s[0 * 33], s[1 * 33]); o.y = pk2(s[2 * 33], s[3 * 33]); o.z = pk2(s[4 * 33], s[5 * 33]); o.w = pk2(s[6 * 33], s[7 * 33]);
        *(uint4*)(WT + (size_t)(ndst0 + n) * K + k0 + 8 * c) = o; }
    asm volatile("s_waitcnt lgkmcnt(0)" ::: "memory");
}
__device__ __forceinline__ int win_src_col(int n) { return n < 1024 ? n : (n < 1536 ? OFF_GA + (n - 1024) : (n < 1792 ? OFF_QL + (n - 1536) : (n < 1952 ? OFF_KVL + (n - 1792) : -1))); }
__device__ __forceinline__ void ph0_weights(const Params& P, Frame& F) {
    LAS float* scr = (LAS float*)(F.lds + F.wave * 16384);
    const int NGW = F.G * NWAVES, gw = NGW - 1 - (F.vb * NWAVES + F.wave);
    constexpr int I_IN = 16 * 64, I_OUT = 16 * 32;
    for (int it = gw; it < I_IN + I_OUT; it += NGW) {
        if (it < I_IN) { const int kb = it / 64, nb = it % 64; p0_transpose_item(P.w_in, DM, INW, win_src_col(32 * nb), F.WIN, 32 * nb, 64 * kb, scr, F.lane); }
        else { const int r = it - I_IN, kb = r / 32, nb = r % 32; p0_transpose_item(P.w_out, DM, DM, 32 * nb, F.WOUT, 32 * nb, 64 * kb, scr, F.lane); }
    }
}

__device__ __forceinline__ void ph1_xn(const Params& P, Frame& F) {
    LAS float* gs = (LAS float*)F.lds; LAS float* sh = gs + 1024;
    for (int item = F.vb; item < TOK / 128; item += F.G) {
        const int row0 = item * 128, b = row0 / SEQ;
        __syncthreads();
        for (int d = F.tid; d < 1024; d += NTHREADS) { const float sc = mod_val(P, F, b, 1024 + d), sf = mod_val(P, F, b, d); gs[d] = P.norm_g[d] * (1.f + sc); sh[d] = sf; }
        if (F.tid < 64) { const int n = (item % 16) * 64 + F.tid; F.gate[(size_t)b * 1024 + n] = mod_val(P, F, b, 2048 + n); }
        __syncthreads();
        for (int i = 0; i < 16; ++i) {
            const int t = row0 + F.wave * 16 + i;
            const float4* xr = (const float4*)(P.x + (size_t)t * 1024) + F.lane;
            float4 v[4]; float ss = 0.f;
#pragma unroll
            for (int j = 0; j < 4; ++j) { v[j] = xr[64 * j]; ss += (v[j].x * v[j].x + v[j].y * v[j].y) + (v[j].z * v[j].z + v[j].w * v[j].w); }
            ss = wave_sum(ss);
            const float r = rsqrtf(ss * (1.f / 1024.f) + EPS);
#pragma unroll
            for (int j = 0; j < 4; ++j) {
                const int d = 4 * F.lane + 256 * j;
                const float o0 = (v[j].x * r) * gs[d] + sh[d], o1 = (v[j].y * r) * gs[d + 1] + sh[d + 1], o2 = (v[j].z * r) * gs[d + 2] + sh[d + 2], o3 = (v[j].w * r) * gs[d + 3] + sh[d + 3];
                uint2 pk; pk.x = (unsigned)f2bf(o0) | ((unsigned)f2bf(o1) << 16); pk.y = (unsigned)f2bf(o2) | ((unsigned)f2bf(o3) << 16);
                *(uint2*)(F.XN + (size_t)t * 1024 + d) = pk;
            }
            if (F.lane < 16) {
                const float ang = (float)P.pos[t] * INVF[F.lane];
                float sn, cs; sincosf(ang, &sn, &cs);
                F.rope[(size_t)t * 32 + F.lane] = cs; F.rope[(size_t)t * 32 + 16 + F.lane] = sn;
            }
        }
    }
}

template <class AF, class BF, class EF>
__device__ __forceinline__ void naive_gemm(Frame& F, int M, int N, int K, AF a, BF bfn, EF epi) {
    LAS float* As = (LAS float*)F.lds;
    LAS float* Bs = As + 16 * 132;
    const int tx = F.tid & 31, ty = F.tid >> 5;
    const int ntm = M / 128, ntn = (N + 127) / 128;
    for (int tile = F.vb; tile < ntm * ntn; tile += F.G) {
        const int m0 = (tile / ntn) * 128, n0 = (tile % ntn) * 128;
        float acc[8][4];
#pragma unroll
        for (int i = 0; i < 8; ++i)
#pragma unroll
            for (int j = 0; j < 4; ++j) acc[i][j] = 0.f;
        for (int k0 = 0; k0 < K; k0 += 16) {
            __syncthreads();
#pragma unroll
            for (int i = 0; i < 4; ++i) { const int e = F.tid + i * NTHREADS; As[(e & 15) * 132 + (e >> 4)] = a(m0 + (e >> 4), k0 + (e & 15)); }
#pragma unroll
            for (int i = 0; i < 4; ++i) { const int e = F.tid + i * NTHREADS; Bs[(e >> 7) * 132 + (e & 127)] = bfn(k0 + (e >> 7), n0 + (e & 127)); }
            __syncthreads();
#pragma unroll
            for (int kk = 0; kk < 16; ++kk) {
                float av[8], bv[4];
#pragma unroll
                for (int i = 0; i < 8; ++i) av[i] = As[kk * 132 + ty * 8 + i];
#pragma unroll
                for (int j = 0; j < 4; ++j) bv[j] = Bs[kk * 132 + tx * 4 + j];
#pragma unroll
                for (int i = 0; i < 8; ++i)
#pragma unroll
                    for (int j = 0; j < 4; ++j) acc[i][j] += av[i] * bv[j];
            }
        }
#pragma unroll
        for (int i = 0; i < 8; ++i)
#pragma unroll
            for (int j = 0; j < 4; ++j) epi(m0 + ty * 8 + i, n0 + tx * 4 + j, acc[i][j]);
    }
    __syncthreads();
}

__device__ __forceinline__ void ph2_inproj(const Params& P, Frame& F) {
    const bf16_t* XN = F.XN; const float* W = P.w_in;
    bf16_t *UP = F.UP, *GP = F.GP, *GA = F.GA, *QL = F.QL, *KVL = F.KVL;
    naive_gemm(F, TOK, INW, DM,
        [=](int m, int k) { return bf2f(XN[(size_t)m * 1024 + k]); },
        [=](int k, int n) { return n < INW ? W[(size_t)k * INW + n] : 0.f; },
        [=](int m, int n, float v) {
            const bf16_t h = f2bf(v);
            if (n < OFF_GP) UP[(size_t)m * 512 + n] = h;
            else if (n < OFF_QL) GP[(size_t)m * 512 + (n - OFF_GP)] = h;
            else if (n < OFF_KVL) QL[(size_t)m * 256 + (n - OFF_QL)] = h;
            else if (n < OFF_GA) KVL[(size_t)m * 160 + (n - OFF_KVL)] = h;
            else if (n < INW) GA[(size_t)m * 512 + (n - OFF_GA)] = h;
        });
}

__device__ __forceinline__ void ph3_upproj(const Params& P, Frame& F) {
    const int gw = F.vb * NWAVES + F.wave, NGW = F.G * NWAVES;
    for (int wi = gw; wi < (TOK / 64) * NH; wi += NGW) {
        const int h = wi % NH, t = (wi / NH) * 64 + F.lane, b = t / SEQ, s = t % SEQ;
        float acc[DQK];
#pragma unroll
        for (int d = 0; d < DQK; ++d) acc[d] = 0.f;
        float ssq = 0.f;
        for (int r = 0; r < QLORA; ++r) {
            float a = bf2f(F.QL[(size_t)t * 256 + r]); ssq += a * a; a *= P.g_q_lat[r];
            const float* w = P.w_uq + (size_t)r * (NH * DQK) + h * DQK;
#pragma unroll
            for (int d = 0; d < DQK; ++d) acc[d] += a * w[d];
        }
        const float rq = rsqrtf(ssq * (1.f / QLORA) + EPS);
        float s2 = 0.f;
#pragma unroll
        for (int d = 0; d < DQK; ++d) { acc[d] *= rq; s2 += acc[d] * acc[d]; }
        const float rh = rsqrtf(s2 * (1.f / DQK) + EPS);
#pragma unroll
        for (int d = 0; d < DQK; ++d) acc[d] = acc[d] * rh * P.g_qnorm[d];
#pragma unroll
        for (int i = 0; i < 16; ++i) {
            const float cs = F.rope[(size_t)t * 32 + i], sn = F.rope[(size_t)t * 32 + 16 + i];
            const float x1 = acc[64 + i], x2 = acc[80 + i];
            acc[64 + i] = x1 * cs - x2 * sn; acc[80 + i] = x2 * cs + x1 * sn;
        }
        bf16_t* qo = F.Q + ((size_t)(b * NH + h) * SEQ + s) * DQK;
#pragma unroll
        for (int d = 0; d < DQK; d += 2) *(unsigned*)(qo + d) = (unsigned)f2bf(acc[d]) | ((unsigned)f2bf(acc[d + 1]) << 16);
    }
    for (int wi = gw; wi < (TOK / 64) * NH; wi += NGW) {
        const int h = wi % NH, t = (wi / NH) * 64 + F.lane, b = t / SEQ, s = t % SEQ;
        float acc[64];
#pragma unroll
        for (int d = 0; d < 64; ++d) acc[d] = 0.f;
        float ssq = 0.f;
        for (int r = 0; r < KVLORA; ++r) {
            float a = bf2f(F.KVL[(size_t)t * 160 + r]); ssq += a * a; a *= P.g_kv_lat[r];
            const float* w = P.w_ukv + (size_t)r * (NH * 128) + h * 128;
#pragma unroll
            for (int d = 0; d < 64; ++d) acc[d] += a * w[d];
        }
        const float rkv = rsqrtf(ssq * (1.f / KVLORA) + EPS);
        float s2 = 0.f;
#pragma unroll
        for (int d = 0; d < 64; ++d) { acc[d] *= rkv; s2 += acc[d] * acc[d]; }
        float kr[32];
#pragma unroll
        for (int i = 0; i < 32; ++i) { kr[i] = bf2f(F.KVL[(size_t)t * 160 + 128 + i]); s2 += kr[i] * kr[i]; }
        const float rh = rsqrtf(s2 * (1.f / DQK) + EPS);
#pragma unroll
        for (int d = 0; d < 64; ++d) acc[d] = acc[d] * rh * P.g_knorm[d];
#pragma unroll
        for (int i = 0; i < 32; ++i) kr[i] = kr[i] * rh * P.g_knorm[64 + i];
#pragma unroll
        for (int i = 0; i < 16; ++i) {
            const float cs = F.rope[(size_t)t * 32 + i], sn = F.rope[(size_t)t * 32 + 16 + i];
            const float x1 = kr[i], x2 = kr[16 + i];
            kr[i] = x1 * cs - x2 * sn; kr[16 + i] = x2 * cs + x1 * sn;
        }
        bf16_t* ko = F.K + ((size_t)(b * NH + h) * SEQ + s) * DQK;
#pragma unroll
        for (int d = 0; d < 64; d += 2) *(unsigned*)(ko + d) = (unsigned)f2bf(acc[d]) | ((unsigned)f2bf(acc[d + 1]) << 16);
#pragma unroll
        for (int i = 0; i < 32; i += 2) *(unsigned*)(ko + 64 + i) = (unsigned)f2bf(kr[i]) | ((unsigned)f2bf(kr[i + 1]) << 16);
    }
    for (int wi = gw; wi < (TOK / 64) * NH; wi += NGW) {
        const int h = wi % NH, t = (wi / NH) * 64 + F.lane, b = t / SEQ, s = t % SEQ;
        float acc[64];
#pragma unroll
        for (int d = 0; d < 64; ++d) acc[d] = 0.f;
        float ssq = 0.f;
        for (int r = 0; r < KVLORA; ++r) {
            float a = bf2f(F.KVL[(size_t)t * 160 + r]); ssq += a * a; a *= P.g_kv_lat[r];
            const float* w = P.w_ukv + (size_t)r * (NH * 128) + h * 128 + 64;
#pragma unroll
            for (int d = 0; d < 64; ++d) acc[d] += a * w[d];
        }
        const float rkv = rsqrtf(ssq * (1.f / KVLORA) + EPS);
        bf16_t* vo = F.V + ((size_t)(b * NH + h) * SEQ + s) * DV;
#pragma unroll
        for (int d = 0; d < 64; d += 2) *(unsigned*)(vo + d) = (unsigned)f2bf(acc[d] * rkv) | ((unsigned)f2bf(acc[d + 1] * rkv) << 16);
    }
}

__device__ __forceinline__ void ph3_pool(const Params& P, Frame& F) {
    LAS float* df = (LAS float*)F.lds;
    for (int item = F.vb; item < (TOK / 32) * 4; item += F.G) {
        const int tt = item >> 2, gi = item & 3, t0 = tt * 32, b = t0 / SEQ, s0 = t0 % SEQ, half = 1 << gi;
        __syncthreads();
        for (int e = F.tid; e < 4096; e += NTHREADS) {
            const int tl = e >> 7, c = e & 127, s = s0 + tl;
            const int lo = (s - half) > 0 ? (s - half) : 0, hi = (s + half) < SEQ ? (s + half) : SEQ;
            float sum = 0.f;
            for (int sp = lo; sp < hi; ++sp) sum += bf2f(F.UP[((size_t)b * SEQ + sp) * 512 + gi * 128 + c]);
            df[e] = sum / (float)(hi - lo) - bf2f(F.UP[((size_t)b * SEQ + s) * 512 + gi * 128 + c]);
        }
        __syncthreads();
        for (int o = F.tid; o < 4096; o += NTHREADS) {
            const int tl = o >> 7, d = o & 127;
            float acc = 0.f;
            for (int c = 0; c < 128; ++c) acc += df[tl * 128 + c] * P.pool_w[((size_t)gi * 128 + c) * 128 + d];
            const int n = gi * 128 + d, t = t0 + tl;
            const float g = bf2f(F.GP[(size_t)t * 512 + n]);
            F.Y[(size_t)t * 1024 + n] = f2bf(acc * P.pool_scale[n] * siluf(g));
        }
    }
    __syncthreads();
}

__device__ __forceinline__ void ph4_attn(const Params& P, Frame& F) {
    LAS float* Ks = (LAS float*)F.lds;
    LAS float* Vs = Ks + 64 * 96;
    const float scale = 0.10206207261596577f;
    const int hf = F.tid & 1, row = F.tid >> 1;
    for (int item = F.vb; item < NB * NH * 8; item += F.G) {
        const int bh = item >> 3, qb = item & 7, s = qb * 256 + row, b = bh / NH, h = bh % NH;
        float q[48];
        { const bf16_t* qp = F.Q + ((size_t)bh * SEQ + s) * DQK + hf * 48;
#pragma unroll
          for (int d = 0; d < 48; ++d) q[d] = bf2f(qp[d]) * scale; }
        float o[32];
#pragma unroll
        for (int d = 0; d < 32; ++d) o[d] = 0.f;
        float m = -1e30f, l = 0.f;
        for (int kt = 0; kt < SEQ / 64; ++kt) {
            __syncthreads();
            { const bf16_t* kp = F.K + ((size_t)bh * SEQ + kt * 64) * DQK;
              for (int e = F.tid; e < 64 * DQK; e += NTHREADS) Ks[e] = bf2f(kp[e]);
              const bf16_t* vp = F.V + ((size_t)bh * SEQ + kt * 64) * DV;
              for (int e = F.tid; e < 64 * DV; e += NTHREADS) Vs[e] = bf2f(vp[e]); }
            __syncthreads();
#pragma unroll 1
            for (int kc = 0; kc < 8; ++kc) {
                float sc[8]; float mx = -1e30f;
#pragma unroll
                for (int j = 0; j < 8; ++j) {
                    float dot = 0.f;
#pragma unroll
                    for (int d = 0; d < 48; ++d) dot += q[d] * Ks[(kc * 8 + j) * DQK + hf * 48 + d];
                    dot += __shfl_xor(dot, 1);
                    sc[j] = dot; mx = fmaxf(mx, dot);
                }
                const float mn = fmaxf(m, mx), alpha = __expf(m - mn);
                l *= alpha;
#pragma unroll
                for (int d = 0; d < 32; ++d) o[d] *= alpha;
                m = mn;
#pragma unroll
                for (int j = 0; j < 8; ++j) {
                    const float p = __expf(sc[j] - m); l += p;
#pragma unroll
                    for (int d = 0; d < 32; ++d) o[d] += p * Vs[(kc * 8 + j) * DV + hf * 32 + d];
                }
            }
        }
        const float rl = 1.f / l; const size_t t = (size_t)b * SEQ + s;
#pragma unroll
        for (int d = 0; d < 32; d += 2) {
            const int col = h * 64 + hf * 32 + d;
            const float g0 = bf2f(F.GA[t * 512 + col]), g1 = bf2f(F.GA[t * 512 + col + 1]);
            *(unsigned*)(F.Y + t * 1024 + 512 + col) = (unsigned)f2bf(o[d] * rl * siluf(g0)) | ((unsigned)f2bf(o[d + 1] * rl * siluf(g1)) << 16);
        }
    }
    __syncthreads();
}

__device__ __forceinline__ void ph5_outproj(const Params& P, Frame& F) {
    const bf16_t* Y = F.Y; const float* W = P.w_out; const float* x = P.x; float* out = P.out;
    const float* ada_b = P.ada_b; const float* modp = F.modp;
    naive_gemm(F, TOK, DM, DM,
        [=](int m, int k) { return bf2f(Y[(size_t)m * 1024 + k]); },
        [=](int k, int n) { return W[(size_t)k * 1024 + n]; },
        [=](int m, int n, float v) {
            const int b = m / SEQ; float g = ada_b[2048 + n];
#pragma unroll
            for (int kq = 0; kq < 4; ++kq) g += modp[((size_t)kq * 16 + b) * 3072 + 2048 + n];
            out[(size_t)m * 1024 + n] = x[(size_t)m * 1024 + n] + g * v;
        });
}


namespace up {
using bf16x8 = __attribute__((ext_vector_type(8))) short;
using f32x16 = __attribute__((ext_vector_type(16))) float;
__device__ __forceinline__ float half_sum(float v) { auto rr = __builtin_amdgcn_permlane32_swap(__float_as_uint(v), __float_as_uint(v), false, false); return __uint_as_float(rr[0]) + __uint_as_float(rr[1]); }
__device__ __forceinline__ uint2 pack4(float a, float b, float c, float d) { uint2 r; r.x = att::cvtpk(a, b); r.y = att::cvtpk(c, d); return r; }
__device__ __forceinline__ float sumsq8(bf16x8 v) { float s = 0.f;
#pragma unroll
    for (int j = 0; j < 8; ++j) { const float a = bf2f((bf16_t)v[j]); s += a * a; } return s; }

__device__ __forceinline__ void p0_frag_weights(const Params& P, Frame& F) {
    const int gt = F.vb * NTHREADS + F.tid, NT = F.G * NTHREADS;
    for (int id = gt; id < 49152; id += NT) {
        float v[8]; bf16_t* dst;
        if (id < 24576) { const int l = id & 63, ks = (id >> 6) & 15, ti = id >> 10; const int n = (ti / 3) * 96 + (ti % 3) * 32 + (l & 31), k0 = ks * 16 + 8 * (l >> 5);
#pragma unroll
            for (int j = 0; j < 8; ++j) v[j] = P.g_q_lat[k0 + j] * P.w_uq[(size_t)(k0 + j) * 768 + n];
            dst = F.WUQ + (size_t)id * 8; }
        else if (id < 40960) { const int id2 = id - 24576; const int l = id2 & 63, ks = (id2 >> 6) & 7, ti = id2 >> 9; const int n = (ti >> 2) * 128 + (ti & 3) * 32 + (l & 31), k0 = ks * 16 + 8 * (l >> 5);
#pragma unroll
            for (int j = 0; j < 8; ++j) v[j] = P.g_kv_lat[k0 + j] * P.w_ukv[(size_t)(k0 + j) * 1024 + n];
            dst = F.WUKV + (size_t)id2 * 8; }
        else { const int id3 = id - 40960; const int l = id3 & 63, ks = (id3 >> 6) & 7, ti = id3 >> 9; const int gi = ti >> 2, d = (ti & 3) * 32 + (l & 31), k0 = ks * 16 + 8 * (l >> 5);
#pragma unroll
            for (int j = 0; j < 8; ++j) v[j] = P.pool_w[((size_t)gi * 128 + k0 + j) * 128 + d];
            dst = F.WPOOL + (size_t)id3 * 8; }
        uint4 o; o.x = pk2(v[0], v[1]); o.y = pk2(v[2], v[3]); o.z = pk2(v[4], v[5]); o.w = pk2(v[6], v[7]);
        *(uint4*)dst = o;
    }
}

__device__ __forceinline__ void q_job(const Params& P, Frame& F, int tg, int hq) {
    const int lane = F.lane, r32 = lane & 31, hi = lane >> 5;
    const int t = tg * 32 + r32, b = t / SEQ, s = t % SEQ;
    bf16x8 bq[16]; float ssq = 0.f;
#pragma unroll
    for (int ks = 0; ks < 16; ++ks) { bq[ks] = *reinterpret_cast<const bf16x8*>(F.QL + (size_t)t * 256 + ks * 16 + hi * 8); ssq += sumsq8(bq[ks]); }
    ssq = half_sum(ssq);
    const float rq = rsqrtf(ssq * (1.f / QLORA) + EPS);
    const float4 c0 = *(const float4*)(F.rope + (size_t)t * 32 + 4 * hi), c1 = *(const float4*)(F.rope + (size_t)t * 32 + 8 + 4 * hi);
    const float4 s0 = *(const float4*)(F.rope + (size_t)t * 32 + 16 + 4 * hi), s1 = *(const float4*)(F.rope + (size_t)t * 32 + 24 + 4 * hi);
    const float cs[8] = {c0.x, c0.y, c0.z, c0.w, c1.x, c1.y, c1.z, c1.w}, sn[8] = {s0.x, s0.y, s0.z, s0.w, s1.x, s1.y, s1.z, s1.w};
#pragma unroll 1
    for (int hh = 0; hh < 4; ++hh) {
        const int h = hq * 4 + hh;
        f32x16 acc[3] = {};
        const bf16_t* wf = F.WUQ + (size_t)(h * 3) * 16 * 512 + lane * 8;
#pragma unroll
        for (int i = 0; i < 3; ++i)
            {
#pragma unroll
              for (int ks = 0; ks < 16; ++ks) { const bf16x8 a = *reinterpret_cast<const bf16x8*>(wf + (size_t)(i * 16 + ks) * 512); acc[i] = __builtin_amdgcn_mfma_f32_32x32x16_bf16(a, bq[ks], acc[i], 0, 0, 0); if ((ks & 7) == 7) asm volatile("" ::: "memory"); } }
        float s2 = 0.f;
#pragma unroll
        for (int i = 0; i < 3; ++i)
#pragma unroll
            for (int r = 0; r < 16; ++r) { acc[i][r] *= rq; s2 += acc[i][r] * acc[i][r]; }
        s2 = half_sum(s2);
        const float rh = rsqrtf(s2 * (1.f / DQK) + EPS);
#pragma unroll
        for (int i = 0; i < 3; ++i)
#pragma unroll
            for (int rg = 0; rg < 4; ++rg) { const float4 g = *(const float4*)(P.g_qnorm + 32 * i + 8 * rg + 4 * hi);
                acc[i][4 * rg + 0] *= rh * g.x; acc[i][4 * rg + 1] *= rh * g.y; acc[i][4 * rg + 2] *= rh * g.z; acc[i][4 * rg + 3] *= rh * g.w; }
#pragma unroll
        for (int r = 0; r < 8; ++r) { const float x1 = acc[2][r], x2 = acc[2][r + 8]; acc[2][r] = x1 * cs[r] - x2 * sn[r]; acc[2][r + 8] = x2 * cs[r] + x1 * sn[r]; }
        bf16_t* qo = F.Q + ((size_t)(b * NH + h) * SEQ + s) * DQK + 4 * hi;
#pragma unroll
        for (int i = 0; i < 3; ++i)
#pragma unroll
            for (int rg = 0; rg < 4; ++rg) *(uint2*)(qo + 32 * i + 8 * rg) = pack4(acc[i][4 * rg], acc[i][4 * rg + 1], acc[i][4 * rg + 2], acc[i][4 * rg + 3]);
    }
}
__device__ __forceinline__ void kv_job(const Params& P, Frame& F, int tg, int hq) {
    const int lane = F.lane, r32 = lane & 31, hi = lane >> 5;
    const int t = tg * 32 + r32, b = t / SEQ, s = t % SEQ;
    bf16x8 bk[8]; float ssq = 0.f;
#pragma unroll
    for (int ks = 0; ks < 8; ++ks) { bk[ks] = *reinterpret_cast<const bf16x8*>(F.KVL + (size_t)t * 160 + ks * 16 + hi * 8); ssq += sumsq8(bk[ks]); }
    ssq = half_sum(ssq);
    const float rkv = rsqrtf(ssq * (1.f / KVLORA) + EPS);
    float kr[16]; float kr2 = 0.f;
#pragma unroll
    for (int rg = 0; rg < 4; ++rg) { const uint2 w = *(const uint2*)(F.KVL + (size_t)t * 160 + 128 + 8 * rg + 4 * hi);
        kr[4 * rg + 0] = __uint_as_float(w.x << 16); kr[4 * rg + 1] = __uint_as_float(w.x & 0xffff0000u); kr[4 * rg + 2] = __uint_as_float(w.y << 16); kr[4 * rg + 3] = __uint_as_float(w.y & 0xffff0000u); }
#pragma unroll
    for (int r = 0; r < 16; ++r) kr2 += kr[r] * kr[r];
    const float4 c0 = *(const float4*)(F.rope + (size_t)t * 32 + 4 * hi), c1 = *(const float4*)(F.rope + (size_t)t * 32 + 8 + 4 * hi);
    const float4 s0 = *(const float4*)(F.rope + (size_t)t * 32 + 16 + 4 * hi), s1 = *(const float4*)(F.rope + (size_t)t * 32 + 24 + 4 * hi);
    const float cs[8] = {c0.x, c0.y, c0.z, c0.w, c1.x, c1.y, c1.z, c1.w}, sn[8] = {s0.x, s0.y, s0.z, s0.w, s1.x, s1.y, s1.z, s1.w};
#pragma unroll 1
    for (int hh = 0; hh < 4; ++hh) {
        const int h = hq * 4 + hh;
        f32x16 acc[4] = {};
        const bf16_t* wf = F.WUKV + (size_t)(h * 4) * 8 * 512 + lane * 8;
#pragma unroll
        for (int i = 0; i < 4; ++i)
            {
#pragma unroll
              for (int ks = 0; ks < 8; ++ks) { const bf16x8 a = *reinterpret_cast<const bf16x8*>(wf + (size_t)(i * 8 + ks) * 512); acc[i] = __builtin_amdgcn_mfma_f32_32x32x16_bf16(a, bk[ks], acc[i], 0, 0, 0); } asm volatile("" ::: "memory"); }
        float s2 = kr2;
#pragma unroll
        for (int i = 0; i < 4; ++i)
#pragma unroll
            for (int r = 0; r < 16; ++r) { acc[i][r] *= rkv; if (i < 2) s2 += acc[i][r] * acc[i][r]; }
        s2 = half_sum(s2);
        const float rh = rsqrtf(s2 * (1.f / DQK) + EPS);
        bf16_t* ko = F.K + ((size_t)(b * NH + h) * SEQ + s) * DQK + 4 * hi;
#pragma unroll
        for (int i = 0; i < 2; ++i)
#pragma unroll
            for (int rg = 0; rg < 4; ++rg) { const float4 g = *(const float4*)(P.g_knorm + 32 * i + 8 * rg + 4 * hi);
                *(uint2*)(ko + 32 * i + 8 * rg) = pack4(acc[i][4 * rg] * rh * g.x, acc[i][4 * rg + 1] * rh * g.y, acc[i][4 * rg + 2] * rh * g.z, acc[i][4 * rg + 3] * rh * g.w); }
        float kn[16];
#pragma unroll
        for (int rg = 0; rg < 4; ++rg) { const float4 g = *(const float4*)(P.g_knorm + 64 + 8 * rg + 4 * hi);
            kn[4 * rg] = kr[4 * rg] * rh * g.x; kn[4 * rg + 1] = kr[4 * rg + 1] * rh * g.y; kn[4 * rg + 2] = kr[4 * rg + 2] * rh * g.z; kn[4 * rg + 3] = kr[4 * rg + 3] * rh * g.w; }
#pragma unroll
        for (int r = 0; r < 8; ++r) { const float x1 = kn[r], x2 = kn[r + 8]; kn[r] = x1 * cs[r] - x2 * sn[r]; kn[r + 8] = x2 * cs[r] + x1 * sn[r]; }
#pragma unroll
        for (int rg = 0; rg < 4; ++rg) *(uint2*)(ko + 64 + 8 * rg) = pack4(kn[4 * rg], kn[4 * rg + 1], kn[4 * rg + 2], kn[4 * rg + 3]);
        bf16_t* vo = F.V + ((size_t)(b * NH + h) * SEQ + s) * DV + 4 * hi;
#pragma unroll
        for (int i = 0; i < 2; ++i)
#pragma unroll
            for (int rg = 0; rg < 4; ++rg) *(uint2*)(vo + 32 * i + 8 * rg) = pack4(acc[2 + i][4 * rg], acc[2 + i][4 * rg + 1], acc[2 + i][4 * rg + 2], acc[2 + i][4 * rg + 3]);
    }
}
__device__ __forceinline__ void pool_job(const Params& P, Frame& F, int tg, int gi) {
    const int lane = F.lane, r32 = lane & 31, hi = lane >> 5;
    const int t = tg * 32 + r32, b = t / SEQ, s = t % SEQ, half = 1 << gi;
    const int lo = (s - half) > 0 ? (s - half) : 0, hi_ = (s + half) < SEQ ? (s + half) : SEQ;
    const float inv = 1.f / (float)(hi_ - lo);
    bf16x8 bd[8];
#pragma unroll
    for (int ks = 0; ks < 8; ++ks) {
        const int c0 = gi * 128 + ks * 16 + 8 * hi;
        float sum[8];
#pragma unroll
        for (int j = 0; j < 8; ++j) sum[j] = 0.f;
#pragma unroll 2
        for (int i = 0; i < 2 * half; ++i) { const int sp = s - half + i; const bool ok = (sp >= 0) && (sp < SEQ); const int spc = ok ? sp : s;
            const bf16x8 v = *reinterpret_cast<const bf16x8*>(F.UP + ((size_t)b * SEQ + spc) * 512 + c0);
#pragma unroll
            for (int j = 0; j < 8; ++j) sum[j] += ok ? bf2f((bf16_t)v[j]) : 0.f; }
        const bf16x8 own = *reinterpret_cast<const bf16x8*>(F.UP + (size_t)t * 512 + c0);
        float d[8];
#pragma unroll
        for (int j = 0; j < 8; ++j) d[j] = sum[j] * inv - bf2f((bf16_t)own[j]);
        uint4 w; w.x = att::cvtpk(d[0], d[1]); w.y = att::cvtpk(d[2], d[3]); w.z = att::cvtpk(d[4], d[5]); w.w = att::cvtpk(d[6], d[7]);
        bd[ks] = *reinterpret_cast<bf16x8*>(&w);
        asm volatile("" ::: "memory");
    }
    f32x16 acc[4] = {};
    const bf16_t* wf = F.WPOOL + (size_t)(gi * 4) * 8 * 512 + lane * 8;
#pragma unroll
    for (int i = 0; i < 4; ++i)
        {
#pragma unroll
          for (int ks = 0; ks < 8; ++ks) { const bf16x8 a = *reinterpret_cast<const bf16x8*>(wf + (size_t)(i * 8 + ks) * 512); acc[i] = __builtin_amdgcn_mfma_f32_32x32x16_bf16(a, bd[ks], acc[i], 0, 0, 0); } asm volatile("" ::: "memory"); }
#pragma unroll
    for (int i = 0; i < 4; ++i)
#pragma unroll
        for (int rg = 0; rg < 4; ++rg) { const int n = gi * 128 + 32 * i + 8 * rg + 4 * hi;
            const uint2 gw = *(const uint2*)(F.GP + (size_t)t * 512 + n); const float4 ps = *(const float4*)(P.pool_scale + n);
            const float g0 = __uint_as_float(gw.x << 16), g1 = __uint_as_float(gw.x & 0xffff0000u), g2 = __uint_as_float(gw.y << 16), g3 = __uint_as_float(gw.y & 0xffff0000u);
            *(uint2*)(F.Y + (size_t)t * 1024 + n) = pack4(acc[i][4 * rg] * ps.x * siluf(g0), acc[i][4 * rg + 1] * ps.y * siluf(g1), acc[i][4 * rg + 2] * ps.z * siluf(g2), acc[i][4 * rg + 3] * ps.w * siluf(g3)); }
}
__device__ __forceinline__ void ph3_mfma(const Params& P, Frame& F) {
    const int gw = F.vb * NWAVES + F.wave, NGW = F.G * NWAVES;
    for (int it = gw; it < 2048; it += NGW) q_job(P, F, it >> 1, it & 1);
    for (int it = gw; it < 2048; it += NGW) kv_job(P, F, it >> 1, it & 1);
    for (int it = gw; it < 2048; it += NGW) { const int tg = it >> 1; pool_job(P, F, tg, (it & 1) ? 1 : 0); pool_job(P, F, tg, (it & 1) ? 2 : 3); }
}
}


namespace up2 {
using up::bf16x8; using up::f32x16; using up::half_sum; using up::sumsq8;
typedef unsigned u32x4 __attribute__((ext_vector_type(4)));
typedef unsigned u32x2 __attribute__((ext_vector_type(2)));
__device__ __forceinline__ u32x2 pack4(float a, float b, float c, float d) { u32x2 r; r.x = att::cvtpk(a, b); r.y = att::cvtpk(c, d); return r; }
constexpr int STG_OFF = 69632, STG_WAVE = 8704;
template <int CH, int RS> __device__ __forceinline__ void tile_store(LAS char* stg, char* gbase, int gpitch, int lane) {
    asm volatile("s_waitcnt lgkmcnt(0)" : "+v"(lane) :: "memory");
#pragma unroll
    for (int j = 0; j < CH / 2; ++j) { const int id = lane + 64 * j, row = id / CH, c = id % CH;
        const u32x4 v = *(const LAS u32x4*)(stg + row * RS + c * 16);
        *(u32x4*)(gbase + (size_t)row * gpitch + c * 16) = v; }
}
__device__ __forceinline__ void wdma(const bf16_t* tile, int npieces8, LAS char* wbuf, int wave, int lane) {
    asm volatile("" : "+v"(lane));
#pragma unroll
    for (int j = 0; j < 6; ++j) if (j < npieces8) { const int p = wave + 8 * j;
        __builtin_amdgcn_global_load_lds((const unsigned*)((const char*)tile + p * 1024 + lane * 16), (LAS unsigned*)(wbuf + p * 1024), 16, 0, 0); }
}
__device__ __forceinline__ void up_unit(const Params& P, Frame& F, int tb, int hh) {
    const int lane = F.lane, wave = F.wave, r32 = lane & 31, hi = lane >> 5;
    const int tw0 = tb * 256 + wave * 32, t = tw0 + r32, b = tw0 / SEQ, sw0 = tw0 % SEQ;
    LAS char* wbuf = (LAS char*)F.lds; LAS char* stg = (LAS char*)F.lds + STG_OFF + wave * STG_WAVE;
#define LOAD_ROPE() int tl_ = t; asm volatile("" : "+v"(tl_) :: "memory"); const float* rp_ = F.rope + (size_t)tl_ * 32 + 4 * hi; \
    const float4 c0 = *(const float4*)(rp_), c1 = *(const float4*)(rp_ + 8), s0 = *(const float4*)(rp_ + 16), s1 = *(const float4*)(rp_ + 24); \
    const float cs[8] = {c0.x, c0.y, c0.z, c0.w, c1.x, c1.y, c1.z, c1.w}, sn[8] = {s0.x, s0.y, s0.z, s0.w, s1.x, s1.y, s1.z, s1.w};
    __syncthreads();
    wdma(F.WUQ + (size_t)(hh * 4) * 24576, 6, wbuf, wave, lane);
    {
        bf16x8 bq[16]; float ssq = 0.f;
#pragma unroll
        for (int ks = 0; ks < 16; ++ks) { bq[ks] = *reinterpret_cast<const bf16x8*>(F.QL + (size_t)t * 256 + ks * 16 + hi * 8); ssq += sumsq8(bq[ks]); }
        ssq = half_sum(ssq);
        const float rq = rsqrtf(ssq * (1.f / QLORA) + EPS);
#pragma unroll 1
        for (int hq = 0; hq < 4; ++hq) {
            const int h = hh * 4 + hq;
            asm volatile("s_waitcnt vmcnt(0)" ::: "memory"); __syncthreads();
            f32x16 acc[3] = {};
#pragma unroll
            for (int i = 0; i < 3; ++i)
#pragma unroll
                for (int ks = 0; ks < 16; ++ks) { const bf16x8 a = *(const LAS bf16x8*)(wbuf + ((i * 16 + ks) * 64 + lane) * 16); acc[i] = __builtin_amdgcn_mfma_f32_32x32x16_bf16(a, bq[ks], acc[i], 0, 0, 0); if ((ks & 3) == 3) asm volatile("" ::: "memory"); }
            __syncthreads();
            if (hq < 3) wdma(F.WUQ + (size_t)(h + 1) * 24576, 6, wbuf, wave, lane); else wdma(F.WUKV + (size_t)(hh * 4) * 16384, 4, wbuf, wave, lane);
            const float* gqn = P.g_qnorm; asm volatile("" : "+s"(gqn) :: "memory");
            float s2 = 0.f;
#pragma unroll
            for (int i = 0; i < 3; ++i)
#pragma unroll
                for (int r = 0; r < 16; ++r) { acc[i][r] *= rq; s2 += acc[i][r] * acc[i][r]; }
            s2 = half_sum(s2);
            const float rh = rsqrtf(s2 * (1.f / DQK) + EPS) * CQ;
#pragma unroll
            for (int i = 0; i < 3; ++i) {
#pragma unroll
                for (int rg = 0; rg < 4; ++rg) { const float4 g = *(const float4*)(gqn + 32 * i + 8 * rg + 4 * hi);
                    acc[i][4 * rg + 0] *= rh * g.x; acc[i][4 * rg + 1] *= rh * g.y; acc[i][4 * rg + 2] *= rh * g.z; acc[i][4 * rg + 3] *= rh * g.w; }
                if (i == 2) { LOAD_ROPE();
#pragma unroll
                    for (int r = 0; r < 8; ++r) { const float x1 = acc[2][r], x2 = acc[2][r + 8]; acc[2][r] = x1 * cs[r] - x2 * sn[r]; acc[2][r + 8] = x2 * cs[r] + x1 * sn[r]; } }
#pragma unroll
                for (int rg = 0; rg < 4; ++rg) *(LAS u32x2*)(stg + r32 * 208 + (32 * i + 8 * rg + 4 * hi) * 2) = pack4(acc[i][4 * rg], acc[i][4 * rg + 1], acc[i][4 * rg + 2], acc[i][4 * rg + 3]);
                asm volatile("" ::: "memory");
            }
            tile_store<12, 208>(stg, (char*)(F.Q + ((size_t)(b * NH + h) * SEQ + sw0) * DQK), DQK * 2, lane);
        }
    }
    {
        bf16x8 bk[8]; float ssq = 0.f;
        int t2 = t; asm volatile("" : "+v"(t2) :: "memory");
#pragma unroll
        for (int ks = 0; ks < 8; ++ks) { bk[ks] = *reinterpret_cast<const bf16x8*>(F.KVL + (size_t)t2 * 160 + ks * 16 + hi * 8); ssq += sumsq8(bk[ks]); }
        ssq = half_sum(ssq);
        const float rkv = rsqrtf(ssq * (1.f / KVLORA) + EPS);
        float kr[16]; float kr2 = 0.f;
#pragma unroll
        for (int rg = 0; rg < 4; ++rg) { const uint2 w = *(const uint2*)(F.KVL + (size_t)t2 * 160 + 128 + 8 * rg + 4 * hi);
            kr[4 * rg + 0] = __uint_as_float(w.x << 16); kr[4 * rg + 1] = __uint_as_float(w.x & 0xffff0000u); kr[4 * rg + 2] = __uint_as_float(w.y << 16); kr[4 * rg + 3] = __uint_as_float(w.y & 0xffff0000u); }
#pragma unroll
        for (int r = 0; r < 16; ++r) kr2 += kr[r] * kr[r];
#pragma unroll 1
        for (int hq = 0; hq < 4; ++hq) {
            const int h = hh * 4 + hq;
            asm volatile("s_waitcnt vmcnt(0)" ::: "memory"); __syncthreads();
            f32x16 acc[4] = {};
#pragma unroll
            for (int i = 0; i < 4; ++i)
#pragma unroll
                for (int ks = 0; ks < 8; ++ks) { const bf16x8 a = *(const LAS bf16x8*)(wbuf + ((i * 8 + ks) * 64 + lane) * 16); acc[i] = __builtin_amdgcn_mfma_f32_32x32x16_bf16(a, bk[ks], acc[i], 0, 0, 0); if ((ks & 3) == 3) asm volatile("" ::: "memory"); }
            __syncthreads();
            if (hq < 3) wdma(F.WUKV + (size_t)(h + 1) * 16384, 4, wbuf, wave, lane);
            const float* gkn = P.g_knorm; asm volatile("" : "+s"(gkn) :: "memory");
            float s2 = kr2;
#pragma unroll
            for (int i = 0; i < 4; ++i)
#pragma unroll
                for (int r = 0; r < 16; ++r) { acc[i][r] *= rkv; if (i < 2) s2 += acc[i][r] * acc[i][r]; }
            s2 = half_sum(s2);
            const float rh = rsqrtf(s2 * (1.f / DQK) + EPS);
#pragma unroll
            for (int i = 0; i < 2; ++i) {
#pragma unroll
                for (int rg = 0; rg < 4; ++rg) { const float4 g = *(const float4*)(gkn + 32 * i + 8 * rg + 4 * hi);
                    *(LAS u32x2*)(stg + r32 * 208 + (32 * i + 8 * rg + 4 * hi) * 2) = pack4(acc[i][4 * rg] * rh * g.x, acc[i][4 * rg + 1] * rh * g.y, acc[i][4 * rg + 2] * rh * g.z, acc[i][4 * rg + 3] * rh * g.w); }
                asm volatile("" ::: "memory"); }
            { float kn[16];
#pragma unroll
            for (int rg = 0; rg < 4; ++rg) { const float4 g = *(const float4*)(gkn + 64 + 8 * rg + 4 * hi);
                kn[4 * rg] = kr[4 * rg] * rh * g.x; kn[4 * rg + 1] = kr[4 * rg + 1] * rh * g.y; kn[4 * rg + 2] = kr[4 * rg + 2] * rh * g.z; kn[4 * rg + 3] = kr[4 * rg + 3] * rh * g.w; }
            { LOAD_ROPE();
#pragma unroll
            for (int r = 0; r < 8; ++r) { const float x1 = kn[r], x2 = kn[r + 8]; kn[r] = x1 * cs[r] - x2 * sn[r]; kn[r + 8] = x2 * cs[r] + x1 * sn[r]; } }
#pragma unroll
            for (int rg = 0; rg < 4; ++rg) *(LAS u32x2*)(stg + r32 * 208 + (64 + 8 * rg + 4 * hi) * 2) = pack4(kn[4 * rg], kn[4 * rg + 1], kn[4 * rg + 2], kn[4 * rg + 3]); }
            tile_store<12, 208>(stg, (char*)(F.K + ((size_t)(b * NH + h) * SEQ + sw0) * DQK), DQK * 2, lane);
#pragma unroll
            for (int i = 0; i < 2; ++i)
#pragma unroll
                for (int rg = 0; rg < 4; ++rg) *(LAS u32x2*)(stg + r32 * 144 + (32 * i + 8 * rg + 4 * hi) * 2) = pack4(acc[2 + i][4 * rg], acc[2 + i][4 * rg + 1], acc[2 + i][4 * rg + 2], acc[2 + i][4 * rg + 3]);
            tile_store<8, 144>(stg, (char*)(F.V + ((size_t)(b * NH + h) * SEQ + sw0) * DV), DV * 2, lane);
        }
    }
#undef LOAD_ROPE
}
__device__ __forceinline__ void pool_unit(const Params& P, Frame& F, int tb, int pr) {
    const int tid = F.tid, lane = F.lane, wave = F.wave, r32 = lane & 31, hi = lane >> 5;
    const int t0 = tb * 256, b = t0 / SEQ, s0 = t0 % SEQ, tw0 = t0 + wave * 32, t = tw0 + r32, s = s0 + wave * 32 + r32;
    LAS char* ut = (LAS char*)F.lds; LAS char* stg = (LAS char*)F.lds + STG_OFF + wave * STG_WAVE;
#pragma unroll 1
    for (int gsel = 0; gsel < 2; ++gsel) {
        const int gi = pr ? (gsel ? 2 : 1) : (gsel ? 3 : 0), half = 1 << gi, nrows = 256 + 2 * half;
        __syncthreads();
        for (int id = tid; id < nrows * 16; id += NTHREADS) { const int lr = id >> 4, c = id & 15, srow = s0 - half + lr;
            if (srow >= 0 && srow < SEQ) { const u32x4 v = *(const u32x4*)(F.UP + ((size_t)b * SEQ + srow) * 512 + gi * 128 + c * 8);
                *(LAS u32x4*)(ut + lr * 256 + ((c ^ (lr & 15)) << 4)) = v; } }
#pragma unroll
        for (int j = 0; j < 8; ++j) { const int id = lane + 64 * j, row = id >> 4, c = id & 15;
            *(LAS u32x4*)(stg + row * 272 + c * 16) = *(const u32x4*)(F.GP + (size_t)(tw0 + row) * 512 + gi * 128 + c * 8); }
        __syncthreads();
        const int lrow = wave * 32 + r32 + half;
        const int lo = (s - half) > 0 ? (s - half) : 0, hi_ = (s + half) < SEQ ? (s + half) : SEQ;
        const float inv = 1.f / (float)(hi_ - lo);
        bf16x8 bd[8];
#pragma unroll
        for (int ks = 0; ks < 8; ++ks) {
            const int chunk = ks * 2 + hi;
            float sum[8];
#pragma unroll
            for (int j = 0; j < 8; ++j) sum[j] = 0.f;
#pragma unroll 2
            for (int i = 0; i < 2 * half; ++i) { const int sp = s - half + i, lr = lrow - half + i; const bool ok = (sp >= 0) && (sp < SEQ);
                const bf16x8 v = *(const LAS bf16x8*)(ut + lr * 256 + ((chunk ^ (lr & 15)) << 4));
#pragma unroll
                for (int j = 0; j < 8; ++j) sum[j] += ok ? bf2f((bf16_t)v[j]) : 0.f; }
            const bf16x8 own = *(const LAS bf16x8*)(ut + lrow * 256 + ((chunk ^ (lrow & 15)) << 4));
            float d[8];
#pragma unroll
            for (int j = 0; j < 8; ++j) d[j] = sum[j] * inv - bf2f((bf16_t)own[j]);
            u32x4 w; w.x = att::cvtpk(d[0], d[1]); w.y = att::cvtpk(d[2], d[3]); w.z = att::cvtpk(d[4], d[5]); w.w = att::cvtpk(d[6], d[7]);
            bd[ks] = *reinterpret_cast<bf16x8*>(&w);
        }
        f32x16 acc[4] = {};
        const bf16_t* wf = F.WPOOL + (size_t)(gi * 4) * 8 * 512 + lane * 8;
#pragma unroll
        for (int i = 0; i < 4; ++i) {
#pragma unroll
            for (int ks = 0; ks < 8; ++ks) { const bf16x8 a = *reinterpret_cast<const bf16x8*>(wf + (size_t)(i * 8 + ks) * 512); acc[i] = __builtin_amdgcn_mfma_f32_32x32x16_bf16(a, bd[ks], acc[i], 0, 0, 0); }
            asm volatile("" ::: "memory"); }
#pragma unroll
        for (int i = 0; i < 4; ++i)
#pragma unroll
            for (int rg = 0; rg < 4; ++rg) { const int nl = 32 * i + 8 * rg + 4 * hi;
                LAS u32x2* sp = (LAS u32x2*)(stg + r32 * 272 + nl * 2);
                const u32x2 gw = *sp; const float4 ps = *(const float4*)(P.pool_scale + gi * 128 + nl);
                const float g0 = __uint_as_float(gw.x << 16), g1 = __uint_as_float(gw.x & 0xffff0000u), g2 = __uint_as_float(gw.y << 16), g3 = __uint_as_float(gw.y & 0xffff0000u);
                *sp = pack4(acc[i][4 * rg] * ps.x * siluf(g0), acc[i][4 * rg + 1] * ps.y * siluf(g1), acc[i][4 * rg + 2] * ps.z * siluf(g2), acc[i][4 * rg + 3] * ps.w * siluf(g3)); }
        tile_store<16, 272>(stg, (char*)(F.Y + (size_t)tw0 * 1024 + gi * 128), 2048, lane);
    }
}
__device__ __forceinline__ void ph3_v2(const Params& P, Frame& F) {
    for (int u = F.vb; u < 256; u += F.G) up_unit(P, F, u >> 1, u & 1);
    for (int u = F.vb; u < 256; u += F.G) pool_unit(P, F, u >> 1, u & 1);
    __syncthreads();
}
}

__device__ __forceinline__ void ph4_attn_mfma(const Params& P, Frame& F) {
    float gq = 0.f, gk = 0.f;
    for (int d = F.lane; d < DQK; d += 64) { gq = fmaxf(gq, fabsf(P.g_qnorm[d])); gk = fmaxf(gk, fabsf(P.g_knorm[d])); }
#pragma unroll
    for (int o = 1; o < 64; o <<= 1) { gq = fmaxf(gq, __shfl_xor(gq, o)); gk = fmaxf(gk, __shfl_xor(gk, o)); }
    const float kbound = 1.01f * 9.797958971132712f * gk;
    const float mglob = 1.01f * CQ * 9.797958971132712f * gq * kbound;
    const bool fast = __builtin_amdgcn_readfirstlane(mglob <= 60.f ? 1 : 0) != 0;
    if (fast) {
        for (int u = F.vb; u < NB * NH * 8; u += F.G) {
            const int bh = u >> 3, qb = u & 7, b = bh / NH, h = bh % NH;
            const size_t t0 = (size_t)b * SEQ + qb * 256;
            att::attn_unit_fast(F.Q + ((size_t)bh * SEQ + qb * 256) * DQK, F.K + (size_t)bh * SEQ * DQK, F.V + (size_t)bh * SEQ * DV,
                                F.GA + t0 * 512 + h * 64, F.Y + t0 * 1024 + 512 + h * 64, (LAS char*)F.lds);
        }
    } else {
        for (int u = F.vb; u < NB * NH * 8; u += F.G) {
            const int bh = u >> 3, qb = u & 7, b = bh / NH, h = bh % NH;
            const size_t t0 = (size_t)b * SEQ + qb * 256;
            att::attn_unit(F.Q + ((size_t)bh * SEQ + qb * 256) * DQK, F.K + (size_t)bh * SEQ * DQK, F.V + (size_t)bh * SEQ * DV,
                           F.GA + t0 * 512 + h * 64, F.Y + t0 * 1024 + 512 + h * 64, (LAS char*)F.lds);
        }
    }
}

__global__ void __launch_bounds__(NTHREADS, 2) fwd_kernel(Params P) {
    extern __shared__ __attribute__((aligned(16))) unsigned char lds[];
    Frame F;
    F.lds = (LAS unsigned char*)lds;
    F.tid = threadIdx.x; F.lane = F.tid & 63; F.wave = __builtin_amdgcn_readfirstlane(F.tid >> 6);
    F.G = gridDim.x; { const int bx = blockIdx.x; F.vb = (F.G % 8 == 0) ? (bx % 8) * (F.G / 8) + bx / 8 : bx; }
    unsigned char* ws = P.ws;
    F.modp = (float*)(ws + WS_MODP); F.rope = (float*)(ws + WS_ROPE); F.gate = (float*)(ws + WS_GATE);
    F.WIN = (bf16_t*)(ws + WS_WIN); F.WUQ = (bf16_t*)(ws + WS_WUQ); F.WUKV = (bf16_t*)(ws + WS_WUKV); F.WPOOL = (bf16_t*)(ws + WS_WPOOL); F.WOUT = (bf16_t*)(ws + WS_WOUT);
    F.XN = (bf16_t*)(ws + WS_XN); F.UP = (bf16_t*)(ws + WS_UP); F.GP = (bf16_t*)(ws + WS_GP); F.GA = (bf16_t*)(ws + WS_GA);
    F.QL = (bf16_t*)(ws + WS_QL); F.KVL = (bf16_t*)(ws + WS_KVL); F.Q = (bf16_t*)(ws + WS_Q); F.K = (bf16_t*)(ws + WS_K); F.V = (bf16_t*)(ws + WS_V); F.Y = (bf16_t*)(ws + WS_Y);
    volatile LAS unsigned* MISC = (volatile LAS unsigned*)(F.lds + MISC_OFF);
    for (int u = F.tid; u < (LDS_BYTES - LDSCTL_OFF) / 4; u += NTHREADS) ((LAS unsigned*)(F.lds + LDSCTL_OFF))[u] = 0u;
    __syncthreads();
    const int lo = P.ph_lo, hi = P.ph_hi;
    XcdBarrier bar; bar.bar = (unsigned*)(ws + WS_CTL) + CW_BAR + P.li * XCD_BAR_WORDS; bar.x = 0; bar.st = nullptr;
    if (hi - lo > 1) bar = xcd_barrier_post((unsigned*)(ws + WS_CTL) + CW_BAR + P.li * XCD_BAR_WORDS, MISC + 8);
#define IN(k) (lo <= (k) && (k) < hi)
#define SEAM(k) do { if (IN(k) && IN((k) + 1)) xcd_barrier(bar); } while (0)
    if (IN(0)) { ph0_mod(P, F); ph0_weights(P, F); up::p0_frag_weights(P, F); } SEAM(0);
    if (IN(1)) { ph1_xn(P, F); } SEAM(1);
    if (IN(2)) { pg8::Gemm g{F.XN, F.WIN, TOK, 2048, DM}; pg8::StaticOrder S; S.init(TOK, 2048, F.G, (int)blockIdx.x);
        pg8::EpiInProj E{F.UP, F.GP, F.GA, F.QL, F.KVL};
        pg8::gemm_phase<pg8::EpiInProj, pg8::StaticOrder, true, true>(F.lds, g, S, E); } SEAM(2);
    if (IN(3)) { up2::ph3_v2(P, F); } SEAM(3);
    if (IN(4)) { ph4_attn_mfma(P, F); } SEAM(4);
    if (IN(5)) { pg8::Gemm g{F.Y, F.WOUT, TOK, DM, DM}; pg8::StaticOrder S; S.init(TOK, DM, F.G, (int)blockIdx.x);
        pg8::EpiOut E{P.x, F.gate, P.out};
        pg8::gemm_phase<pg8::EpiOut, pg8::StaticOrder, true, true>(F.lds, g, S, E); }
#undef IN
#undef SEAM
}

extern "C" void kernel_launch(void* const* d_in, const int* in_sizes, int n_in, void* d_out, int out_size, void* d_ws, size_t ws_size, hipStream_t stream) {
    static int grid = 0;
    if (grid == 0) {
        if (n_in != 16 || in_sizes[0] != TOK * DM || out_size != TOK * DM || ws_size < WS_END) {
            fprintf(stderr, "kernel_launch: shape mismatch: n_in %d in0 %d out %d ws %zu\n", n_in, n_in > 0 ? in_sizes[0] : -1, out_size, ws_size); grid = -1; return; }
        int dev = 0, cus = 0, per_cu = 0;
        if (hipGetDevice(&dev) != hipSuccess || hipDeviceGetAttribute(&cus, hipDeviceAttributeMultiprocessorCount, dev) != hipSuccess) { grid = -1; return; }
        if (hipFuncSetAttribute((const void*)fwd_kernel, hipFuncAttributeMaxDynamicSharedMemorySize, LDS_BYTES) != hipSuccess) { fprintf(stderr, "kernel_launch: hipFuncSetAttribute failed\n"); grid = -1; return; }
        if (hipOccupancyMaxActiveBlocksPerMultiprocessor(&per_cu, (const void*)fwd_kernel, NTHREADS, LDS_BYTES) != hipSuccess || per_cu < 1) {
            fprintf(stderr, "kernel_launch: occupancy query reports %d blocks per CU\n", per_cu); (void)hipGetLastError(); grid = -1; return; }
        grid = cus;
    }
    if (grid < 0) return;
    (void)hipMemsetAsync((char*)d_ws + WS_CTL, 0, CTL_ZERO_BYTES, stream);
    Params p{};
    p.x = (const float*)d_in[0]; p.c = (const float*)d_in[1]; p.pos = (const int*)d_in[2]; p.ada_w = (const float*)d_in[3]; p.ada_b = (const float*)d_in[4];
    p.norm_g = (const float*)d_in[5]; p.w_in = (const float*)d_in[6]; p.pool_w = (const float*)d_in[7]; p.pool_scale = (const float*)d_in[8];
    p.g_q_lat = (const float*)d_in[9]; p.w_uq = (const float*)d_in[10]; p.g_kv_lat = (const float*)d_in[11]; p.w_ukv = (const float*)d_in[12];
    p.g_qnorm = (const float*)d_in[13]; p.g_knorm = (const float*)d_in[14]; p.w_out = (const float*)d_in[15];
    p.out = (float*)d_out; p.ws = (unsigned char*)d_ws;
    if (PROBE_DUP >= 100) {
        p.ph_lo = 0; p.ph_hi = PROBE_DUP - 100 + 1; p.li = 0;
        hipLaunchKernelGGL(fwd_kernel, dim3(grid), dim3(NTHREADS), LDS_BYTES, stream, p);
        p.ph_lo = PROBE_DUP - 100; p.ph_hi = N_PHASES; p.li = 1;
        hipLaunchKernelGGL(fwd_kernel, dim3(grid), dim3(NTHREADS), LDS_BYTES, stream, p);
    } else if (MK_N_LAUNCHES == 1) {
        p.ph_lo = 0; p.ph_hi = N_PHASES;
        hipLaunchKernelGGL(fwd_kernel, dim3(grid), dim3(NTHREADS), LDS_BYTES, stream, p);
    } else {
        for (int k = 0; k < N_PHASES; ++k) { p.ph_lo = k; p.ph_hi = k + 1; hipLaunchKernelGGL(fwd_kernel, dim3(grid), dim3(NTHREADS), LDS_BYTES, stream, p); }
    }
    const hipError_t le = hipPeekAtLastError();
    if (le != hipSuccess) fprintf(stderr, "kernel_launch: launch failed: %s\n", hipGetErrorName(le));
}
```

```cpp
#include <hip/hip_runtime.h>
#include <cstdio>
#include <cstdint>

#ifndef PROBE_DUP
#define PROBE_DUP -1
#endif
#ifndef PROBE_TS
#define PROBE_TS -1
#endif
#ifndef MK_N_LAUNCHES
#define MK_N_LAUNCHES 1
#endif

#ifndef ATT_PHASE_PAD
#define ATT_PHASE_PAD ""
#endif
#ifndef PG8_PHASE_PAD
#define PG8_PHASE_PAD "\n\ts_nop 0"
#endif
#ifndef UP_PHASE_PAD
#define UP_PHASE_PAD ""
#endif
#define GAS __attribute__((address_space(1)))
#define LAS __attribute__((address_space(3)))
typedef unsigned short bf16_t;
typedef float f32x4_t __attribute__((ext_vector_type(4)));

constexpr int DM = 1024, NB = 16, SEQ = 2048, TOK = NB * SEQ;
constexpr int NH = 8, DQK = 96, DNOPE = 64, DROPE = 32, DV = 64, QLORA = 256, KVLORA = 128, INW = 1952;
constexpr int OFF_UP = 0, OFF_GP = 512, OFF_QL = 1024, OFF_KVL = 1280, OFF_KR = 1408, OFF_GA = 1440;
constexpr float EPS = 1e-6f;
constexpr float CQ = 0.10206207261596577f * 1.4426950408889634f;
constexpr int NTHREADS = 512, NWAVES = 8;
constexpr int N_PHASES = 6;

constexpr size_t MiB = 1u << 20;
constexpr size_t WS_CTL = 0, CTL_ZERO_BYTES = 65536;
constexpr size_t WS_MODP = 1 * MiB;
constexpr size_t WS_ROPE = 2 * MiB;
constexpr size_t WS_GATE = 1 * MiB + 786432;
constexpr size_t WS_WIN = 6 * MiB;
constexpr size_t WS_WUQ = 10 * MiB;
constexpr size_t WS_WUKV = 11 * MiB;
constexpr size_t WS_WPOOL = 12 * MiB;
constexpr size_t WS_WOUT = 13 * MiB;
constexpr size_t WS_Y = 16 * MiB;
constexpr size_t WS_V = 80 * MiB;
constexpr size_t WS_K = 112 * MiB;
constexpr size_t WS_Q = 160 * MiB;
constexpr size_t WS_KVL = 208 * MiB;
constexpr size_t WS_QL = 224 * MiB;
constexpr size_t WS_GA = 240 * MiB;
constexpr size_t WS_GP = 272 * MiB;
constexpr size_t WS_UP = 304 * MiB;
constexpr size_t WS_XN = 336 * MiB;
constexpr size_t WS_END = 400 * MiB;
constexpr int CW_MODCNT = 2048;
constexpr int CW_BAR = 4096;

constexpr int RING_BYTES = 159744;
constexpr int LDSCTL_OFF = RING_BYTES, MISC_OFF = LDSCTL_OFF + 320;
constexpr int LDS_BYTES = 163840;

__device__ const float INVF[16] = {1.0f, 0.5623413251903491f, 0.31622776601683794f, 0.1778279410038923f, 0.1f, 0.05623413251903491f, 0.03162277660168379f,
                                   0.01778279410038923f, 0.01f, 0.005623413251903491f, 0.003162277660168379f, 0.001778279410038923f, 0.001f,
                                   0.0005623413251903491f, 0.00031622776601683794f, 0.0001778279410038923f};

__device__ __forceinline__ float bf2f(bf16_t v) { return __uint_as_float(((unsigned)v) << 16); }
__device__ __forceinline__ bf16_t f2bf(float f) { unsigned u = __float_as_uint(f); return (bf16_t)((u + 0x7fffu + ((u >> 16) & 1u)) >> 16); }
__device__ __forceinline__ float siluf(float v) { return v / (1.f + __expf(-v)); }
__device__ __forceinline__ float wave_sum(float v) {
#pragma unroll
    for (int o = 1; o < 64; o <<= 1) v += __shfl_xor(v, o);
    return v;
}

struct Params {
    const float *x, *c; const int* pos; const float *ada_w, *ada_b, *norm_g, *w_in, *pool_w, *pool_scale, *g_q_lat, *w_uq, *g_kv_lat, *w_ukv, *g_qnorm, *g_knorm, *w_out;
    float* out; unsigned char* ws; int ph_lo, ph_hi, li, pad;
};

#define XB_TMO      128
#define XB_XCNT(j)  (256  + 64 * (j))
#define XB_XSUB(j)  (1280 + 64 * (j))
#define XB_XGEN(j)  (2304 + 64 * (j))
#define XB_TOP      3328
#define XB_TOPGEN   3392
#define XCD_BAR_WORDS 3456
#define XB_SPIN_CAP (1u << 22)
__device__ __forceinline__ unsigned xb_ld(unsigned* p)              { return __hip_atomic_load(p, __ATOMIC_RELAXED, __HIP_MEMORY_SCOPE_AGENT); }
__device__ __forceinline__ unsigned xb_add(unsigned* p, unsigned v) { return __hip_atomic_fetch_add(p, v, __ATOMIC_RELAXED, __HIP_MEMORY_SCOPE_AGENT); }
__device__ __forceinline__ unsigned xb_xcc_id() { return (unsigned)__builtin_amdgcn_s_getreg((3 << 11) | 20) & 0xFu; }
#define XB_SPIN(cond, bar) do { unsigned _sp = 0; while (cond) { __builtin_amdgcn_s_sleep(1); \
    if ((++_sp & 255u) == 0u) { if (xb_ld(&(bar)[XB_TMO])) break; if (_sp > XB_SPIN_CAP) { atomicAdd(&(bar)[XB_TMO], 1u); break; } } } } while (0)
struct XcdBarrier { unsigned* bar; unsigned x; volatile LAS unsigned* st; };
__device__ __forceinline__ XcdBarrier xcd_barrier_post(unsigned* bar, volatile LAS unsigned* st) {
    XcdBarrier b; b.bar = bar; b.x = xb_xcc_id(); b.st = st;
    if (threadIdx.x == 0) (void)xb_add(&bar[XB_XCNT(b.x)], 1u);
    return b;
}
__device__ __forceinline__ void xcd_barrier_complete(unsigned* bar, unsigned x, unsigned& nloc, unsigned& nx) {
    const unsigned G = gridDim.x * gridDim.y * gridDim.z;
    unsigned sum, cnt, mine, sp = 0u;
    for (;;) {
        sum = 0u; cnt = 0u; mine = 0u;
#pragma unroll
        for (unsigned j = 0; j < 16; ++j) { const unsigned c = xb_ld(&bar[XB_XCNT(j)]); sum += c; cnt += (c > 0u) ? 1u : 0u; mine = (j == x) ? c : mine; }
        if (sum == G) break;
        __builtin_amdgcn_s_sleep(1);
        if ((++sp & 255u) == 0u) { if (xb_ld(&bar[XB_TMO])) break; if (sp > XB_SPIN_CAP) { atomicAdd(&bar[XB_TMO], 1u); break; } }
    }
    nloc = mine > 0u ? mine : 1u; nx = cnt > 0u ? cnt : 1u;
}
__device__ __forceinline__ void xcd_barrier(const XcdBarrier& b) {
    asm volatile("s_waitcnt vmcnt(0)" ::: "memory");
    __syncthreads();
    if (threadIdx.x == 0) {
        unsigned* bar = b.bar;
        __builtin_amdgcn_s_waitcnt(0);
        unsigned nloc = b.st[0], nx = b.st[1];
        if (nloc == 0u) { xcd_barrier_complete(bar, b.x, nloc, nx); b.st[0] = nloc; b.st[1] = nx; }
        const unsigned old = xb_add(&bar[XB_XSUB(b.x)], 1u);
        const unsigned gen = old / nloc;
        if (old + 1u == (gen + 1u) * nloc) {
            __builtin_amdgcn_fence(__ATOMIC_RELEASE, "agent");
            asm volatile("s_waitcnt vmcnt(0)" ::: "memory");
            const unsigned og = xb_add(&bar[XB_TOP], 1u);
            const unsigned tg = og / nx;
            if (og + 1u == (tg + 1u) * nx) xb_add(&bar[XB_TOPGEN], 1u);
            else XB_SPIN(xb_ld(&bar[XB_TOPGEN]) == tg, bar);
            __builtin_amdgcn_fence(__ATOMIC_ACQUIRE, "agent");
            asm volatile("s_waitcnt vmcnt(0)" ::: "memory");
            xb_add(&bar[XB_XGEN(b.x)], 1u);
            asm volatile("s_waitcnt vmcnt(0)" ::: "memory");
        } else {
            XB_SPIN(xb_ld(&bar[XB_XGEN(b.x)]) == gen, bar);
            asm volatile("buffer_inv sc0\n\ts_waitcnt vmcnt(0)" ::: "memory");
        }
    }
    __syncthreads();
}


namespace pg8 {
#define PG8_LAS __attribute__((address_space(3)))
typedef short bf16x8 __attribute__((ext_vector_type(8)));
typedef float f32x4 __attribute__((ext_vector_type(4)));
typedef unsigned u32x4 __attribute__((ext_vector_type(4)));
constexpr int BM = 256, BK = 64, HALF = 128, HTB = HALF * BK * 2, STAGE_BYTES = 8 * HTB, NXCD = 8, WGM = 8;
__host__ __device__ __forceinline__ int lds_byte(int r, int c) { const int st = (r >> 4) * 2 + (c >> 5), rr = r & 15, cc = c & 31, ob = rr * 64 + cc * 2; return st * 1024 + (ob ^ (((ob >> 9) & 1) << 5)); }
__host__ __device__ __forceinline__ void stage_rc(int b, int& R, int& C) { const int st = b / 1024, sb = b % 1024, swz = sb ^ (((sb >> 9) & 1) << 5); R = (st >> 1) * 16 + swz / 64; C = (st & 1) * 32 + (swz % 64) / 2; }
__host__ __device__ __forceinline__ int perm32(int rho) { const int n = rho >> 4, i = rho & 15; return 8 * (i >> 2) + 4 * n + (i & 3); }
struct Unit { int pm, pn; };
struct Gemm { const bf16_t* A; const bf16_t* Bt; int M, N, K; };
struct StaticOrder {
    int nM, nN, nwg, G, c;
    __host__ __device__ void init(int M, int N, int G_, int c_) { nM = M / BM; nN = N / BM; nwg = nM * nN; G = G_; c = c_; }
    __host__ __device__ bool next(int i, Unit& u) const {
        const long L = (long)i * G + c; if (L >= nwg) return false;
        int wgid = (int)L; { const int q = nwg / NXCD, r = nwg % NXCD, xcd = wgid % NXCD, off = wgid / NXCD; wgid = (xcd < r ? xcd * (q + 1) : r * (q + 1) + (xcd - r) * q) + off; }
        const int nig = WGM * nN, gid = wgid / nig, fm = gid * WGM, gsz = (nM - fm) < WGM ? (nM - fm) : WGM;
        u.pm = fm + ((wgid % nig) % gsz); u.pn = (wgid % nig) / gsz; return true;
    }
    __device__ __forceinline__ void a_ready(const Unit&) const {}
    __device__ __forceinline__ void done(const Unit&) const {}
};
__device__ __forceinline__ unsigned cvt_pk_bf16(float lo, float hi) { unsigned r; asm volatile("v_cvt_pk_bf16_f32 %0, %1, %2" : "=v"(r) : "v"(lo), "v"(hi)); return r; }

struct EpiInProj {
    static constexpr bool PERM = true, AFTER_DRAIN = false;
    bf16_t *UP, *GP, *GA, *QL, *KVL;
    __device__ __forceinline__ void operator()(const f32x4 (&acc)[2][2][4][2], const Unit& u, int wr, int wc, int fr, int fq) const {
        const int row0 = u.pm * BM + wr * 64 + fr;
        bf16_t* base; int ldc, ncols = 256;
        switch (u.pn) {
            case 0: base = UP; ldc = 512; break;       case 1: base = UP + 256; ldc = 512; break;
            case 2: base = GP; ldc = 512; break;       case 3: base = GP + 256; ldc = 512; break;
            case 4: base = GA; ldc = 512; break;       case 5: base = GA + 256; ldc = 512; break;
            case 6: base = QL; ldc = 256; break;       default: base = KVL; ldc = 160; ncols = 160; break;
        }
        const int col0 = wc * 32 + 8 * fq;
#pragma unroll
        for (int ai = 0; ai < 2; ++ai)
#pragma unroll
            for (int m = 0; m < 4; ++m) { bf16_t* rowp = base + (size_t)(row0 + ai * HALF + m * 16) * ldc + col0;
#pragma unroll
                for (int bj = 0; bj < 2; ++bj) { const f32x4 v0 = acc[ai][bj][m][0], v1 = acc[ai][bj][m][1];
                    u32x4 w; w.x = cvt_pk_bf16(v0[0], v0[1]); w.y = cvt_pk_bf16(v0[2], v0[3]); w.z = cvt_pk_bf16(v1[0], v1[1]); w.w = cvt_pk_bf16(v1[2], v1[3]);
                    if (col0 + bj * HALF < ncols) *(u32x4*)(rowp + bj * HALF) = w; } }
    }
};
struct EpiOut {
    static constexpr bool PERM = false, AFTER_DRAIN = false;
    const float* x; const float* gate; float* out; int stg;
    __device__ __forceinline__ void prefetch(const Unit&, int, unsigned&) const {}
    __device__ __forceinline__ void operator()(const f32x4 (&acc)[2][2][4][2], const Unit& u, int wr, int wc, int fr, int fq) const {
        int lane = fq * 16 + fr; asm volatile("" : "+v"(lane));
        const int wbase = stg + (wr * 4 + wc) * 2304;
        const int waddr = wbase + (lane & 15) * 144 + (lane >> 4) * 16;
        const int r8 = lane >> 3, c8 = lane & 7;
        const int raddr = wbase + r8 * 144 + c8 * 16;
        const int b = (u.pm * BM) / SEQ; const int colw = u.pn * BM + wc * 32 + 4 * c8;
        f32x4 gv[2];
#pragma unroll
        for (int bj = 0; bj < 2; ++bj) gv[bj] = *(const f32x4*)(gate + (size_t)b * 1024 + colw + bj * HALF);
#pragma unroll
        for (int ai = 0; ai < 2; ++ai) {
            const size_t rbase = (size_t)(u.pm * BM + ai * HALF + wr * 64 + r8) * 1024 + colw;
            f32x4 xs[4][2][2];
#pragma unroll
            for (int m = 0; m < 4; ++m)
#pragma unroll
                for (int bj = 0; bj < 2; ++bj)
#pragma unroll
                    for (int h = 0; h < 2; ++h) xs[m][bj][h] = __builtin_nontemporal_load((const f32x4*)(x + rbase + (size_t)(m * 16 + h * 8) * 1024 + bj * HALF));
#pragma unroll
            for (int m = 0; m < 4; ++m) {
                f32x4 y[2][2];
#pragma unroll
                for (int bj = 0; bj < 2; ++bj) {
                    asm volatile("ds_write_b128 %0, %1\n\tds_write_b128 %0, %2 offset:64" :: "v"(waddr), "v"(acc[ai][bj][m][0]), "v"(acc[ai][bj][m][1]));
                    asm volatile("ds_read_b128 %0, %2\n\tds_read_b128 %1, %2 offset:1152" : "=&v"(y[bj][0]), "=&v"(y[bj][1]) : "v"(raddr)); }
                asm volatile("s_waitcnt lgkmcnt(0)" : "+v"(y[0][0]), "+v"(y[0][1]), "+v"(y[1][0]), "+v"(y[1][1]));
#pragma unroll
                for (int bj = 0; bj < 2; ++bj)
#pragma unroll
                    for (int h = 0; h < 2; ++h) *(f32x4*)(out + rbase + (size_t)(m * 16 + h * 8) * 1024 + bj * HALF) = xs[m][bj][h] + gv[bj] * y[bj][h];
            }
            asm volatile("" ::: "memory");
        }
    }
};

template <class Epi, class Sched, bool ALIGN_EPI = false, bool SP2 = false>
__device__ __forceinline__ void gemm_phase(PG8_LAS unsigned char* lds, const Gemm g, const Sched& S, const Epi& E) {
    const int tid = threadIdx.x, wid = __builtin_amdgcn_readfirstlane(tid >> 6), lane = tid & 63, wr = wid >> 2, wc = wid & 3, fr = lane & 15, fq = lane >> 4;
    const int K = g.K, nt = K / BK;
    unsigned voffA[2], voffB[2];
#pragma unroll
    for (int i = 0; i < 2; ++i) { int R, C; stage_rc(tid * 16 + i * 8192, R, C); const int Rb = Epi::PERM ? ((R & ~31) + perm32(R & 31)) : R;
        voffA[i] = (unsigned)(R * K + C) * 2u; voffB[i] = (unsigned)(Rb * K + C) * 2u; }
    const size_t kstep = (size_t)(BK * 2);
    const size_t hstep = (size_t)HALF * K * 2;
    const size_t tstep = 2 * hstep;
    const unsigned ldsw = (unsigned)wid * 1024u;
    const int aoff = lds_byte(wr * 64 + fr, fq * 8), boff = lds_byte(wc * 32 + fr, fq * 8);
#define PG8_SA(b, h) (((b) * 2 + (h)) * HTB)
#define PG8_SB(b, h) ((4 + (b) * 2 + (h)) * HTB)
#define PG8_STAGE(bufoff, gbase, voff) do { _Pragma("unroll") for (int _i = 0; _i < 2; ++_i) \
        __builtin_amdgcn_global_load_lds((const unsigned*)((const char*)(gbase) + (voff)[_i]), (PG8_LAS unsigned*)(lds + (bufoff) + ldsw + _i * 8192), 16, 0, 0); } while (0)
#define PG8_LDA(dst, b, h) do { _Pragma("unroll") for (int m = 0; m < 4; ++m) _Pragma("unroll") for (int k = 0; k < 2; ++k) dst[m][k] = *(const PG8_LAS bf16x8*)(lds + PG8_SA(b, h) + aoff + m * 2048 + k * 1024); } while (0)
#define PG8_LDB(dst, b, h) do { _Pragma("unroll") for (int n = 0; n < 2; ++n) _Pragma("unroll") for (int k = 0; k < 2; ++k) dst[n][k] = *(const PG8_LAS bf16x8*)(lds + PG8_SB(b, h) + boff + n * 2048 + k * 1024); } while (0)
#define PG8_MMA(ai, bj, At, Bt) do { __builtin_amdgcn_s_setprio(1); _Pragma("unroll") for (int m = 0; m < 4; ++m) _Pragma("unroll") for (int n = 0; n < 2; ++n) _Pragma("unroll") for (int k = 0; k < 2; ++k) \
        acc[ai][bj][m][n] = __builtin_amdgcn_mfma_f32_16x16x32_bf16(Bt[n][k], At[m][k], acc[ai][bj][m][n], 0, 0, 0); __builtin_amdgcn_s_setprio(0); } while (0)
#define PG8_WAIT_V(n) asm volatile("s_waitcnt vmcnt(" #n ")" ::: "memory")
#define PG8_WAIT_L(n) asm volatile("s_waitcnt lgkmcnt(" #n ")" ::: "memory")
#define PG8_BAR __builtin_amdgcn_s_barrier()
#define PG8_SCHED __builtin_amdgcn_sched_barrier(0)
    Unit cur, nxt; int ui = 0;
    if (!S.next(0, cur)) return;
    f32x4 acc[2][2][4][2];
#pragma unroll
    for (int a = 0; a < 2; ++a)
#pragma unroll
        for (int b = 0; b < 2; ++b)
#pragma unroll
            for (int m = 0; m < 4; ++m)
#pragma unroll
                for (int n = 0; n < 2; ++n) acc[a][b][m][n] = (f32x4){0.f, 0.f, 0.f, 0.f};
    bf16x8 At[4][2], B0[2][2], B1[2][2];
    const char* cA = (const char*)g.A + (size_t)cur.pm * tstep; const char* cB = (const char*)g.Bt + (size_t)cur.pn * tstep;
    S.a_ready(cur);
    if constexpr (SP2) {
        PG8_STAGE(PG8_SB(0, 0), cB, voffB); PG8_STAGE(PG8_SB(0, 1), cB + hstep, voffB); PG8_STAGE(PG8_SA(0, 0), cA, voffA); PG8_STAGE(PG8_SA(0, 1), cA + hstep, voffA);
        if (wr == 1) PG8_BAR;
        PG8_WAIT_V(2); PG8_BAR;
        PG8_STAGE(PG8_SB(1, 0), cB + kstep, voffB); PG8_STAGE(PG8_SA(1, 0), cA + kstep, voffA); PG8_STAGE(PG8_SB(1, 1), cB + hstep + kstep, voffB);
        PG8_WAIT_V(6); PG8_BAR;
    } else {
        PG8_STAGE(PG8_SB(0, 0), cB, voffB); PG8_STAGE(PG8_SA(0, 0), cA, voffA); PG8_STAGE(PG8_SB(0, 1), cB + hstep, voffB); PG8_STAGE(PG8_SA(0, 1), cA + hstep, voffA);
        if (wr == 1) PG8_BAR;
        PG8_WAIT_V(4); PG8_BAR;
        PG8_STAGE(PG8_SB(1, 0), cB + kstep, voffB); PG8_STAGE(PG8_SA(1, 0), cA + kstep, voffA); PG8_STAGE(PG8_SB(1, 1), cB + hstep + kstep, voffB);
        PG8_WAIT_V(6); PG8_BAR;
    }
    for (;;) {
        const bool has_next = S.next(ui + 1, nxt);
        const char* nA = has_next ? (const char*)g.A + (size_t)nxt.pm * tstep : cA; const char* nB = has_next ? (const char*)g.Bt + (size_t)nxt.pn * tstep : cB;
        for (int t = 0; t < nt; t += 2) {
            asm volatile(".p2align 3" PG8_PHASE_PAD);
            const bool last = (t == nt - 2);
            const char* a1 = cA + (size_t)(t + 1) * kstep;
            const char* a2 = last ? nA : cA + (size_t)(t + 2) * kstep; const char* b2 = last ? nB : cB + (size_t)(t + 2) * kstep;
            const char* a3 = a2 + kstep; const char* b3 = b2 + kstep;
            if (last && has_next) S.a_ready(nxt);
            if constexpr (SP2) {
            PG8_LDB(B0, 0, 0); PG8_LDB(B1, 0, 1); PG8_SCHED; PG8_LDA(At, 0, 0); PG8_STAGE(PG8_SA(1, 1), a1 + hstep, voffA);
            PG8_WAIT_V(8); PG8_WAIT_L(0); PG8_BAR; PG8_MMA(0, 0, At, B0); PG8_MMA(0, 1, At, B1); PG8_BAR; PG8_SCHED;
            PG8_LDA(At, 0, 1); PG8_STAGE(PG8_SB(0, 0), b2, voffB); PG8_STAGE(PG8_SB(0, 1), b2 + hstep, voffB); PG8_STAGE(PG8_SA(0, 0), a2, voffA);
            PG8_WAIT_V(8); PG8_WAIT_L(0); PG8_BAR; PG8_MMA(1, 0, At, B0); PG8_MMA(1, 1, At, B1); PG8_BAR; PG8_SCHED;
            PG8_LDB(B0, 1, 0); PG8_LDB(B1, 1, 1); PG8_SCHED; PG8_LDA(At, 1, 0); PG8_STAGE(PG8_SA(0, 1), a2 + hstep, voffA);
            PG8_WAIT_V(8); PG8_WAIT_L(0); PG8_BAR; PG8_MMA(0, 0, At, B0); PG8_MMA(0, 1, At, B1); PG8_BAR; PG8_SCHED;
            PG8_LDA(At, 1, 1); PG8_STAGE(PG8_SB(1, 0), b3, voffB); PG8_STAGE(PG8_SB(1, 1), b3 + hstep, voffB); PG8_STAGE(PG8_SA(1, 0), a3, voffA);
            PG8_WAIT_V(8); PG8_WAIT_L(0); PG8_BAR; PG8_MMA(1, 0, At, B0); PG8_MMA(1, 1, At, B1); PG8_BAR; PG8_SCHED;
            } else {
            PG8_LDB(B0, 0, 0); PG8_SCHED; PG8_LDA(At, 0, 0); PG8_STAGE(PG8_SA(1, 1), a1 + hstep, voffA);
            PG8_WAIT_L(8); PG8_BAR; PG8_WAIT_L(0); PG8_MMA(0, 0, At, B0); PG8_BAR; PG8_SCHED;
            PG8_LDB(B1, 0, 1); PG8_STAGE(PG8_SB(0, 0), b2, voffB);
            PG8_BAR; PG8_WAIT_L(0); PG8_MMA(0, 1, At, B1); PG8_BAR;
            PG8_LDA(At, 0, 1); PG8_STAGE(PG8_SA(0, 0), a2, voffA);
            PG8_BAR; PG8_WAIT_L(0); PG8_MMA(1, 0, At, B0); PG8_BAR; PG8_SCHED;
            PG8_STAGE(PG8_SB(0, 1), b2 + hstep, voffB);
            PG8_WAIT_V(6); PG8_BAR; PG8_MMA(1, 1, At, B1); PG8_BAR;
            PG8_LDB(B0, 1, 0); PG8_SCHED; PG8_LDA(At, 1, 0); PG8_STAGE(PG8_SA(0, 1), a2 + hstep, voffA);
            PG8_WAIT_L(8); PG8_BAR; PG8_WAIT_L(0); PG8_MMA(0, 0, At, B0); PG8_BAR; PG8_SCHED;
            PG8_LDB(B1, 1, 1); PG8_STAGE(PG8_SB(1, 0), b3, voffB);
            PG8_BAR; PG8_WAIT_L(0); PG8_MMA(0, 1, At, B1); PG8_BAR;
            PG8_LDA(At, 1, 1); PG8_STAGE(PG8_SA(1, 0), a3, voffA);
            PG8_BAR; PG8_WAIT_L(0); PG8_MMA(1, 0, At, B0); PG8_BAR; PG8_SCHED;
            PG8_STAGE(PG8_SB(1, 1), b3 + hstep, voffB);
            PG8_WAIT_V(6); PG8_BAR; PG8_MMA(1, 1, At, B1); PG8_BAR;
            }
        }
        if constexpr (ALIGN_EPI) { if (wr == 0) PG8_BAR; }
        if constexpr (!Epi::AFTER_DRAIN) { E(acc, cur, wr, wc, fr, fq); S.done(cur); }
        if (!has_next) break;
#pragma unroll
        for (int a = 0; a < 2; ++a)
#pragma unroll
            for (int b = 0; b < 2; ++b)
#pragma unroll
                for (int m = 0; m < 4; ++m)
#pragma unroll
                    for (int n = 0; n < 2; ++n) acc[a][b][m][n] = (f32x4){0.f, 0.f, 0.f, 0.f};
        cur = nxt; cA = nA; cB = nB; ++ui;
        if constexpr (ALIGN_EPI) { if (wr == 1) PG8_BAR; }
    }
    PG8_WAIT_V(0);
    if constexpr (!ALIGN_EPI) { if (wr == 0) PG8_BAR; }
    PG8_BAR;
#undef PG8_SA
#undef PG8_SB
#undef PG8_STAGE
#undef PG8_LDA
#undef PG8_LDB
#undef PG8_MMA
#undef PG8_WAIT_V
#undef PG8_WAIT_L
#undef PG8_BAR
#undef PG8_SCHED
}
}


namespace att {
using bf16x8 = __attribute__((ext_vector_type(8))) short;
using s16x4  = __attribute__((ext_vector_type(4))) short;
using f32x16 = __attribute__((ext_vector_type(16))) float;
using u32x4  = __attribute__((ext_vector_type(4))) unsigned;
constexpr int NW = 8, QBLK = 32, KVBLK = 64;
constexpr float SCALE = 0.10206207261596577f;
constexpr float THR = 8.f;
constexpr int SHM_V = 16384, SHM_K = 16384, SHM_ATTN = 2 * SHM_V + 2 * SHM_K + NW * 64 * 4;
#define KSWZ(row, colB) ((row) * 256 + ((colB) ^ (((row) & 15) << 4)))
#define SBAR() __builtin_amdgcn_sched_barrier(0)
__device__ __forceinline__ int crow(int r, int hi) { return (r & 3) + 8 * (r >> 2) + 4 * hi; }
__device__ __forceinline__ unsigned cvtpk(float lo, float hi) { unsigned r; asm volatile("v_cvt_pk_bf16_f32 %0, %1, %2" : "=v"(r) : "v"(lo), "v"(hi)); return r; }
typedef __bf16 bf16x2_t __attribute__((ext_vector_type(2)));
typedef float f32x2_t __attribute__((ext_vector_type(2)));
__device__ __forceinline__ unsigned cvtpk_b(float lo, float hi) { const f32x2_t f = {lo, hi}; const bf16x2_t b = __builtin_convertvector(f, bf16x2_t); return *reinterpret_cast<const unsigned*>(&b); }
__device__ __forceinline__ s16x4 tr_read_b(const LAS char* p) { return __builtin_amdgcn_ds_read_tr16_b64_v4i16((LAS s16x4*)p); }
__device__ __forceinline__ void partialSM(f32x16& p0, f32x16& p1, float& m_reg, float& mn, float& alpha) {
  constexpr float C = 1.f;
  float pmax = p0[0]; for (int r = 1; r < 16; ++r) pmax = fmaxf(pmax, p0[r]); for (int r = 0; r < 16; ++r) pmax = fmaxf(pmax, p1[r]);
  { auto rr = __builtin_amdgcn_permlane32_swap(__float_as_uint(pmax), __float_as_uint(pmax), false, false);
    pmax = fmaxf(__uint_as_float(rr[0]), __uint_as_float(rr[1])); }
  if (__builtin_expect(__all(pmax - m_reg <= THR * 1.4426950408889634f), 1)) { mn = m_reg; alpha = 1.f; }
  else { mn = fmaxf(m_reg, pmax); alpha = __builtin_amdgcn_exp2f((m_reg - mn) * C); m_reg = mn; }
  float mnC = -mn * C;
  for (int r = 0; r < 16; ++r) p0[r] = fmaf(p0[r], C, mnC); for (int r = 0; r < 16; ++r) p1[r] = fmaf(p1[r], C, mnC);
  for (int r = 0; r < 16; ++r) p0[r] = __builtin_amdgcn_exp2f(p0[r]);
}
__device__ __forceinline__ void finishSM(f32x16& p0, f32x16& p1, float alpha, float& l_reg, bf16x8& pa0, bf16x8& pa1, bf16x8& pa2, bf16x8& pa3) {
  for (int r = 0; r < 16; ++r) p1[r] = __builtin_amdgcn_exp2f(p1[r]);
  float ps = 0; for (int r = 0; r < 16; ++r) ps += p0[r]; for (int r = 0; r < 16; ++r) ps += p1[r];
  { auto rr = __builtin_amdgcn_permlane32_swap(__float_as_uint(ps), __float_as_uint(ps), false, false);
    ps = __uint_as_float(rr[0]) + __uint_as_float(rr[1]); }
  l_reg = l_reg * alpha + ps;
#define PK4(P, BASE, OUT) do { unsigned a0 = cvtpk(P[BASE + 0], P[BASE + 1]), a1 = cvtpk(P[BASE + 2], P[BASE + 3]);   \
    unsigned b0 = cvtpk(P[BASE + 4], P[BASE + 5]), b1 = cvtpk(P[BASE + 6], P[BASE + 7]);                              \
    auto r0 = __builtin_amdgcn_permlane32_swap(a0, b0, false, false); auto r1 = __builtin_amdgcn_permlane32_swap(a1, b1, false, false); \
    u32x4 w = {r0[0], r1[0], r0[1], r1[1]}; OUT = *reinterpret_cast<bf16x8*>(&w); } while (0)
  PK4(p0, 0, pa0); PK4(p0, 8, pa1); PK4(p1, 0, pa2); PK4(p1, 8, pa3);
#undef PK4
}
__device__ __forceinline__ void qkt(f32x16& p0, f32x16& p1, const LAS char* Ks, const bf16x8* qr, int r32, int hi) {
  p0 = f32x16{}; p1 = f32x16{};
#pragma unroll
  for (int d0 = 0; d0 < 6; ++d0) { int cb = (d0 * 16 + hi * 8) * 2;
    bf16x8 b0 = *reinterpret_cast<const LAS bf16x8*>(Ks + KSWZ(r32, cb));
    bf16x8 b1 = *reinterpret_cast<const LAS bf16x8*>(Ks + KSWZ(32 + r32, cb));
    p0 = __builtin_amdgcn_mfma_f32_32x32x16_bf16(b0, qr[d0], p0, 0, 0, 0);
    p1 = __builtin_amdgcn_mfma_f32_32x32x16_bf16(b1, qr[d0], p1, 0, 0, 0); }
}
__device__ __forceinline__ int v_st(int k, int c) { const int kk = (k & ~0xC) | ((k & 4) << 1) | ((k & 8) >> 1); return ((kk >> 3) * 4 + (c >> 5)) * 512 + ((kk & 7) * 32 + (c & 31)) * 2; }
__device__ __forceinline__ int v_rd_base(int lane) { return ((lane & 3) << 3) | (((lane >> 2) & 3) << 6) | (((lane >> 4) & 1) << 5) | (((lane >> 5) & 1) << 8); }
constexpr int v_rd_off(int d0, int ks, int half) { return d0 * 512 + ks * 4096 + half * 2048; }
template <int OFF> __device__ __forceinline__ s16x4 tr_read(int vb) {
  s16x4 r; asm volatile("ds_read_b64_tr_b16 %0, %1 offset:%2" : "=&v"(r) : "v"(vb), "i"(OFF) : "memory"); return r;
}
template <int D0> __device__ __forceinline__ void pv_one(f32x16& od, int vb, bf16x8 pa0, bf16x8 pa1, bf16x8 pa2, bf16x8 pa3) {
  const s16x4 l0 = tr_read<v_rd_off(D0, 0, 0)>(vb), h0 = tr_read<v_rd_off(D0, 0, 1)>(vb), l1 = tr_read<v_rd_off(D0, 1, 0)>(vb), h1 = tr_read<v_rd_off(D0, 1, 1)>(vb);
  const s16x4 l2 = tr_read<v_rd_off(D0, 2, 0)>(vb), h2 = tr_read<v_rd_off(D0, 2, 1)>(vb), l3 = tr_read<v_rd_off(D0, 3, 0)>(vb), h3 = tr_read<v_rd_off(D0, 3, 1)>(vb);
  asm volatile("s_waitcnt lgkmcnt(0)" ::: "memory"); SBAR();
#define PK(L, H) (bf16x8){L[0], L[1], L[2], L[3], H[0], H[1], H[2], H[3]}
  od = __builtin_amdgcn_mfma_f32_32x32x16_bf16(pa0, PK(l0, h0), od, 0, 0, 0);
  od = __builtin_amdgcn_mfma_f32_32x32x16_bf16(pa1, PK(l1, h1), od, 0, 0, 0);
  od = __builtin_amdgcn_mfma_f32_32x32x16_bf16(pa2, PK(l2, h2), od, 0, 0, 0);
  od = __builtin_amdgcn_mfma_f32_32x32x16_bf16(pa3, PK(l3, h3), od, 0, 0, 0);
#undef PK
}
__device__ __forceinline__ void pv_d0(f32x16* o, int vb, bf16x8 pa0, bf16x8 pa1, bf16x8 pa2, bf16x8 pa3) {
  pv_one<0>(o[0], vb, pa0, pa1, pa2, pa3); pv_one<1>(o[1], vb, pa0, pa1, pa2, pa3);
}
__device__ __forceinline__ void attn_unit(const bf16_t* Qb, const bf16_t* Kh, const bf16_t* Vh, const bf16_t* GAb, bf16_t* Yb, LAS char* lds) {
  const int tid = threadIdx.x, wid = tid >> 6, lane = tid & 63, r32 = lane & 31, hi = lane >> 5;
  LAS char* V_lds = lds; LAS char* K_lds = lds + 2 * SHM_V;
  LAS float* ws = (LAS float*)(lds + 2 * SHM_V + 2 * SHM_K) + wid * 64; LAS float* li_l = ws; LAS float* al_l = ws + 32;
  float m_reg = -1e30f, l_reg = 0; f32x16 o[2] = {}; bf16x8 qr[6];
  const bf16_t* Qw = Qb + (size_t)(wid * QBLK + r32) * DQK + hi * 8;
#pragma unroll
  for (int d0 = 0; d0 < 6; ++d0) qr[d0] = *reinterpret_cast<const bf16x8*>(Qw + d0 * 16);
  const int kst0 = KSWZ(tid / 12, (tid % 12) * 16), kst1 = KSWZ((512 + tid) / 12, ((512 + tid) % 12) * 16);
  const bool k2 = __builtin_amdgcn_readfirstlane(wid) < 4;
  const int vst = v_st(tid >> 3, (tid & 7) * 8);
  const int vb0 = (int)(uintptr_t)V_lds + v_rd_base(lane);
  struct { bf16x8 k0, k1, v; } sr_[2];
#define SLOAD(i, key0) do { const bf16_t* kp_ = Kh + (size_t)(key0) * DQK; sr_[i].k0 = *reinterpret_cast<const bf16x8*>(kp_ + tid * 8); \
    if (k2) sr_[i].k1 = *reinterpret_cast<const bf16x8*>(kp_ + (512 + tid) * 8); sr_[i].v = *reinterpret_cast<const bf16x8*>(Vh + (size_t)(key0) * DV + tid * 8); } while (0)
#define SWRITE(b, i) do { *(LAS bf16x8*)(K_lds + (b) * SHM_K + kst0) = sr_[i].k0; if (k2) *(LAS bf16x8*)(K_lds + (b) * SHM_K + kst1) = sr_[i].k1; \
    *(LAS bf16x8*)(V_lds + (b) * SHM_V + vst) = sr_[i].v; } while (0)
#define RESC(a) do { if (__any((a) < 1.f)) { if (hi == 0) al_l[r32] = (a); asm volatile("s_waitcnt lgkmcnt(0)" ::: "memory"); \
    for (int d = 0; d < 2; ++d) for (int r = 0; r < 16; ++r) o[d][r] *= al_l[crow(r, hi)]; } } while (0)
  f32x16 pA0, pA1, pB0, pB1; float mnA, mnB, alA, alB; bf16x8 pa0, pa1, pa2, pa3; constexpr int NT = SEQ / KVBLK;
  constexpr int SE = 0, SO = 1;
  SLOAD(SE, 0); SWRITE(0, SE); __syncthreads();
  qkt(pA0, pA1, K_lds, qr, r32, hi); partialSM(pA0, pA1, m_reg, mnA, alA);
  SLOAD(SO, KVBLK); SLOAD(SE, 2 * KVBLK);
  SWRITE(1, SO); __syncthreads();
  for (int j = 1; j + 1 < NT; j += 2) {
    SBAR(); qkt(pB0, pB1, K_lds + SHM_K, qr, r32, hi);
    finishSM(pA0, pA1, alA, l_reg, pa0, pa1, pa2, pa3); SBAR();
    SLOAD(SO, (j + 2) * KVBLK); SBAR();
    pv_d0(o, vb0, pa0, pa1, pa2, pa3); partialSM(pB0, pB1, m_reg, mnB, alB);
    __syncthreads(); SWRITE(0, SE);
    RESC(alB); __syncthreads();
    SBAR(); qkt(pA0, pA1, K_lds, qr, r32, hi);
    finishSM(pB0, pB1, alB, l_reg, pa0, pa1, pa2, pa3); SBAR();
    if (j + 3 < NT) SLOAD(SE, (j + 3) * KVBLK); SBAR();
    pv_d0(o, vb0 + SHM_V, pa0, pa1, pa2, pa3); partialSM(pA0, pA1, m_reg, mnA, alA);
    __syncthreads(); SWRITE(1, SO);
    RESC(alA); __syncthreads();
  }
  SBAR(); qkt(pB0, pB1, K_lds + SHM_K, qr, r32, hi);
  finishSM(pA0, pA1, alA, l_reg, pa0, pa1, pa2, pa3); SBAR();
  pv_d0(o, vb0, pa0, pa1, pa2, pa3); partialSM(pB0, pB1, m_reg, mnB, alB);
  __syncthreads(); RESC(alB);
  finishSM(pB0, pB1, alB, l_reg, pa0, pa1, pa2, pa3); SBAR();
  pv_d0(o, vb0 + SHM_V, pa0, pa1, pa2, pa3);
  if (hi == 0) li_l[r32] = l_reg; asm volatile("s_waitcnt lgkmcnt(0)" ::: "memory");
  float rli[16];
#pragma unroll
  for (int r = 0; r < 16; ++r) rli[r] = __builtin_amdgcn_rcpf(li_l[crow(r, hi)]);
#pragma unroll
  for (int r = 0; r < 16; ++r) { const int orow = wid * QBLK + crow(r, hi);
#pragma unroll
    for (int d0 = 0; d0 < 2; ++d0) { const int col = d0 * 32 + r32; const float g = bf2f(GAb[(size_t)orow * 512 + col]);
      Yb[(size_t)orow * 1024 + col] = f2bf(o[d0][r] * rli[r] * siluf(g)); } }
  __syncthreads();
#undef SLOAD
#undef SWRITE
#undef RESC
}

constexpr int DST = 5, DSTB = 24576, DV_OFF = 16384;
template <int D0> __device__ __forceinline__ void pv_one_c(f32x16& od, int vb, bf16x8 pa0, bf16x8 pa1, bf16x8 pa2, bf16x8 pa3) {
  const s16x4 l0 = tr_read<D0 * 512 + 0>(vb), h0 = tr_read<D0 * 512 + 1024>(vb), l1 = tr_read<D0 * 512 + 2048>(vb), h1 = tr_read<D0 * 512 + 3072>(vb);
  const s16x4 l2 = tr_read<D0 * 512 + 4096>(vb), h2 = tr_read<D0 * 512 + 5120>(vb), l3 = tr_read<D0 * 512 + 6144>(vb), h3 = tr_read<D0 * 512 + 7168>(vb);
  asm volatile("s_waitcnt lgkmcnt(0)" ::: "memory"); SBAR();
#define PK(L, H) (bf16x8){L[0], L[1], L[2], L[3], H[0], H[1], H[2], H[3]}
  od = __builtin_amdgcn_mfma_f32_32x32x16_bf16(pa0, PK(l0, h0), od, 0, 0, 0);
  od = __builtin_amdgcn_mfma_f32_32x32x16_bf16(pa1, PK(l1, h1), od, 0, 0, 0);
  od = __builtin_amdgcn_mfma_f32_32x32x16_bf16(pa2, PK(l2, h2), od, 0, 0, 0);
  od = __builtin_amdgcn_mfma_f32_32x32x16_bf16(pa3, PK(l3, h3), od, 0, 0, 0);
#undef PK
}
typedef unsigned u32x2a __attribute__((ext_vector_type(2)));
template <int D0> __device__ __forceinline__ void pv_one_t(f32x16& od, int vb, bf16x8 pa0, bf16x8 pa1, bf16x8 pa2, bf16x8 pa3) {
  const s16x4 l0 = tr_read<D0 * 512 + 0>(vb), h0 = tr_read<D0 * 512 + 1024>(vb), l1 = tr_read<D0 * 512 + 2048>(vb), h1 = tr_read<D0 * 512 + 3072>(vb);
  const s16x4 l2 = tr_read<D0 * 512 + 4096>(vb), h2 = tr_read<D0 * 512 + 5120>(vb), l3 = tr_read<D0 * 512 + 6144>(vb), h3 = tr_read<D0 * 512 + 7168>(vb);
  asm volatile("s_waitcnt lgkmcnt(0)" ::: "memory"); SBAR();
#define PK(L, H) (bf16x8){L[0], L[1], L[2], L[3], H[0], H[1], H[2], H[3]}
  od = __builtin_amdgcn_mfma_f32_32x32x16_bf16(PK(l0, h0), pa0, od, 0, 0, 0);
  od = __builtin_amdgcn_mfma_f32_32x32x16_bf16(PK(l1, h1), pa1, od, 0, 0, 0);
  od = __builtin_amdgcn_mfma_f32_32x32x16_bf16(PK(l2, h2), pa2, od, 0, 0, 0);
  od = __builtin_amdgcn_mfma_f32_32x32x16_bf16(PK(l3, h3), pa3, od, 0, 0, 0);
#undef PK
}
__device__ __forceinline__ void epi_tile(const f32x16& o0, const f32x16& o1, float l_acc, int l2, bf16_t* Yg, size_t tw, int h, LAS char* stgo) {
  { auto rr = __builtin_amdgcn_permlane32_swap(__float_as_uint(l_acc), __float_as_uint(l_acc), false, false); l_acc = __uint_as_float(rr[0]) + __uint_as_float(rr[1]); }
  const int qb2 = l2 & 31, hib = l2 >> 5;
  const float rl = __builtin_amdgcn_rcpf(l_acc);
#pragma unroll
  for (int d0 = 0; d0 < 2; ++d0) {
    const f32x16& od = d0 ? o1 : o0;
#pragma unroll
    for (int rg = 0; rg < 4; ++rg) { LAS u32x2a* sp = (LAS u32x2a*)(stgo + qb2 * 128 + ((((4 * d0 + rg) ^ (qb2 & 7))) << 4) + 8 * hib);
      const u32x2a gw = *sp;
      const float g0 = __uint_as_float(gw.x << 16), g1 = __uint_as_float(gw.x & 0xffff0000u), g2 = __uint_as_float(gw.y << 16), g3 = __uint_as_float(gw.y & 0xffff0000u);
      u32x2a w; w.x = cvtpk(od[4 * rg] * rl * siluf(g0), od[4 * rg + 1] * rl * siluf(g1)); w.y = cvtpk(od[4 * rg + 2] * rl * siluf(g2), od[4 * rg + 3] * rl * siluf(g3));
      *sp = w; } }
  asm volatile("s_waitcnt lgkmcnt(0)" ::: "memory");
  char* ydst = (char*)(Yg + tw * 1024 + 512 + h * 64);
#pragma unroll
  for (int j = 0; j < 4; ++j) { const int id = l2 + 64 * j, row = id >> 3, c = id & 7;
    const u32x4 v = *(const LAS u32x4*)(stgo + row * 128 + ((c ^ (row & 7)) << 4));
    __builtin_nontemporal_store(v, (u32x4*)(ydst + (size_t)row * 2048 + c * 16)); }
}
__device__ __forceinline__ void ga_dma(const bf16_t* GAg, size_t tw, int h, int l2, LAS char* stgo) {
  const int rq = l2 >> 3, ph = l2 & 7; const char* gsrc = (const char*)(GAg + tw * 512 + h * 64);
#pragma unroll
  for (int p = 0; p < 4; ++p) { const int row = 8 * p + rq;
    __builtin_amdgcn_global_load_lds((const unsigned*)(gsrc + (size_t)row * 1024 + ((ph ^ (row & 7)) << 4)), (LAS unsigned*)(stgo + p * 1024), 16, 0, 0); }
}
__device__ __forceinline__ void ga_load(const bf16_t* GAg, size_t tw, int h, int l2, u32x4 (&g)[4]) {
  const int rq = l2 >> 3, ph = l2 & 7; const char* gsrc = (const char*)(GAg + tw * 512 + h * 64);
#pragma unroll
  for (int p = 0; p < 4; ++p) { const int row = 8 * p + rq; g[p] = *(const u32x4*)(gsrc + (size_t)row * 1024 + ((ph ^ (row & 7)) << 4)); }
}
__device__ __forceinline__ void ga_write(int l2, LAS char* stgo, const u32x4 (&g)[4]) {
#pragma unroll
  for (int p = 0; p < 4; ++p) *(LAS u32x4*)(stgo + p * 1024 + l2 * 16) = g[p];
}
__device__ __forceinline__ void attn_phase_fast(const bf16_t* Qg, const bf16_t* Kg, const bf16_t* Vg, const bf16_t* GAg, bf16_t* Yg, int u0, int ustride, int utotal, LAS char* lds) {
  const int tid = threadIdx.x, wid = __builtin_amdgcn_readfirstlane(tid >> 6), lane = tid & 63, r32 = lane & 31, hi = lane >> 5;
  if (u0 >= utotal) return;
  unsigned koff0, voff;
  { const int row0 = 4 * wid + (lane >> 4), ph = lane & 15; const int lg0 = ph ^ (row0 & 15);
    koff0 = (unsigned)(row0 * 192 + (lg0 < 12 ? lg0 : 0) * 16);
    const int st = 2 * wid + (lane >> 5), s = lane & 31, k = (st >> 1) * 8 + (s >> 2), c = (st & 1) * 32 + 8 * (s & 3); voff = (unsigned)(k * 128 + c * 2); }
  const int vb0 = (int)(uintptr_t)lds + DV_OFF + v_rd_base(lane);
  constexpr int NT = SEQ / KVBLK;
  const bf16_t* Kh; const bf16_t* Vh;
#define DMA_TILE(t, sb) do { const char* kt_ = (const char*)Kh + (size_t)(t) * (KVBLK * DQK * 2); const char* vt_ = (const char*)Vh + (size_t)(t) * (KVBLK * DV * 2); \
    asm volatile("" : "+s"(kt_), "+s"(vt_));     \
    __builtin_amdgcn_global_load_lds((const unsigned*)(kt_ + koff0), (LAS unsigned*)(lds + (sb) + wid * 1024), 16, 0, 0); \
    __builtin_amdgcn_global_load_lds((const unsigned*)(kt_ + 32 * 192 + koff0), (LAS unsigned*)(lds + (sb) + (wid + 8) * 1024), 16, 0, 0); \
    __builtin_amdgcn_global_load_lds((const unsigned*)(vt_ + voff), (LAS unsigned*)(lds + (sb) + DV_OFF + wid * 1024), 16, 0, 0); } while (0)
#define UNIT_BEGIN(uu) do { const int bh_ = (uu) >> 2, qb_ = (uu) & 3; Kh = Kg + (size_t)bh_ * SEQ * DQK; Vh = Vg + (size_t)bh_ * SEQ * DV; \
    int l3_ = lane; asm volatile("" : "+v"(l3_));     \
    const bf16_t* Qw_ = Qg + ((size_t)bh_ * SEQ + qb_ * 512 + wid * 64 + (l3_ & 31)) * DQK + (l3_ >> 5) * 8; \
    _Pragma("unroll") for (int d0 = 0; d0 < 6; ++d0) qA[d0] = *reinterpret_cast<const bf16x8*>(Qw_ + d0 * 16); \
    _Pragma("unroll") for (int d0 = 0; d0 < 6; ++d0) qB[d0] = *reinterpret_cast<const bf16x8*>(Qw_ + 32 * DQK + d0 * 16); \
    DMA_TILE(0, 0); DMA_TILE(1, DSTB); DMA_TILE(2, 2 * DSTB); DMA_TILE(3, 3 * DSTB); } while (0)
  bf16x8 qA[6], qB[6], kf[6];
  const f32x16 zero16 = {};
  f32x16 s0, s1; bf16x8 pa0, pa1;
  s16x4 vl0, vh0, vl1, vh1, vl2, vh2, vl3, vh3;
#define KLOAD(off, KH) do { int kx_ = ((r32 & 15) ^ hi) << 4; asm volatile("" : "+v"(kx_)); \
    const LAS char* Ks = lds + (off) + r32 * 256 + (KH) * 8192; \
    _Pragma("unroll") for (int d0 = 0; d0 < 6; ++d0) kf[d0] = *reinterpret_cast<const LAS bf16x8*>(Ks + ((d0 * 32) ^ kx_)); } while (0)
#define QKC(S, QR) do { \
    _Pragma("unroll") for (int d0 = 0; d0 < 6; ++d0) S = __builtin_amdgcn_mfma_f32_32x32x16_bf16(kf[d0], QR[d0], d0 == 0 ? zero16 : S, 0, 0, 0); } while (0)
#define VLOAD(vb, KH) do { \
    vl0 = tr_read<(KH) * 4096 + 0>(vb); vh0 = tr_read<(KH) * 4096 + 1024>(vb); vl1 = tr_read<(KH) * 4096 + 2048>(vb); vh1 = tr_read<(KH) * 4096 + 3072>(vb); \
    vl2 = tr_read<512 + (KH) * 4096 + 0>(vb); vh2 = tr_read<512 + (KH) * 4096 + 1024>(vb); vl3 = tr_read<512 + (KH) * 4096 + 2048>(vb); vh3 = tr_read<512 + (KH) * 4096 + 3072>(vb); } while (0)
#define WAITLV() asm volatile("s_waitcnt lgkmcnt(0)" : "+v"(vl0), "+v"(vh0), "+v"(vl1), "+v"(vh1), "+v"(vl2), "+v"(vh2), "+v"(vl3), "+v"(vh3) :: "memory")
#define SGB(mask, n) __builtin_amdgcn_sched_group_barrier(mask, n, 0)
#define SLOTPAT() do { _Pragma("unroll") for (int g_ = 0; g_ < 10; ++g_) { SGB(0x008, 1); SGB(0x002, 4); } } while (0)
#define SOFT(S, LACC) do { \
    _Pragma("unroll") for (int r = 0; r < 16; ++r) S[r] = __builtin_amdgcn_exp2f(S[r]); \
    { float s_ = S[0]; _Pragma("unroll") for (int r = 1; r < 16; ++r) s_ += S[r]; LACC += s_; asm volatile("" : "+v"(LACC)); }     \
    { u32x4 w0 = {cvtpk_b(S[0], S[1]), cvtpk_b(S[2], S[3]), cvtpk_b(S[4], S[5]), cvtpk_b(S[6], S[7])}; pa0 = *reinterpret_cast<bf16x8*>(&w0); \
      u32x4 w1 = {cvtpk_b(S[8], S[9]), cvtpk_b(S[10], S[11]), cvtpk_b(S[12], S[13]), cvtpk_b(S[14], S[15])}; pa1 = *reinterpret_cast<bf16x8*>(&w1); } } while (0)
#define PK(L, H) (bf16x8){L[0], L[1], L[2], L[3], H[0], H[1], H[2], H[3]}
#define PVC(O) do { \
    O[0] = __builtin_amdgcn_mfma_f32_32x32x16_bf16(PK(vl0, vh0), pa0, O[0], 0, 0, 0); \
    O[1] = __builtin_amdgcn_mfma_f32_32x32x16_bf16(PK(vl2, vh2), pa0, O[1], 0, 0, 0); \
    O[0] = __builtin_amdgcn_mfma_f32_32x32x16_bf16(PK(vl1, vh1), pa1, O[0], 0, 0, 0); \
    O[1] = __builtin_amdgcn_mfma_f32_32x32x16_bf16(PK(vl3, vh3), pa1, O[1], 0, 0, 0); } while (0)
#define WAITBAR(N) asm volatile("s_waitcnt vmcnt(" #N ") lgkmcnt(0)\n\ts_barrier" ::: "memory")
#define ADV(x) ((x) == (DST - 1) * DSTB ? 0 : (x) + DSTB)
#define FSTEP(jj, L, Q, VM) do { \
    if (L) DMA_TILE((jj) + 4, s_n4); \
    SBAR(); \
    VLOAD(vb0 + s_cur, 0); QKC(s1, qB); KLOAD(s_cur, 1); SOFT(s0, lA); WAITLV(); PVC(oA); SLOTPAT();     \
    SBAR(); \
    QKC(s0, qA); SOFT(s1, lB); PVC(oB); SLOTPAT(); \
    SBAR(); \
    VLOAD(vb0 + s_cur, 1); QKC(s1, qB); if (Q) KLOAD(s_n1, 0); SOFT(s0, lA); WAITLV(); PVC(oA); SLOTPAT(); \
    SBAR(); \
    if (Q) QKC(s0, qA); \
    SOFT(s1, lB); PVC(oB); SLOTPAT(); \
    WAITBAR(VM); \
    s_cur = s_n1; s_n1 = ADV(s_n1); s_n4 = ADV(s_n4); } while (0)
  int u = u0;
  UNIT_BEGIN(u);
  if (wid >= 4) __builtin_amdgcn_s_setprio(1);
#pragma unroll 1
  for (;;) {
    asm volatile("" : "+v"(qA[0]), "+v"(qA[1]), "+v"(qA[2]), "+v"(qA[3]), "+v"(qA[4]), "+v"(qA[5]));
    asm volatile("" : "+v"(qB[0]), "+v"(qB[1]), "+v"(qB[2]), "+v"(qB[3]), "+v"(qB[4]), "+v"(qB[5]));
    f32x16 oA[2] = {}, oB[2] = {}; float lA = 0.f, lB = 0.f;
    { int l4 = lane; asm volatile("" : "+v"(l4)); const int bh = u >> 2, qb = u & 3, b = bh / NH, h = bh % NH;
      ga_dma(GAg, (size_t)b * SEQ + qb * 512 + wid * 64, h, l4, lds + 124928 + wid * 4096); }
    WAITBAR(8);
    KLOAD(0, 0); QKC(s0, qA);
    int s_cur = 0, s_n1 = DSTB, s_n4 = 4 * DSTB;
#pragma unroll 1
    for (int j = 0; j + 4 < NT; ++j) { asm volatile(".p2align 3" ATT_PHASE_PAD); FSTEP(j, true, true, 6); }
    FSTEP(NT - 4, false, true, 3); FSTEP(NT - 3, false, true, 0);
    FSTEP(NT - 2, false, true, 0); FSTEP(NT - 1, false, false, 0);
    const int ucur = u; const int un = u + ustride; const bool has_next = un < utotal;
    if (has_next) UNIT_BEGIN(un);
    { const int bh = ucur >> 2, qb = ucur & 3, b = bh / NH, h = bh % NH;
      const size_t tw = (size_t)b * SEQ + qb * 512 + wid * 64;
      LAS char* stgo = lds + 124928 + wid * 4096;
      int l2 = lane; asm volatile("" : "+v"(l2) :: "memory");
      u32x4 gB[4]; ga_load(GAg, tw + 32, h, l2, gB);
      epi_tile(oA[0], oA[1], lA, l2, Yg, tw, h, stgo);
      ga_write(l2, stgo, gB);
      epi_tile(oB[0], oB[1], lB, l2, Yg, tw + 32, h, stgo); }
    if (!has_next) break;
    u = un;
  }
  __builtin_amdgcn_s_setprio(0);
  __syncthreads();
#undef FSTEP
#undef ADV
#undef WAITBAR
#undef PVC
#undef PK
#undef SOFT
#undef SLOTPAT
#undef SGB
#undef WAITLV
#undef VLOAD
#undef QKC
#undef KLOAD
#undef DMA_TILE
#undef UNIT_BEGIN
}
#undef KSWZ
#undef SBAR
}

struct Frame {
    LAS unsigned char* lds;
    int tid, lane, wave, vb, G;
    float* modp; float* rope; float* gate;
    bf16_t *WIN, *WUQ, *WUKV, *WPOOL, *WOUT;
    bf16_t *XN, *UP, *GP, *GA, *QL, *KVL, *Q, *K, *V, *Y;
};
__device__ __forceinline__ float mod_val(const Params& P, const Frame& F, int b, int e) {
    float s = P.ada_b[e];
#pragma unroll
    for (int kq = 0; kq < 4; ++kq) s += F.modp[((size_t)kq * 16 + b) * 3072 + e];
    return s;
}

__device__ __forceinline__ void ph0_mod(const Params& P, Frame& F) {
    LAS float* cact = (LAS float*)F.lds;
    LAS float* red = (LAS float*)(F.lds + 65536);
    int have = -1;
    for (int item = F.vb; item < 192; item += F.G) {
        const int cg = item % 48, kq = item / 48;
        const int col = cg * 64 + F.lane, r0 = kq * 256 + F.wave * 32;
        float wv[32];
#pragma unroll
        for (int r = 0; r < 32; ++r) wv[r] = P.ada_w[(size_t)(r0 + r) * 3072 + col];
        if (have != kq) {
            float cv[8];
#pragma unroll
            for (int j = 0; j < 8; ++j) { const int i = F.tid + NTHREADS * j; cv[j] = P.c[(i >> 8) * 1024 + kq * 256 + (i & 255)]; }
            __syncthreads();
#pragma unroll
            for (int j = 0; j < 8; ++j) { const int i = F.tid + NTHREADS * j; cact[(i & 255) * 16 + (i >> 8)] = siluf(cv[j]); }
            __syncthreads(); have = kq; }
        float acc[16];
#pragma unroll
        for (int b = 0; b < 16; ++b) acc[b] = 0.f;
#pragma unroll
        for (int r = 0; r < 32; ++r) {
            const LAS f32x4_t* cr = (const LAS f32x4_t*)(cact + (F.wave * 32 + r) * 16);
            const f32x4_t c0 = cr[0], c1 = cr[1], c2 = cr[2], c3 = cr[3];
            acc[0] += c0[0] * wv[r]; acc[1] += c0[1] * wv[r]; acc[2] += c0[2] * wv[r]; acc[3] += c0[3] * wv[r];
            acc[4] += c1[0] * wv[r]; acc[5] += c1[1] * wv[r]; acc[6] += c1[2] * wv[r]; acc[7] += c1[3] * wv[r];
            acc[8] += c2[0] * wv[r]; acc[9] += c2[1] * wv[r]; acc[10] += c2[2] * wv[r]; acc[11] += c2[3] * wv[r];
            acc[12] += c3[0] * wv[r]; acc[13] += c3[1] * wv[r]; acc[14] += c3[2] * wv[r]; acc[15] += c3[3] * wv[r];
        }
#pragma unroll
        for (int b = 0; b < 16; ++b) red[(F.wave * 16 + b) * 64 + F.lane] = acc[b];
        __syncthreads();
        for (int o = F.tid; o < 1024; o += NTHREADS) {
            const int b = o >> 6, cl = o & 63; float s = 0.f;
#pragma unroll
            for (int w = 0; w < 8; ++w) s += red[(w * 16 + b) * 64 + cl];
            F.modp[((size_t)kq * 16 + b) * 3072 + cg * 64 + cl] = s;
        }
        __syncthreads();
    }
}


__device__ __forceinline__ unsigned pk2(float lo, float hi) { return (unsigned)f2bf(lo) | ((unsigned)f2bf(hi) << 16); }
__device__ __forceinline__ void p0_transpose_item(const float* W, int K, int N, int nsrc0, bf16_t* WT, int ndst0, int k0, LAS float* scr, int lane) {
    if (nsrc0 >= 0) {
        float tv[32];
#pragma unroll
        for (int i = 0; i < 32; ++i) { const int kk = 2 * i + (lane >> 5); tv[i] = W[(size_t)(k0 + kk) * N + nsrc0 + (lane & 31)]; }
#pragma unroll
        for (int i = 0; i < 32; ++i) { const int kk = 2 * i + (lane >> 5); scr[kk * 33 + (lane & 31)] = tv[i]; }
    } else {
#pragma unroll 8
        for (int i = 0; i < 32; ++i) { const int kk = 2 * i + (lane >> 5); scr[kk * 33 + (lane & 31)] = 0.f; }
    }
    asm volatile("s_waitcnt lgkmcnt(0)" ::: "memory");
    const int c = lane & 7;
#pragma unroll
    for (int j = 0; j < 4; ++j) { const int n = (lane >> 3) + 8 * j; const LAS float* s = scr + (8 * c) * 33 + n;
        uint4 o; o.x = pk2(s[0 * 33], s[1 * 33]); o.y = pk2(s[2 * 33], s[3 * 33]); o.z = pk2(s[4 * 33], s[5 * 33]); o.w = pk2(s[6 * 33], s[7 * 33]);
        *(uint4*)(WT + (size_t)(ndst0 + n) * K + k0 + 8 * c) = o; }
    asm volatile("s_waitcnt lgkmcnt(0)" ::: "memory");
}
__device__ __forceinline__ int win_src_col(int n) { return n < 1024 ? n : (n < 1536 ? OFF_GA + (n - 1024) : (n < 1792 ? OFF_QL + (n - 1536) : (n < 1952 ? OFF_KVL + (n - 1792) : -1))); }
__device__ __forceinline__ void ph0_weights(const Params& P, Frame& F) {
    LAS float* scr = (LAS float*)(F.lds + F.wave * 16384);
    const int NGW = F.G * NWAVES, gw = F.vb * NWAVES + F.wave;
    constexpr int I_IN = 16 * 48, I_OUT = 16 * 32;
    for (int it = gw; it < I_IN + I_OUT; it += NGW) {
        if (it < I_IN) { const int kb = it / 48, nb = 16 + it % 48; if (nb >= 16) p0_transpose_item(P.w_in, DM, INW, win_src_col(32 * nb), F.WIN, 32 * nb, 64 * kb, scr, F.lane); }
        else { const int r = it - I_IN, kb = r / 32, nb = r % 32; p0_transpose_item(P.w_out, DM, DM, 32 * nb, F.WOUT, 32 * nb, 64 * kb, scr, F.lane); }
    }
}

__device__ __forceinline__ void ph1_xn(const Params& P, Frame& F, unsigned* modcnt) {
    LAS float* gs = (LAS float*)F.lds; LAS float* sh = gs + 1024;
#define XN_LOAD(V, I0) do { _Pragma("unroll") for (int q = 0; q < 4; ++q) { const f32x4_t* xr = (const f32x4_t*)(P.x + (size_t)(row0 + F.wave * 16 + (I0) + q) * 1024) + F.lane; \
        _Pragma("unroll") for (int j = 0; j < 4; ++j) V[q][j] = __builtin_nontemporal_load(xr + 64 * j); } } while (0)
#define XN_PROC(V, I0) do { float ss[4]; \
        _Pragma("unroll") for (int q = 0; q < 4; ++q) { float s = 0.f; \
            _Pragma("unroll") for (int j = 0; j < 4; ++j) s += (V[q][j][0] * V[q][j][0] + V[q][j][1] * V[q][j][1]) + (V[q][j][2] * V[q][j][2] + V[q][j][3] * V[q][j][3]); \
            ss[q] = s; } \
        _Pragma("unroll") for (int o = 1; o < 64; o <<= 1) { _Pragma("unroll") for (int q = 0; q < 4; ++q) ss[q] += __shfl_xor(ss[q], o); } \
        _Pragma("unroll") for (int q = 0; q < 4; ++q) { const float r = rsqrtf(ss[q] * (1.f / 1024.f) + EPS); const int t = row0 + F.wave * 16 + (I0) + q; \
            _Pragma("unroll") for (int j = 0; j < 4; ++j) { \
                const float o0 = (V[q][j][0] * r) * gr[j].x + sr[j].x, o1 = (V[q][j][1] * r) * gr[j].y + sr[j].y, o2 = (V[q][j][2] * r) * gr[j].z + sr[j].z, o3 = (V[q][j][3] * r) * gr[j].w + sr[j].w; \
                const unsigned long long pk = (unsigned long long)((unsigned)f2bf(o0) | ((unsigned)f2bf(o1) << 16)) | ((unsigned long long)((unsigned)f2bf(o2) | ((unsigned)f2bf(o3) << 16)) << 32); \
                __hip_atomic_store((unsigned long long*)(F.XN + (size_t)t * 1024 + 4 * F.lane + 256 * j), pk, __ATOMIC_RELAXED, __HIP_MEMORY_SCOPE_AGENT); } } } while (0)
    for (int item = F.vb; item < TOK / 128; item += F.G) {
        const int row0 = item * 128, b = row0 / SEQ;
        f32x4_t va[4][4], vb[4][4];
        XN_LOAD(va, 0);
        if (modcnt != nullptr && item == F.vb) {
            if (F.tid == 0) { unsigned sp = 0; while (__hip_atomic_load(modcnt, __ATOMIC_RELAXED, __HIP_MEMORY_SCOPE_AGENT) < 192u) { __builtin_amdgcn_s_sleep(2); if (++sp > (1u << 22)) break; }
                __builtin_amdgcn_fence(__ATOMIC_ACQUIRE, "agent"); asm volatile("s_waitcnt vmcnt(0)" ::: "memory"); }
        }
        __syncthreads();
        for (int d = F.tid; d < 1024; d += NTHREADS) { const float sc = mod_val(P, F, b, 1024 + d), sf = mod_val(P, F, b, d); gs[d] = P.norm_g[d] * (1.f + sc); sh[d] = sf; }
        if (F.tid < 64) { const int n = (item % 16) * 64 + F.tid; F.gate[(size_t)b * 1024 + n] = mod_val(P, F, b, 2048 + n); }
#pragma unroll 1
        for (int e = F.tid; e < 2048; e += NTHREADS) { const int t = row0 + (e >> 4), f = e & 15;
            const float ang = (float)P.pos[t] * INVF[f]; float sn, cs; sincosf(ang, &sn, &cs);
            F.rope[(size_t)t * 32 + f] = cs; F.rope[(size_t)t * 32 + 16 + f] = sn; }
        __syncthreads();
        f32x4_t gr[4], sr[4];
#pragma unroll
        for (int j = 0; j < 4; ++j) { gr[j] = *(const LAS f32x4_t*)(gs + 4 * F.lane + 256 * j); sr[j] = *(const LAS f32x4_t*)(sh + 4 * F.lane + 256 * j); }
        XN_LOAD(vb, 4);  XN_PROC(va, 0);
        XN_LOAD(va, 8);  XN_PROC(vb, 4);
        XN_LOAD(vb, 12); XN_PROC(va, 8);
        XN_PROC(vb, 12);
    }
    __syncthreads();
#undef XN_LOAD
#undef XN_PROC
}

namespace up {
using bf16x8 = __attribute__((ext_vector_type(8))) short;
using f32x16 = __attribute__((ext_vector_type(16))) float;
__device__ __forceinline__ float half_sum(float v) { auto rr = __builtin_amdgcn_permlane32_swap(__float_as_uint(v), __float_as_uint(v), false, false); return __uint_as_float(rr[0]) + __uint_as_float(rr[1]); }
__device__ __forceinline__ uint2 pack4(float a, float b, float c, float d) { uint2 r; r.x = att::cvtpk(a, b); r.y = att::cvtpk(c, d); return r; }
__device__ __forceinline__ float sumsq8(bf16x8 v) { float s = 0.f;
#pragma unroll
    for (int j = 0; j < 8; ++j) { const float a = bf2f((bf16_t)v[j]); s += a * a; } return s; }

__device__ __forceinline__ void p0_frag_weights(const Params& P, Frame& F) {
    const int NT = F.G * NTHREADS; int gt = F.vb * NTHREADS + F.tid - (F.G == 256 ? 160 * NTHREADS : 0); if (gt < 0) gt += NT;
    for (int id = gt; id < 49152; id += NT) {
        float v[8]; bf16_t* dst;
        if (id < 24576) { const int l = id & 63, ks = (id >> 6) & 15, ti = id >> 10; const int n = (ti / 3) * 96 + (ti % 3) * 32 + (l & 31), k0 = ks * 16 + 8 * (l >> 5);
#pragma unroll
            for (int j = 0; j < 8; ++j) v[j] = P.g_q_lat[k0 + j] * P.w_uq[(size_t)(k0 + j) * 768 + n];
            dst = F.WUQ + (size_t)id * 8; }
        else if (id < 40960) { const int id2 = id - 24576; const int l = id2 & 63, ks = (id2 >> 6) & 7, ti = id2 >> 9; const int n = (ti >> 2) * 128 + (ti & 3) * 32 + (l & 31), k0 = ks * 16 + 8 * (l >> 5);
#pragma unroll
            for (int j = 0; j < 8; ++j) v[j] = P.g_kv_lat[k0 + j] * P.w_ukv[(size_t)(k0 + j) * 1024 + n];
            dst = F.WUKV + (size_t)id2 * 8; }
        else { const int id3 = id - 40960; const int l = id3 & 63, ks = (id3 >> 6) & 7, ti = id3 >> 9; const int gi = ti >> 2, d = (ti & 3) * 32 + (l & 31), k0 = ks * 16 + 8 * (l >> 5);
#pragma unroll
            for (int j = 0; j < 8; ++j) v[j] = P.pool_w[((size_t)gi * 128 + k0 + j) * 128 + d];
            dst = F.WPOOL + (size_t)id3 * 8; }
        uint4 o; o.x = pk2(v[0], v[1]); o.y = pk2(v[2], v[3]); o.z = pk2(v[4], v[5]); o.w = pk2(v[6], v[7]);
        *(uint4*)dst = o;
    }
}

}


namespace up2 {
using up::bf16x8; using up::f32x16; using up::half_sum; using up::sumsq8;
typedef unsigned u32x4 __attribute__((ext_vector_type(4)));
typedef unsigned u32x2 __attribute__((ext_vector_type(2)));
typedef float f32x4v __attribute__((ext_vector_type(4)));
__device__ __forceinline__ u32x2 pack4(float a, float b, float c, float d) { u32x2 r; r.x = att::cvtpk(a, b); r.y = att::cvtpk(c, d); return r; }
constexpr int STG_OFF = 69632, STG_WAVE = 8704;
template <int CH, int RS> __device__ __forceinline__ void tile_store(LAS char* stg, char* gbase, int gpitch, int lane) {
    asm volatile("s_waitcnt lgkmcnt(0)" : "+v"(lane) :: "memory");
#pragma unroll
    for (int j = 0; j < CH / 2; ++j) { const int id = lane + 64 * j, row = id / CH, c = id % CH;
        const u32x4 v = *(const LAS u32x4*)(stg + row * RS + c * 16);
        *(u32x4*)(gbase + (size_t)row * gpitch + c * 16) = v; }
}
__device__ __forceinline__ void wdma(const bf16_t* tile, int npieces8, LAS char* wbuf, int wave, int lane) {
    asm volatile("" : "+v"(lane));
#pragma unroll
    for (int j = 0; j < 6; ++j) if (j < npieces8) { const int p = wave + 8 * j;
        __builtin_amdgcn_global_load_lds((const unsigned*)((const char*)tile + p * 1024 + lane * 16), (LAS unsigned*)(wbuf + p * 1024), 16, 0, 0); }
}
__device__ __forceinline__ void up_unit(const Params& P, Frame& F, int tb, int hh) {
    const int lane = F.lane, wave = F.wave, r32 = lane & 31, hi = lane >> 5;
    const int tw0 = tb * 256 + wave * 32, t = tw0 + r32, b = tw0 / SEQ, sw0 = tw0 % SEQ;
    LAS char* wb0 = (LAS char*)F.lds; LAS char* stg = (LAS char*)F.lds + 98304 + wave * 6656;
#define LOAD_ROPE() int tl_ = t; asm volatile("" : "+v"(tl_) :: "memory"); const float* rp_ = F.rope + (size_t)tl_ * 32 + 4 * hi; \
    const float4 c0 = *(const float4*)(rp_), c1 = *(const float4*)(rp_ + 8), s0 = *(const float4*)(rp_ + 16), s1 = *(const float4*)(rp_ + 24); \
    const float cs[8] = {c0.x, c0.y, c0.z, c0.w, c1.x, c1.y, c1.z, c1.w}, sn[8] = {s0.x, s0.y, s0.z, s0.w, s1.x, s1.y, s1.z, s1.w};
    __syncthreads();
    LAS float* gl = (LAS float*)(F.lds + 151552);
    if (F.tid < 192) gl[F.tid] = F.tid < 96 ? P.g_qnorm[F.tid] : P.g_knorm[F.tid - 96];
    wdma(F.WUQ + (size_t)(hh * 4) * 24576, 6, wb0, wave, lane);
    {
        bf16x8 bq[16]; float ssq = 0.f;
#pragma unroll
        for (int ks = 0; ks < 16; ++ks) { bq[ks] = *reinterpret_cast<const bf16x8*>(F.QL + (size_t)t * 256 + ks * 16 + hi * 8); ssq += sumsq8(bq[ks]); }
        ssq = half_sum(ssq);
        const float rq = rsqrtf(ssq * (1.f / QLORA) + EPS);
#pragma unroll 1
        for (int hq = 0; hq < 4; ++hq) {
            asm volatile(".p2align 3" UP_PHASE_PAD);
            const int h = hh * 4 + hq;
            if (hq == 0) asm volatile("s_waitcnt vmcnt(0) lgkmcnt(0)\n\ts_barrier" ::: "memory"); else asm volatile("s_waitcnt vmcnt(6) lgkmcnt(0)\n\ts_barrier" ::: "memory");
            LAS char* wbuf = wb0 + (hq & 1) * 49152;
            { LAS char* wnext = wb0 + ((hq + 1) & 1) * 49152;
              if (hq < 3) wdma(F.WUQ + (size_t)(h + 1) * 24576, 6, wnext, wave, lane); else wdma(F.WUKV + (size_t)(hh * 4) * 16384, 4, wnext, wave, lane); }
            f32x16 acc[3] = {};
#pragma unroll
            for (int i = 0; i < 3; ++i)
#pragma unroll
                for (int ks = 0; ks < 16; ++ks) { const bf16x8 a = *(const LAS bf16x8*)(wbuf + ((i * 16 + ks) * 64 + lane) * 16); acc[i] = __builtin_amdgcn_mfma_f32_32x32x16_bf16(a, bq[ks], acc[i], 0, 0, 0); if ((ks & 7) == 7) asm volatile("" ::: "memory"); }
            LOAD_ROPE();
            const LAS float* gqn = gl;
            float s2 = 0.f;
#pragma unroll
            for (int i = 0; i < 3; ++i)
#pragma unroll
                for (int r = 0; r < 16; ++r) { acc[i][r] *= rq; s2 += acc[i][r] * acc[i][r]; }
            s2 = half_sum(s2);
            const float rh = rsqrtf(s2 * (1.f / DQK) + EPS) * CQ;
#pragma unroll
            for (int i = 0; i < 3; ++i) {
#pragma unroll
                for (int rg = 0; rg < 4; ++rg) { const f32x4v g = *(const LAS f32x4v*)(gqn + 32 * i + 8 * rg + 4 * hi);
                    acc[i][4 * rg + 0] *= rh * g.x; acc[i][4 * rg + 1] *= rh * g.y; acc[i][4 * rg + 2] *= rh * g.z; acc[i][4 * rg + 3] *= rh * g.w; }
                if (i == 2) {
#pragma unroll
                    for (int r = 0; r < 8; ++r) { const float x1 = acc[2][r], x2 = acc[2][r + 8]; acc[2][r] = x1 * cs[r] - x2 * sn[r]; acc[2][r + 8] = x2 * cs[r] + x1 * sn[r]; } }
#pragma unroll
                for (int rg = 0; rg < 4; ++rg) *(LAS u32x2*)(stg + r32 * 208 + (32 * i + 8 * rg + 4 * hi) * 2) = pack4(acc[i][4 * rg], acc[i][4 * rg + 1], acc[i][4 * rg + 2], acc[i][4 * rg + 3]);
                asm volatile("" ::: "memory");
            }
            asm volatile("s_waitcnt vmcnt(0)" ::: "memory");
            tile_store<12, 208>(stg, (char*)(F.Q + ((size_t)(b * NH + h) * SEQ + sw0) * DQK), DQK * 2, lane);
        }
    }
    {
        bf16x8 bk[8]; float ssq = 0.f;
        int t2 = t; asm volatile("" : "+v"(t2) :: "memory");
#pragma unroll
        for (int ks = 0; ks < 8; ++ks) { bk[ks] = *reinterpret_cast<const bf16x8*>(F.KVL + (size_t)t2 * 160 + ks * 16 + hi * 8); ssq += sumsq8(bk[ks]); }
        ssq = half_sum(ssq);
        const float rkv = rsqrtf(ssq * (1.f / KVLORA) + EPS);
        float kr[16]; float kr2 = 0.f;
#pragma unroll
        for (int rg = 0; rg < 4; ++rg) { const uint2 w = *(const uint2*)(F.KVL + (size_t)t2 * 160 + 128 + 8 * rg + 4 * hi);
            kr[4 * rg + 0] = __uint_as_float(w.x << 16); kr[4 * rg + 1] = __uint_as_float(w.x & 0xffff0000u); kr[4 * rg + 2] = __uint_as_float(w.y << 16); kr[4 * rg + 3] = __uint_as_float(w.y & 0xffff0000u); }
#pragma unroll
        for (int r = 0; r < 16; ++r) kr2 += kr[r] * kr[r];
#pragma unroll 1
        for (int hq = 0; hq < 4; ++hq) {
            asm volatile(".p2align 3" UP_PHASE_PAD);
            const int h = hh * 4 + hq;
            if (hq == 0) asm volatile("s_waitcnt vmcnt(0) lgkmcnt(0)\n\ts_barrier" ::: "memory"); else asm volatile("s_waitcnt vmcnt(10) lgkmcnt(0)\n\ts_barrier" ::: "memory");
            LAS char* wbuf = wb0 + (hq & 1) * 49152;
            if (hq < 3) wdma(F.WUKV + (size_t)(h + 1) * 16384, 4, wb0 + ((hq + 1) & 1) * 49152, wave, lane);
            f32x16 acc[4] = {};
#pragma unroll
            for (int i = 0; i < 4; ++i)
#pragma unroll
                for (int ks = 0; ks < 8; ++ks) { const bf16x8 a = *(const LAS bf16x8*)(wbuf + ((i * 8 + ks) * 64 + lane) * 16); acc[i] = __builtin_amdgcn_mfma_f32_32x32x16_bf16(a, bk[ks], acc[i], 0, 0, 0); if ((ks & 7) == 7) asm volatile("" ::: "memory"); }
            LOAD_ROPE();
            const LAS float* gkn = gl + 96;
            float s2 = kr2;
#pragma unroll
            for (int i = 0; i < 4; ++i)
#pragma unroll
                for (int r = 0; r < 16; ++r) { acc[i][r] *= rkv; if (i < 2) s2 += acc[i][r] * acc[i][r]; }
            s2 = half_sum(s2);
            const float rh = rsqrtf(s2 * (1.f / DQK) + EPS);
#pragma unroll
            for (int i = 0; i < 2; ++i) {
#pragma unroll
                for (int rg = 0; rg < 4; ++rg) { const f32x4v g = *(const LAS f32x4v*)(gkn + 32 * i + 8 * rg + 4 * hi);
                    *(LAS u32x2*)(stg + r32 * 208 + (32 * i + 8 * rg + 4 * hi) * 2) = pack4(acc[i][4 * rg] * rh * g.x, acc[i][4 * rg + 1] * rh * g.y, acc[i][4 * rg + 2] * rh * g.z, acc[i][4 * rg + 3] * rh * g.w); }
                asm volatile("" ::: "memory"); }
            { float kn[16];
#pragma unroll
            for (int rg = 0; rg < 4; ++rg) { const f32x4v g = *(const LAS f32x4v*)(gkn + 64 + 8 * rg + 4 * hi);
                kn[4 * rg] = kr[4 * rg] * rh * g.x; kn[4 * rg + 1] = kr[4 * rg + 1] * rh * g.y; kn[4 * rg + 2] = kr[4 * rg + 2] * rh * g.z; kn[4 * rg + 3] = kr[4 * rg + 3] * rh * g.w; }
            {
#pragma unroll
            for (int r = 0; r < 8; ++r) { const float x1 = kn[r], x2 = kn[r + 8]; kn[r] = x1 * cs[r] - x2 * sn[r]; kn[r + 8] = x2 * cs[r] + x1 * sn[r]; } }
#pragma unroll
            for (int rg = 0; rg < 4; ++rg) *(LAS u32x2*)(stg + r32 * 208 + (64 + 8 * rg + 4 * hi) * 2) = pack4(kn[4 * rg], kn[4 * rg + 1], kn[4 * rg + 2], kn[4 * rg + 3]); }
            asm volatile("s_waitcnt vmcnt(0)" ::: "memory");
            tile_store<12, 208>(stg, (char*)(F.K + ((size_t)(b * NH + h) * SEQ + sw0) * DQK), DQK * 2, lane);
#pragma unroll
            for (int i = 0; i < 2; ++i)
#pragma unroll
                for (int rg = 0; rg < 4; ++rg) *(LAS u32x2*)(stg + r32 * 144 + (32 * i + 8 * rg + 4 * hi) * 2) = pack4(acc[2 + i][4 * rg], acc[2 + i][4 * rg + 1], acc[2 + i][4 * rg + 2], acc[2 + i][4 * rg + 3]);
            tile_store<8, 144>(stg, (char*)(F.V + ((size_t)(b * NH + h) * SEQ + sw0) * DV), DV * 2, lane);
        }
    }
#undef LOAD_ROPE
}
}


namespace up3 {
using up::bf16x8; using up::f32x16; using up::half_sum; using up::sumsq8;
using up2::u32x4; using up2::u32x2; using up2::f32x4v; using up2::pack4; using up2::tile_store; using up2::STG_OFF; using up2::STG_WAVE;
template <int GI> __device__ __forceinline__ void stencil_job_t(const Params& P, Frame& F, int strip) {
    constexpr int half = 1 << GI, NR = 8 + 2 * half;
    const int lane = F.lane, rq = lane >> 4, ch = lane & 15;
    const int t0 = strip * 32, b = t0 / SEQ, s0 = t0 % SEQ, sb = s0 + 8 * rq;
    const bf16_t* ub = F.UP + (size_t)b * SEQ * 512 + GI * 128 + ch * 8;
    bf16x8 rows[NR], gv[8];
#pragma unroll
    for (int i = 0; i < NR; ++i) { const int sp = sb - half + i; const int spc = sp < 0 ? 0 : (sp >= SEQ ? SEQ - 1 : sp); rows[i] = *reinterpret_cast<const bf16x8*>(ub + (size_t)spc * 512); }
#pragma unroll
    for (int k = 0; k < 8; ++k) gv[k] = __builtin_nontemporal_load(reinterpret_cast<const bf16x8*>(F.GP + ((size_t)b * SEQ + sb + k) * 512 + GI * 128 + ch * 8));
    const float4 psa = *(const float4*)(P.pool_scale + GI * 128 + ch * 8), psb = *(const float4*)(P.pool_scale + GI * 128 + ch * 8 + 4);
    const float ps[8] = {psa.x, psa.y, psa.z, psa.w, psb.x, psb.y, psb.z, psb.w};
    float sum[8];
#pragma unroll
    for (int j = 0; j < 8; ++j) sum[j] = 0.f;
#pragma unroll
    for (int i = 0; i < 2 * half; ++i) { const int sp = sb - half + i; const bool ok = (sp >= 0) && (sp < SEQ);
#pragma unroll
        for (int j = 0; j < 8; ++j) sum[j] += ok ? bf2f((bf16_t)rows[i][j]) : 0.f; }
#pragma unroll
    for (int k = 0; k < 8; ++k) {
        const int s = sb + k; const int lo = (s - half) > 0 ? (s - half) : 0, hi_ = (s + half) < SEQ ? (s + half) : SEQ;
        const float inv = 1.f / (float)(hi_ - lo);
        float y[8];
#pragma unroll
        for (int j = 0; j < 8; ++j) y[j] = (sum[j] * inv - bf2f((bf16_t)rows[half + k][j])) * ps[j] * siluf(bf2f((bf16_t)gv[k][j]));
        u32x4 w; w.x = att::cvtpk(y[0], y[1]); w.y = att::cvtpk(y[2], y[3]); w.z = att::cvtpk(y[4], y[5]); w.w = att::cvtpk(y[6], y[7]);
        __builtin_nontemporal_store(w, (u32x4*)(F.Y + ((size_t)b * SEQ + s) * 1024 + GI * 128 + ch * 8));
        if (k < 7) { const int so = s - half, sn_ = s + half; const bool oko = so >= 0, okn = sn_ < SEQ;
#pragma unroll
            for (int j = 0; j < 8; ++j) sum[j] += (okn ? bf2f((bf16_t)rows[k + 2 * half][j]) : 0.f) - (oko ? bf2f((bf16_t)rows[k][j]) : 0.f); }
    }
}
__device__ __forceinline__ void stencil_job(const Params& P, Frame& F, int strip, int gi) {
    if (gi == 0) stencil_job_t<0>(P, F, strip); else if (gi == 1) stencil_job_t<1>(P, F, strip); else if (gi == 2) stencil_job_t<2>(P, F, strip); else stencil_job_t<3>(P, F, strip);
}
__device__ __forceinline__ void fold_pool_weights(const Params& P, Frame& F) {
    const int NGW0 = F.G * NWAVES, lane = F.lane; const bool tail64 = (F.G == 256);
    const int gw = tail64 ? (F.vb - 192) * NWAVES + F.wave : F.vb * NWAVES + F.wave, NGW = tail64 ? 64 * NWAVES : NGW0;
    if (gw < 0) return;
    if (tail64) {
        const int j = F.vb - 192, g = j & 3, q = j >> 2, kb = q * 8 + F.wave;
        LAS float* wt = (LAS float*)(F.lds + F.wave * 4096);
        LAS float* pl = (LAS float*)(F.lds + 32768);
        const float* wrow = P.w_in + (size_t)(kb * 8) * INW + g * 128;
        float wv[8][2];
#pragma unroll
        for (int r = 0; r < 8; ++r) { wv[r][0] = wrow[(size_t)r * INW + lane]; wv[r][1] = wrow[(size_t)r * INW + 64 + lane]; }
        { const f32x4_t* src = (const f32x4_t*)(P.pool_w + (size_t)g * 128 * 128); f32x4_t pv[8];
#pragma unroll
          for (int i = 0; i < 8; ++i) pv[i] = src[F.tid + NTHREADS * i];
#pragma unroll
          for (int i = 0; i < 8; ++i) *(LAS f32x4_t*)(pl + 4 * (F.tid + NTHREADS * i)) = pv[i]; }
#pragma unroll
        for (int r = 0; r < 8; ++r) { wt[lane * 8 + r] = wv[r][0]; wt[(64 + lane) * 8 + r] = wv[r][1]; }
        __syncthreads();
        float a0[8], a1[8];
#pragma unroll
        for (int r = 0; r < 8; ++r) { a0[r] = 0.f; a1[r] = 0.f; }
#pragma unroll 8
        for (int c = 0; c < 128; ++c) { const float p0 = pl[c * 128 + lane], p1 = pl[c * 128 + 64 + lane];
            const f32x4_t wa = *(const LAS f32x4_t*)(wt + c * 8), wb = *(const LAS f32x4_t*)(wt + c * 8 + 4);
            a0[0] += wa.x * p0; a0[1] += wa.y * p0; a0[2] += wa.z * p0; a0[3] += wa.w * p0; a0[4] += wb.x * p0; a0[5] += wb.y * p0; a0[6] += wb.z * p0; a0[7] += wb.w * p0;
            a1[0] += wa.x * p1; a1[1] += wa.y * p1; a1[2] += wa.z * p1; a1[3] += wa.w * p1; a1[4] += wb.x * p1; a1[5] += wb.y * p1; a1[6] += wb.z * p1; a1[7] += wb.w * p1; }
        uint4 o; o.x = pk2(a0[0], a0[1]); o.y = pk2(a0[2], a0[3]); o.z = pk2(a0[4], a0[5]); o.w = pk2(a0[6], a0[7]);
        *(uint4*)(F.WIN + (size_t)(g * 128 + lane) * 1024 + kb * 8) = o;
        o.x = pk2(a1[0], a1[1]); o.y = pk2(a1[2], a1[3]); o.z = pk2(a1[4], a1[5]); o.w = pk2(a1[6], a1[7]);
        *(uint4*)(F.WIN + (size_t)(g * 128 + 64 + lane) * 1024 + kb * 8) = o;
        __syncthreads();
        return;
    }
    LAS float* wt = (LAS float*)(F.lds + F.wave * 16384);
    for (int it = gw; it < 1024; it += NGW) {
        const int kb = it >> 3, nc = it & 7, g = nc >> 1, d = (nc & 1) * 64 + lane;
        const float* wrow = P.w_in + (size_t)(kb * 8) * INW + g * 128;
        float wv[8][2];
#pragma unroll
        for (int j = 0; j < 8; ++j) { wv[j][0] = wrow[(size_t)j * INW + lane]; wv[j][1] = wrow[(size_t)j * INW + 64 + lane]; }
#pragma unroll
        for (int j = 0; j < 8; ++j) { wt[lane * 8 + j] = wv[j][0]; wt[(64 + lane) * 8 + j] = wv[j][1]; }
        asm volatile("s_waitcnt lgkmcnt(0)" ::: "memory");
        float acc[8];
#pragma unroll
        for (int j = 0; j < 8; ++j) acc[j] = 0.f;
        const float* pw = P.pool_w + (size_t)g * 128 * 128 + d;
#pragma unroll 16
        for (int c = 0; c < 128; ++c) { const float pv = pw[(size_t)c * 128];
            const f32x4_t wa = *(const LAS f32x4_t*)(wt + c * 8), wb = *(const LAS f32x4_t*)(wt + c * 8 + 4);
            acc[0] += wa.x * pv; acc[1] += wa.y * pv; acc[2] += wa.z * pv; acc[3] += wa.w * pv; acc[4] += wb.x * pv; acc[5] += wb.y * pv; acc[6] += wb.z * pv; acc[7] += wb.w * pv; }
        uint4 o; o.x = pk2(acc[0], acc[1]); o.y = pk2(acc[2], acc[3]); o.z = pk2(acc[4], acc[5]); o.w = pk2(acc[6], acc[7]);
        *(uint4*)(F.WIN + (size_t)(g * 128 + d) * 1024 + kb * 8) = o;
        asm volatile("s_waitcnt lgkmcnt(0)" ::: "memory");
    }
}
__device__ __forceinline__ void ph3_v3(const Params& P, Frame& F) {
    const int gw = F.vb * NWAVES + F.wave, NGW = F.G * NWAVES;
    for (int u = F.vb; u < 256; u += F.G) up2::up_unit(P, F, u >> 1, u & 1);
    for (int it = gw; it < 2048; it += NGW) { stencil_job(P, F, it >> 1, (it & 1) ? 1 : 0); stencil_job(P, F, it >> 1, (it & 1) ? 2 : 3); }
    __syncthreads();
}
}

__device__ __forceinline__ void ph4_attn_mfma(const Params& P, Frame& F) {
    float gq = 0.f, gk = 0.f;
    for (int d = F.lane; d < DQK; d += 64) { gq = fmaxf(gq, fabsf(P.g_qnorm[d])); gk = fmaxf(gk, fabsf(P.g_knorm[d])); }
#pragma unroll
    for (int o = 1; o < 64; o <<= 1) { gq = fmaxf(gq, __shfl_xor(gq, o)); gk = fmaxf(gk, __shfl_xor(gk, o)); }
    const float kbound = 1.01f * 9.797958971132712f * gk;
    const float mglob = 1.01f * CQ * 9.797958971132712f * gq * kbound;
    const bool fast = __builtin_amdgcn_readfirstlane(mglob <= 60.f ? 1 : 0) != 0;
    if (fast) {
        att::attn_phase_fast(F.Q, F.K, F.V, F.GA, F.Y, F.vb, F.G, NB * NH * 4, (LAS char*)F.lds);
    } else {
        for (int u = F.vb; u < NB * NH * 8; u += F.G) {
            const int bh = u >> 3, qb = u & 7, b = bh / NH, h = bh % NH;
            const size_t t0 = (size_t)b * SEQ + qb * 256;
            att::attn_unit(F.Q + ((size_t)bh * SEQ + qb * 256) * DQK, F.K + (size_t)bh * SEQ * DQK, F.V + (size_t)bh * SEQ * DV,
                           F.GA + t0 * 512 + h * 64, F.Y + t0 * 1024 + 512 + h * 64, (LAS char*)F.lds);
        }
    }
}

__global__ void __launch_bounds__(NTHREADS, 2) fwd_kernel(Params P) {
    extern __shared__ __attribute__((aligned(16))) unsigned char lds[];
    Frame F;
    F.lds = (LAS unsigned char*)lds;
    F.tid = threadIdx.x; F.lane = F.tid & 63; F.wave = __builtin_amdgcn_readfirstlane(F.tid >> 6);
    F.G = gridDim.x; { const int bx = blockIdx.x; F.vb = (F.G % 8 == 0) ? (bx % 8) * (F.G / 8) + bx / 8 : bx; }
    unsigned char* ws = P.ws + (size_t)P.pad * MiB;
    F.modp = (float*)(ws + WS_MODP); F.rope = (float*)(ws + WS_ROPE); F.gate = (float*)(ws + WS_GATE);
    F.WIN = (bf16_t*)(ws + WS_WIN); F.WUQ = (bf16_t*)(ws + WS_WUQ); F.WUKV = (bf16_t*)(ws + WS_WUKV); F.WPOOL = (bf16_t*)(ws + WS_WPOOL); F.WOUT = (bf16_t*)(ws + WS_WOUT);
    F.XN = (bf16_t*)(ws + WS_XN); F.UP = (bf16_t*)(ws + WS_UP); F.GP = (bf16_t*)(ws + WS_GP); F.GA = (bf16_t*)(ws + WS_GA);
    F.QL = (bf16_t*)(ws + WS_QL); F.KVL = (bf16_t*)(ws + WS_KVL); F.Q = (bf16_t*)(ws + WS_Q); F.K = (bf16_t*)(ws + WS_K); F.V = (bf16_t*)(ws + WS_V); F.Y = (bf16_t*)(ws + WS_Y);
    volatile LAS unsigned* MISC = (volatile LAS unsigned*)(F.lds + MISC_OFF);
    for (int u = F.tid; u < (LDS_BYTES - LDSCTL_OFF) / 4; u += NTHREADS) ((LAS unsigned*)(F.lds + LDSCTL_OFF))[u] = 0u;
    __syncthreads();
    const int lo = P.ph_lo, hi = P.ph_hi;
    XcdBarrier bar; bar.bar = (unsigned*)(ws + WS_CTL) + CW_BAR + P.li * XCD_BAR_WORDS; bar.x = 0; bar.st = nullptr;
    if (hi - lo > 1) bar = xcd_barrier_post((unsigned*)(ws + WS_CTL) + CW_BAR + P.li * XCD_BAR_WORDS, MISC + 8);
#define IN(k) (lo <= (k) && (k) < hi)
    unsigned long long ts_a = 0, ts_b = 0;
#define SEAM(k) do { if (IN(k) && IN((k) + 1)) xcd_barrier(bar); if (PROBE_TS == (k) + 1) ts_a = __builtin_amdgcn_s_memrealtime(); if (PROBE_TS == (k)) ts_b = __builtin_amdgcn_s_memrealtime(); } while (0)
    if (PROBE_TS == 0 || PROBE_TS == 6) ts_a = __builtin_amdgcn_s_memrealtime();
    if (IN(0) && IN(1)) {
        unsigned* modcnt = (unsigned*)(ws + WS_CTL) + CW_MODCNT;
        int nitems = 0; for (int item = F.vb; item < 192; item += F.G) ++nitems;
        ph0_mod(P, F);
        if (nitems) { asm volatile("s_waitcnt vmcnt(0)" ::: "memory"); __syncthreads();
            if (F.tid == 0) { __builtin_amdgcn_fence(__ATOMIC_RELEASE, "agent"); asm volatile("s_waitcnt vmcnt(0)" ::: "memory"); __hip_atomic_fetch_add(modcnt, (unsigned)nitems, __ATOMIC_RELAXED, __HIP_MEMORY_SCOPE_AGENT); } }
        ph0_weights(P, F); up::p0_frag_weights(P, F); up3::fold_pool_weights(P, F);
        ph1_xn(P, F, modcnt);
        if (PROBE_TS == 0) ts_b = __builtin_amdgcn_s_memrealtime();
        SEAM(1);
    } else {
        if (IN(0)) { ph0_mod(P, F); } SEAM(0);
        if (IN(1)) { ph1_xn(P, F, nullptr); ph0_weights(P, F); up::p0_frag_weights(P, F); up3::fold_pool_weights(P, F); } SEAM(1);
    }
    if (IN(2)) { pg8::Gemm g{F.XN, F.WIN, TOK, 2048, DM}; pg8::StaticOrder S; S.init(TOK, 2048, F.G, (int)blockIdx.x);
        pg8::EpiInProj E{F.UP, F.GP, F.GA, F.QL, F.KVL};
        pg8::gemm_phase<pg8::EpiInProj, pg8::StaticOrder, true, true>(F.lds, g, S, E); } SEAM(2);
    if (IN(3)) { up3::ph3_v3(P, F); } SEAM(3);
    if (IN(4)) { ph4_attn_mfma(P, F); } SEAM(4);
    if (IN(5)) { pg8::Gemm g{F.Y, F.WOUT, TOK, DM, DM}; pg8::StaticOrder S; S.init(TOK, DM, F.G, (int)blockIdx.x);
        pg8::EpiOut E{P.x, F.gate, P.out, (int)(uintptr_t)F.lds + 131072};
        pg8::gemm_phase<pg8::EpiOut, pg8::StaticOrder, true, true>(F.lds, g, S, E); }
    if (PROBE_TS >= 0) { xcd_barrier(bar); if (PROBE_TS >= 5) ts_b = __builtin_amdgcn_s_memrealtime();
        if (blockIdx.x == 0 && F.tid == 0) { const float us = (float)(ts_b - ts_a) * 0.01f; P.out[0] = P.out[0] + us * 0.01f; } }
#undef IN
#undef SEAM
}

extern "C" void kernel_launch(void* const* d_in, const int* in_sizes, int n_in, void* d_out, int out_size, void* d_ws, size_t ws_size, hipStream_t stream) {
    static int grid = 0;
    if (grid == 0) {
        if (n_in != 16 || in_sizes[0] != TOK * DM || out_size != TOK * DM || ws_size < WS_END) {
            fprintf(stderr, "kernel_launch: shape mismatch: n_in %d in0 %d out %d ws %zu\n", n_in, n_in > 0 ? in_sizes[0] : -1, out_size, ws_size); grid = -1; return; }
        int dev = 0, cus = 0, per_cu = 0;
        if (hipGetDevice(&dev) != hipSuccess || hipDeviceGetAttribute(&cus, hipDeviceAttributeMultiprocessorCount, dev) != hipSuccess) { grid = -1; return; }
        if (hipFuncSetAttribute((const void*)fwd_kernel, hipFuncAttributeMaxDynamicSharedMemorySize, LDS_BYTES) != hipSuccess) { fprintf(stderr, "kernel_launch: hipFuncSetAttribute failed\n"); grid = -1; return; }
        if (hipOccupancyMaxActiveBlocksPerMultiprocessor(&per_cu, (const void*)fwd_kernel, NTHREADS, LDS_BYTES) != hipSuccess || per_cu < 1) {
            fprintf(stderr, "kernel_launch: occupancy query reports %d blocks per CU\n", per_cu); (void)hipGetLastError(); grid = -1; return; }
        grid = cus;
    }
    if (grid < 0) return;
    const int shift_mib = (int)((ws_size - WS_END) / (2 * MiB)) * 2;
    (void)hipMemsetAsync((char*)d_ws + (size_t)shift_mib * MiB + WS_CTL, 0, CTL_ZERO_BYTES, stream);
    Params p{}; p.pad = shift_mib;
    p.x = (const float*)d_in[0]; p.c = (const float*)d_in[1]; p.pos = (const int*)d_in[2]; p.ada_w = (const float*)d_in[3]; p.ada_b = (const float*)d_in[4];
    p.norm_g = (const float*)d_in[5]; p.w_in = (const float*)d_in[6]; p.pool_w = (const float*)d_in[7]; p.pool_scale = (const float*)d_in[8];
    p.g_q_lat = (const float*)d_in[9]; p.w_uq = (const float*)d_in[10]; p.g_kv_lat = (const float*)d_in[11]; p.w_ukv = (const float*)d_in[12];
    p.g_qnorm = (const float*)d_in[13]; p.g_knorm = (const float*)d_in[14]; p.w_out = (const float*)d_in[15];
    p.out = (float*)d_out; p.ws = (unsigned char*)d_ws;
    if (PROBE_DUP >= 100) {
        p.ph_lo = 0; p.ph_hi = PROBE_DUP - 100 + 1; p.li = 0;
        hipLaunchKernelGGL(fwd_kernel, dim3(grid), dim3(NTHREADS), LDS_BYTES, stream, p);
        p.ph_lo = PROBE_DUP - 100; p.ph_hi = N_PHASES; p.li = 1;
        hipLaunchKernelGGL(fwd_kernel, dim3(grid), dim3(NTHREADS), LDS_BYTES, stream, p);
    } else if (MK_N_LAUNCHES == 1) {
        p.ph_lo = 0; p.ph_hi = N_PHASES;
        hipLaunchKernelGGL(fwd_kernel, dim3(grid), dim3(NTHREADS), LDS_BYTES, stream, p);
    } else {
        for (int k = 0; k < N_PHASES; ++k) { p.ph_lo = k; p.ph_hi = k + 1; hipLaunchKernelGGL(fwd_kernel, dim3(grid), dim3(NTHREADS), LDS_BYTES, stream, p); }
    }
    const hipError_t le = hipPeekAtLastError();
    if (le != hipSuccess) fprintf(stderr, "kernel_launch: launch failed: %s\n", hipGetErrorName(le));
}
```

```cpp
#include <hip/hip_runtime.h>
#include <cstdio>
#include <cstdint>

#ifndef PROBE_DUP
#define PROBE_DUP -1
#endif
#ifndef PROBE_TS
#define PROBE_TS -1
#endif
#ifndef MK_N_LAUNCHES
#define MK_N_LAUNCHES 1
#endif

#define GAS __attribute__((address_space(1)))
#define LAS __attribute__((address_space(3)))
typedef unsigned short bf16_t;
typedef float f32x4_t __attribute__((ext_vector_type(4)));

constexpr int DM = 1024, NB = 16, SEQ = 2048, TOK = NB * SEQ;
constexpr int NH = 8, DQK = 96, DNOPE = 64, DROPE = 32, DV = 64, QLORA = 256, KVLORA = 128, INW = 1952;
constexpr int OFF_UP = 0, OFF_GP = 512, OFF_QL = 1024, OFF_KVL = 1280, OFF_KR = 1408, OFF_GA = 1440;
constexpr float EPS = 1e-6f;
constexpr float CQ = 0.10206207261596577f * 1.4426950408889634f;
constexpr int NTHREADS = 512, NWAVES = 8;
constexpr int N_PHASES = 6;

constexpr size_t MiB = 1u << 20;
constexpr size_t WS_CTL = 0, CTL_ZERO_BYTES = 65536;
constexpr size_t WS_MODP = 1 * MiB;
constexpr size_t WS_ROPE = 2 * MiB;
constexpr size_t WS_GATE = 1 * MiB + 786432;
constexpr size_t WS_WIN = 6 * MiB;
constexpr size_t WS_WUQ = 10 * MiB;
constexpr size_t WS_WUKV = 11 * MiB;
constexpr size_t WS_WPOOL = 12 * MiB;
constexpr size_t WS_WOUT = 13 * MiB;
constexpr size_t WS_Y = 16 * MiB;
constexpr size_t WS_V = 80 * MiB;
constexpr size_t WS_K = 112 * MiB;
constexpr size_t WS_Q = 160 * MiB;
constexpr size_t WS_KVL = 208 * MiB;
constexpr size_t WS_QL = 224 * MiB;
constexpr size_t WS_GA = 240 * MiB;
constexpr size_t WS_GP = 272 * MiB;
constexpr size_t WS_UP = 304 * MiB;
constexpr size_t WS_XN = 336 * MiB;
constexpr size_t WS_END = 400 * MiB;
constexpr int CW_MODCNT = 2048;
constexpr int CW_BAR = 4096;

constexpr int RING_BYTES = 159744;
constexpr int LDSCTL_OFF = RING_BYTES, MISC_OFF = LDSCTL_OFF + 320;
constexpr int LDS_BYTES = 163840;

__device__ const float INVF[16] = {1.0f, 0.5623413251903491f, 0.31622776601683794f, 0.1778279410038923f, 0.1f, 0.05623413251903491f, 0.03162277660168379f,
                                   0.01778279410038923f, 0.01f, 0.005623413251903491f, 0.003162277660168379f, 0.001778279410038923f, 0.001f,
                                   0.0005623413251903491f, 0.00031622776601683794f, 0.0001778279410038923f};

__device__ __forceinline__ float bf2f(bf16_t v) { return __uint_as_float(((unsigned)v) << 16); }
__device__ __forceinline__ bf16_t f2bf(float f) { unsigned u = __float_as_uint(f); return (bf16_t)((u + 0x7fffu + ((u >> 16) & 1u)) >> 16); }
__device__ __forceinline__ float siluf(float v) { return v / (1.f + __expf(-v)); }
__device__ __forceinline__ float wave_sum(float v) {
#pragma unroll
    for (int o = 1; o < 64; o <<= 1) v += __shfl_xor(v, o);
    return v;
}

struct Params {
    const float *x, *c; const int* pos; const float *ada_w, *ada_b, *norm_g, *w_in, *pool_w, *pool_scale, *g_q_lat, *w_uq, *g_kv_lat, *w_ukv, *g_qnorm, *g_knorm, *w_out;
    float* out; unsigned char* ws; int ph_lo, ph_hi, li, pad;
};

#define XB_TMO      128
#define XB_XCNT(j)  (256  + 64 * (j))
#define XB_XSUB(j)  (1280 + 64 * (j))
#define XB_XGEN(j)  (2304 + 64 * (j))
#define XB_TOP      3328
#define XB_TOPGEN   3392
#define XCD_BAR_WORDS 3456
#define XB_SPIN_CAP (1u << 22)
__device__ __forceinline__ unsigned xb_ld(unsigned* p)              { return __hip_atomic_load(p, __ATOMIC_RELAXED, __HIP_MEMORY_SCOPE_AGENT); }
__device__ __forceinline__ unsigned xb_add(unsigned* p, unsigned v) { return __hip_atomic_fetch_add(p, v, __ATOMIC_RELAXED, __HIP_MEMORY_SCOPE_AGENT); }
__device__ __forceinline__ unsigned xb_xcc_id() { return (unsigned)__builtin_amdgcn_s_getreg((3 << 11) | 20) & 0xFu; }
#define XB_SPIN(cond, bar) do { unsigned _sp = 0; while (cond) { __builtin_amdgcn_s_sleep(1); \
    if ((++_sp & 255u) == 0u) { if (xb_ld(&(bar)[XB_TMO])) break; if (_sp > XB_SPIN_CAP) { atomicAdd(&(bar)[XB_TMO], 1u); break; } } } } while (0)
struct XcdBarrier { unsigned* bar; unsigned x; volatile LAS unsigned* st; };
__device__ __forceinline__ XcdBarrier xcd_barrier_post(unsigned* bar, volatile LAS unsigned* st) {
    XcdBarrier b; b.bar = bar; b.x = xb_xcc_id(); b.st = st;
    if (threadIdx.x == 0) (void)xb_add(&bar[XB_XCNT(b.x)], 1u);
    return b;
}
__device__ __forceinline__ void xcd_barrier_complete(unsigned* bar, unsigned x, unsigned& nloc, unsigned& nx) {
    const unsigned G = gridDim.x * gridDim.y * gridDim.z;
    unsigned sum, cnt, mine, sp = 0u;
    for (;;) {
        sum = 0u; cnt = 0u; mine = 0u;
#pragma unroll
        for (unsigned j = 0; j < 16; ++j) { const unsigned c = xb_ld(&bar[XB_XCNT(j)]); sum += c; cnt += (c > 0u) ? 1u : 0u; mine = (j == x) ? c : mine; }
        if (sum == G) break;
        __builtin_amdgcn_s_sleep(1);
        if ((++sp & 255u) == 0u) { if (xb_ld(&bar[XB_TMO])) break; if (sp > XB_SPIN_CAP) { atomicAdd(&bar[XB_TMO], 1u); break; } }
    }
    nloc = mine > 0u ? mine : 1u; nx = cnt > 0u ? cnt : 1u;
}
__device__ __forceinline__ void xcd_barrier(const XcdBarrier& b) {
    asm volatile("s_waitcnt vmcnt(0)" ::: "memory");
    __syncthreads();
    if (threadIdx.x == 0) {
        unsigned* bar = b.bar;
        __builtin_amdgcn_s_waitcnt(0);
        unsigned nloc = b.st[0], nx = b.st[1];
        if (nloc == 0u) { xcd_barrier_complete(bar, b.x, nloc, nx); b.st[0] = nloc; b.st[1] = nx; }
        const unsigned old = xb_add(&bar[XB_XSUB(b.x)], 1u);
        const unsigned gen = old / nloc;
        if (old + 1u == (gen + 1u) * nloc) {
            __builtin_amdgcn_fence(__ATOMIC_RELEASE, "agent");
            asm volatile("s_waitcnt vmcnt(0)" ::: "memory");
            const unsigned og = xb_add(&bar[XB_TOP], 1u);
            const unsigned tg = og / nx;
            if (og + 1u == (tg + 1u) * nx) xb_add(&bar[XB_TOPGEN], 1u);
            else XB_SPIN(xb_ld(&bar[XB_TOPGEN]) == tg, bar);
            __builtin_amdgcn_fence(__ATOMIC_ACQUIRE, "agent");
            asm volatile("s_waitcnt vmcnt(0)" ::: "memory");
            xb_add(&bar[XB_XGEN(b.x)], 1u);
            asm volatile("s_waitcnt vmcnt(0)" ::: "memory");
        } else {
            XB_SPIN(xb_ld(&bar[XB_XGEN(b.x)]) == gen, bar);
            asm volatile("buffer_inv sc0\n\ts_waitcnt vmcnt(0)" ::: "memory");
        }
    }
    __syncthreads();
}


namespace pg8 {
#define PG8_LAS __attribute__((address_space(3)))
typedef short bf16x8 __attribute__((ext_vector_type(8)));
typedef float f32x4 __attribute__((ext_vector_type(4)));
typedef unsigned u32x4 __attribute__((ext_vector_type(4)));
constexpr int BM = 256, BK = 64, HALF = 128, HTB = HALF * BK * 2, STAGE_BYTES = 8 * HTB, NXCD = 8, WGM = 8;
__host__ __device__ __forceinline__ int lds_byte(int r, int c) { const int st = (r >> 4) * 2 + (c >> 5), rr = r & 15, cc = c & 31, ob = rr * 64 + cc * 2; return st * 1024 + (ob ^ (((ob >> 9) & 1) << 5)); }
__host__ __device__ __forceinline__ void stage_rc(int b, int& R, int& C) { const int st = b / 1024, sb = b % 1024, swz = sb ^ (((sb >> 9) & 1) << 5); R = (st >> 1) * 16 + swz / 64; C = (st & 1) * 32 + (swz % 64) / 2; }
__host__ __device__ __forceinline__ int perm32(int rho) { const int n = rho >> 4, i = rho & 15; return 8 * (i >> 2) + 4 * n + (i & 3); }
struct Unit { int pm, pn; };
struct Gemm { const bf16_t* A; const bf16_t* Bt; int M, N, K; };
struct StaticOrder {
    int nM, nN, nwg, G, c;
    __host__ __device__ void init(int M, int N, int G_, int c_) { nM = M / BM; nN = N / BM; nwg = nM * nN; G = G_; c = c_; }
    __host__ __device__ bool next(int i, Unit& u) const {
        const long L = (long)i * G + c; if (L >= nwg) return false;
        int wgid = (int)L; { const int q = nwg / NXCD, r = nwg % NXCD, xcd = wgid % NXCD, off = wgid / NXCD; wgid = (xcd < r ? xcd * (q + 1) : r * (q + 1) + (xcd - r) * q) + off; }
        const int nig = WGM * nN, gid = wgid / nig, fm = gid * WGM, gsz = (nM - fm) < WGM ? (nM - fm) : WGM;
        u.pm = fm + ((wgid % nig) % gsz); u.pn = (wgid % nig) / gsz; return true;
    }
    __device__ __forceinline__ void a_ready(const Unit&) const {}
    __device__ __forceinline__ void done(const Unit&) const {}
};
__device__ __forceinline__ unsigned cvt_pk_bf16(float lo, float hi) { unsigned r; asm volatile("v_cvt_pk_bf16_f32 %0, %1, %2" : "=v"(r) : "v"(lo), "v"(hi)); return r; }

struct EpiInProj {
    static constexpr bool PERM = true, AFTER_DRAIN = false;
    bf16_t *UP, *GP, *GA, *QL, *KVL;
    __device__ __forceinline__ void operator()(const f32x4 (&acc)[2][2][4][2], const Unit& u, int wr, int wc, int fr, int fq) const {
        const int row0 = u.pm * BM + wr * 64 + fr;
        bf16_t* base; int ldc, ncols = 256;
        switch (u.pn) {
            case 0: base = UP; ldc = 512; break;       case 1: base = UP + 256; ldc = 512; break;
            case 2: base = GP; ldc = 512; break;       case 3: base = GP + 256; ldc = 512; break;
            case 4: base = GA; ldc = 512; break;       case 5: base = GA + 256; ldc = 512; break;
            case 6: base = QL; ldc = 256; break;       default: base = KVL; ldc = 160; ncols = 160; break;
        }
        const int col0 = wc * 32 + 8 * fq;
#pragma unroll
        for (int ai = 0; ai < 2; ++ai)
#pragma unroll
            for (int m = 0; m < 4; ++m) { bf16_t* rowp = base + (size_t)(row0 + ai * HALF + m * 16) * ldc + col0;
#pragma unroll
                for (int bj = 0; bj < 2; ++bj) { const f32x4 v0 = acc[ai][bj][m][0], v1 = acc[ai][bj][m][1];
                    u32x4 w; w.x = cvt_pk_bf16(v0[0], v0[1]); w.y = cvt_pk_bf16(v0[2], v0[3]); w.z = cvt_pk_bf16(v1[0], v1[1]); w.w = cvt_pk_bf16(v1[2], v1[3]);
                    if (col0 + bj * HALF < ncols) *(u32x4*)(rowp + bj * HALF) = w; } }
    }
};
struct EpiOut {
    static constexpr bool PERM = false, AFTER_DRAIN = false;
    const float* x; const float* gate; float* out; int stg;
    __device__ __forceinline__ void prefetch(const Unit&, int, unsigned&) const {}
    __device__ __forceinline__ void operator()(const f32x4 (&acc)[2][2][4][2], const Unit& u, int wr, int wc, int fr, int fq) const {
        int lane = fq * 16 + fr; asm volatile("" : "+v"(lane));
        const int wbase = stg + (wr * 4 + wc) * 2304;
        const int waddr = wbase + (lane & 15) * 144 + (lane >> 4) * 16;
        const int r8 = lane >> 3, c8 = lane & 7;
        const int raddr = wbase + r8 * 144 + c8 * 16;
        const int b = (u.pm * BM) / SEQ; const int colw = u.pn * BM + wc * 32 + 4 * c8;
        f32x4 gv[2];
#pragma unroll
        for (int bj = 0; bj < 2; ++bj) gv[bj] = *(const f32x4*)(gate + (size_t)b * 1024 + colw + bj * HALF);
#pragma unroll
        for (int ai = 0; ai < 2; ++ai) {
            const size_t rbase = (size_t)(u.pm * BM + ai * HALF + wr * 64 + r8) * 1024 + colw;
            f32x4 xs[4][2][2];
#pragma unroll
            for (int m = 0; m < 4; ++m)
#pragma unroll
                for (int bj = 0; bj < 2; ++bj)
#pragma unroll
                    for (int h = 0; h < 2; ++h) xs[m][bj][h] = __builtin_nontemporal_load((const f32x4*)(x + rbase + (size_t)(m * 16 + h * 8) * 1024 + bj * HALF));
#pragma unroll
            for (int m = 0; m < 4; ++m) {
                f32x4 y[2][2];
#pragma unroll
                for (int bj = 0; bj < 2; ++bj) {
                    asm volatile("ds_write_b128 %0, %1\n\tds_write_b128 %0, %2 offset:64" :: "v"(waddr), "v"(acc[ai][bj][m][0]), "v"(acc[ai][bj][m][1]));
                    asm volatile("ds_read_b128 %0, %2\n\tds_read_b128 %1, %2 offset:1152" : "=&v"(y[bj][0]), "=&v"(y[bj][1]) : "v"(raddr)); }
                asm volatile("s_waitcnt lgkmcnt(0)" : "+v"(y[0][0]), "+v"(y[0][1]), "+v"(y[1][0]), "+v"(y[1][1]));
#pragma unroll
                for (int bj = 0; bj < 2; ++bj)
#pragma unroll
                    for (int h = 0; h < 2; ++h) *(f32x4*)(out + rbase + (size_t)(m * 16 + h * 8) * 1024 + bj * HALF) = xs[m][bj][h] + gv[bj] * y[bj][h];
            }
            asm volatile("" ::: "memory");
        }
    }
};

template <class Epi, class Sched, bool ALIGN_EPI = false, bool SP2 = false>
__device__ __forceinline__ void gemm_phase(PG8_LAS unsigned char* lds, const Gemm g, const Sched& S, const Epi& E) {
    const int tid = threadIdx.x, wid = __builtin_amdgcn_readfirstlane(tid >> 6), lane = tid & 63, wr = wid >> 2, wc = wid & 3, fr = lane & 15, fq = lane >> 4;
    const int K = g.K, nt = K / BK;
    unsigned voffA[2], voffB[2];
#pragma unroll
    for (int i = 0; i < 2; ++i) { int R, C; stage_rc(tid * 16 + i * 8192, R, C); const int Rb = Epi::PERM ? ((R & ~31) + perm32(R & 31)) : R;
        voffA[i] = (unsigned)(R * K + C) * 2u; voffB[i] = (unsigned)(Rb * K + C) * 2u; }
    const size_t kstep = (size_t)(BK * 2);
    const size_t hstep = (size_t)HALF * K * 2;
    const size_t tstep = 2 * hstep;
    const unsigned ldsw = (unsigned)wid * 1024u;
    const int aoff = lds_byte(wr * 64 + fr, fq * 8), boff = lds_byte(wc * 32 + fr, fq * 8);
#define PG8_SA(b, h) (((b) * 2 + (h)) * HTB)
#define PG8_SB(b, h) ((4 + (b) * 2 + (h)) * HTB)
#define PG8_STAGE(bufoff, gbase, voff) do { _Pragma("unroll") for (int _i = 0; _i < 2; ++_i) \
        __builtin_amdgcn_global_load_lds((const unsigned*)((const char*)(gbase) + (voff)[_i]), (PG8_LAS unsigned*)(lds + (bufoff) + ldsw + _i * 8192), 16, 0, 0); } while (0)
#define PG8_LDA(dst, b, h) do { _Pragma("unroll") for (int m = 0; m < 4; ++m) _Pragma("unroll") for (int k = 0; k < 2; ++k) dst[m][k] = *(const PG8_LAS bf16x8*)(lds + PG8_SA(b, h) + aoff + m * 2048 + k * 1024); } while (0)
#define PG8_LDB(dst, b, h) do { _Pragma("unroll") for (int n = 0; n < 2; ++n) _Pragma("unroll") for (int k = 0; k < 2; ++k) dst[n][k] = *(const PG8_LAS bf16x8*)(lds + PG8_SB(b, h) + boff + n * 2048 + k * 1024); } while (0)
#define PG8_MMA(ai, bj, At, Bt) do { __builtin_amdgcn_s_setprio(1); _Pragma("unroll") for (int m = 0; m < 4; ++m) _Pragma("unroll") for (int n = 0; n < 2; ++n) _Pragma("unroll") for (int k = 0; k < 2; ++k) \
        acc[ai][bj][m][n] = __builtin_amdgcn_mfma_f32_16x16x32_bf16(Bt[n][k], At[m][k], acc[ai][bj][m][n], 0, 0, 0); __builtin_amdgcn_s_setprio(0); } while (0)
#define PG8_WAIT_V(n) asm volatile("s_waitcnt vmcnt(" #n ")" ::: "memory")
#define PG8_WAIT_L(n) asm volatile("s_waitcnt lgkmcnt(" #n ")" ::: "memory")
#define PG8_BAR __builtin_amdgcn_s_barrier()
#define PG8_SCHED __builtin_amdgcn_sched_barrier(0)
    Unit cur, nxt; int ui = 0;
    if (!S.next(0, cur)) return;
    f32x4 acc[2][2][4][2];
#pragma unroll
    for (int a = 0; a < 2; ++a)
#pragma unroll
        for (int b = 0; b < 2; ++b)
#pragma unroll
            for (int m = 0; m < 4; ++m)
#pragma unroll
                for (int n = 0; n < 2; ++n) acc[a][b][m][n] = (f32x4){0.f, 0.f, 0.f, 0.f};
    bf16x8 At[4][2], B0[2][2], B1[2][2];
    const char* cA = (const char*)g.A + (size_t)cur.pm * tstep; const char* cB = (const char*)g.Bt + (size_t)cur.pn * tstep;
    S.a_ready(cur);
    if constexpr (SP2) {
        PG8_STAGE(PG8_SB(0, 0), cB, voffB); PG8_STAGE(PG8_SB(0, 1), cB + hstep, voffB); PG8_STAGE(PG8_SA(0, 0), cA, voffA); PG8_STAGE(PG8_SA(0, 1), cA + hstep, voffA);
        if (wr == 1) PG8_BAR;
        PG8_WAIT_V(2); PG8_BAR;
        PG8_STAGE(PG8_SB(1, 0), cB + kstep, voffB); PG8_STAGE(PG8_SA(1, 0), cA + kstep, voffA); PG8_STAGE(PG8_SB(1, 1), cB + hstep + kstep, voffB);
        PG8_WAIT_V(6); PG8_BAR;
    } else {
        PG8_STAGE(PG8_SB(0, 0), cB, voffB); PG8_STAGE(PG8_SA(0, 0), cA, voffA); PG8_STAGE(PG8_SB(0, 1), cB + hstep, voffB); PG8_STAGE(PG8_SA(0, 1), cA + hstep, voffA);
        if (wr == 1) PG8_BAR;
        PG8_WAIT_V(4); PG8_BAR;
        PG8_STAGE(PG8_SB(1, 0), cB + kstep, voffB); PG8_STAGE(PG8_SA(1, 0), cA + kstep, voffA); PG8_STAGE(PG8_SB(1, 1), cB + hstep + kstep, voffB);
        PG8_WAIT_V(6); PG8_BAR;
    }
    for (;;) {
        const bool has_next = S.next(ui + 1, nxt);
        const char* nA = has_next ? (const char*)g.A + (size_t)nxt.pm * tstep : cA; const char* nB = has_next ? (const char*)g.Bt + (size_t)nxt.pn * tstep : cB;
        for (int t = 0; t < nt; t += 2) {
            const bool last = (t == nt - 2);
            const char* a1 = cA + (size_t)(t + 1) * kstep;
            const char* a2 = last ? nA : cA + (size_t)(t + 2) * kstep; const char* b2 = last ? nB : cB + (size_t)(t + 2) * kstep;
            const char* a3 = a2 + kstep; const char* b3 = b2 + kstep;
            if (last && has_next) S.a_ready(nxt);
            if constexpr (SP2) {
            PG8_LDB(B0, 0, 0); PG8_LDB(B1, 0, 1); PG8_SCHED; PG8_LDA(At, 0, 0); PG8_STAGE(PG8_SA(1, 1), a1 + hstep, voffA);
            PG8_WAIT_V(8); PG8_WAIT_L(0); PG8_BAR; PG8_MMA(0, 0, At, B0); PG8_MMA(0, 1, At, B1); PG8_BAR; PG8_SCHED;
            PG8_LDA(At, 0, 1); PG8_STAGE(PG8_SB(0, 0), b2, voffB); PG8_STAGE(PG8_SB(0, 1), b2 + hstep, voffB); PG8_STAGE(PG8_SA(0, 0), a2, voffA);
            PG8_WAIT_V(8); PG8_WAIT_L(0); PG8_BAR; PG8_MMA(1, 0, At, B0); PG8_MMA(1, 1, At, B1); PG8_BAR; PG8_SCHED;
            PG8_LDB(B0, 1, 0); PG8_LDB(B1, 1, 1); PG8_SCHED; PG8_LDA(At, 1, 0); PG8_STAGE(PG8_SA(0, 1), a2 + hstep, voffA);
            PG8_WAIT_V(8); PG8_WAIT_L(0); PG8_BAR; PG8_MMA(0, 0, At, B0); PG8_MMA(0, 1, At, B1); PG8_BAR; PG8_SCHED;
            PG8_LDA(At, 1, 1); PG8_STAGE(PG8_SB(1, 0), b3, voffB); PG8_STAGE(PG8_SB(1, 1), b3 + hstep, voffB); PG8_STAGE(PG8_SA(1, 0), a3, voffA);
            PG8_WAIT_V(8); PG8_WAIT_L(0); PG8_BAR; PG8_MMA(1, 0, At, B0); PG8_MMA(1, 1, At, B1); PG8_BAR; PG8_SCHED;
            } else {
            PG8_LDB(B0, 0, 0); PG8_SCHED; PG8_LDA(At, 0, 0); PG8_STAGE(PG8_SA(1, 1), a1 + hstep, voffA);
            PG8_WAIT_L(8); PG8_BAR; PG8_WAIT_L(0); PG8_MMA(0, 0, At, B0); PG8_BAR; PG8_SCHED;
            PG8_LDB(B1, 0, 1); PG8_STAGE(PG8_SB(0, 0), b2, voffB);
            PG8_BAR; PG8_WAIT_L(0); PG8_MMA(0, 1, At, B1); PG8_BAR;
            PG8_LDA(At, 0, 1); PG8_STAGE(PG8_SA(0, 0), a2, voffA);
            PG8_BAR; PG8_WAIT_L(0); PG8_MMA(1, 0, At, B0); PG8_BAR; PG8_SCHED;
            PG8_STAGE(PG8_SB(0, 1), b2 + hstep, voffB);
            PG8_WAIT_V(6); PG8_BAR; PG8_MMA(1, 1, At, B1); PG8_BAR;
            PG8_LDB(B0, 1, 0); PG8_SCHED; PG8_LDA(At, 1, 0); PG8_STAGE(PG8_SA(0, 1), a2 + hstep, voffA);
            PG8_WAIT_L(8); PG8_BAR; PG8_WAIT_L(0); PG8_MMA(0, 0, At, B0); PG8_BAR; PG8_SCHED;
            PG8_LDB(B1, 1, 1); PG8_STAGE(PG8_SB(1, 0), b3, voffB);
            PG8_BAR; PG8_WAIT_L(0); PG8_MMA(0, 1, At, B1); PG8_BAR;
            PG8_LDA(At, 1, 1); PG8_STAGE(PG8_SA(1, 0), a3, voffA);
            PG8_BAR; PG8_WAIT_L(0); PG8_MMA(1, 0, At, B0); PG8_BAR; PG8_SCHED;
            PG8_STAGE(PG8_SB(1, 1), b3 + hstep, voffB);
            PG8_WAIT_V(6); PG8_BAR; PG8_MMA(1, 1, At, B1); PG8_BAR;
            }
        }
        if constexpr (ALIGN_EPI) { if (wr == 0) PG8_BAR; }
        if constexpr (!Epi::AFTER_DRAIN) { E(acc, cur, wr, wc, fr, fq); S.done(cur); }
        if (!has_next) break;
#pragma unroll
        for (int a = 0; a < 2; ++a)
#pragma unroll
            for (int b = 0; b < 2; ++b)
#pragma unroll
                for (int m = 0; m < 4; ++m)
#pragma unroll
                    for (int n = 0; n < 2; ++n) acc[a][b][m][n] = (f32x4){0.f, 0.f, 0.f, 0.f};
        cur = nxt; cA = nA; cB = nB; ++ui;
        if constexpr (ALIGN_EPI) { if (wr == 1) PG8_BAR; }
    }
    PG8_WAIT_V(0);
    if constexpr (!ALIGN_EPI) { if (wr == 0) PG8_BAR; }
    PG8_BAR;
#undef PG8_SA
#undef PG8_SB
#undef PG8_STAGE
#undef PG8_LDA
#undef PG8_LDB
#undef PG8_MMA
#undef PG8_WAIT_V
#undef PG8_WAIT_L
#undef PG8_BAR
#undef PG8_SCHED
}
}


namespace att {
using bf16x8 = __attribute__((ext_vector_type(8))) short;
using s16x4  = __attribute__((ext_vector_type(4))) short;
using f32x16 = __attribute__((ext_vector_type(16))) float;
using u32x4  = __attribute__((ext_vector_type(4))) unsigned;
constexpr int NW = 8, QBLK = 32, KVBLK = 64;
constexpr float SCALE = 0.10206207261596577f;
constexpr float THR = 8.f;
constexpr int SHM_V = 16384, SHM_K = 16384, SHM_ATTN = 2 * SHM_V + 2 * SHM_K + NW * 64 * 4;
#define KSWZ(row, colB) ((row) * 256 + ((colB) ^ (((row) & 15) << 4)))
#define SBAR() __builtin_amdgcn_sched_barrier(0)
__device__ __forceinline__ int crow(int r, int hi) { return (r & 3) + 8 * (r >> 2) + 4 * hi; }
__device__ __forceinline__ unsigned cvtpk(float lo, float hi) { unsigned r; asm volatile("v_cvt_pk_bf16_f32 %0, %1, %2" : "=v"(r) : "v"(lo), "v"(hi)); return r; }
typedef __bf16 bf16x2_t __attribute__((ext_vector_type(2)));
typedef float f32x2_t __attribute__((ext_vector_type(2)));
__device__ __forceinline__ unsigned cvtpk_b(float lo, float hi) { const f32x2_t f = {lo, hi}; const bf16x2_t b = __builtin_convertvector(f, bf16x2_t); return *reinterpret_cast<const unsigned*>(&b); }
__device__ __forceinline__ s16x4 tr_read_b(const LAS char* p) { return __builtin_amdgcn_ds_read_tr16_b64_v4i16((LAS s16x4*)p); }
__device__ __forceinline__ void partialSM(f32x16& p0, f32x16& p1, float& m_reg, float& mn, float& alpha) {
  constexpr float C = 1.f;
  float pmax = p0[0]; for (int r = 1; r < 16; ++r) pmax = fmaxf(pmax, p0[r]); for (int r = 0; r < 16; ++r) pmax = fmaxf(pmax, p1[r]);
  { auto rr = __builtin_amdgcn_permlane32_swap(__float_as_uint(pmax), __float_as_uint(pmax), false, false);
    pmax = fmaxf(__uint_as_float(rr[0]), __uint_as_float(rr[1])); }
  if (__builtin_expect(__all(pmax - m_reg <= THR * 1.4426950408889634f), 1)) { mn = m_reg; alpha = 1.f; }
  else { mn = fmaxf(m_reg, pmax); alpha = __builtin_amdgcn_exp2f((m_reg - mn) * C); m_reg = mn; }
  float mnC = -mn * C;
  for (int r = 0; r < 16; ++r) p0[r] = fmaf(p0[r], C, mnC); for (int r = 0; r < 16; ++r) p1[r] = fmaf(p1[r], C, mnC);
  for (int r = 0; r < 16; ++r) p0[r] = __builtin_amdgcn_exp2f(p0[r]);
}
__device__ __forceinline__ void finishSM(f32x16& p0, f32x16& p1, float alpha, float& l_reg, bf16x8& pa0, bf16x8& pa1, bf16x8& pa2, bf16x8& pa3) {
  for (int r = 0; r < 16; ++r) p1[r] = __builtin_amdgcn_exp2f(p1[r]);
  float ps = 0; for (int r = 0; r < 16; ++r) ps += p0[r]; for (int r = 0; r < 16; ++r) ps += p1[r];
  { auto rr = __builtin_amdgcn_permlane32_swap(__float_as_uint(ps), __float_as_uint(ps), false, false);
    ps = __uint_as_float(rr[0]) + __uint_as_float(rr[1]); }
  l_reg = l_reg * alpha + ps;
#define PK4(P, BASE, OUT) do { unsigned a0 = cvtpk(P[BASE + 0], P[BASE + 1]), a1 = cvtpk(P[BASE + 2], P[BASE + 3]);   \
    unsigned b0 = cvtpk(P[BASE + 4], P[BASE + 5]), b1 = cvtpk(P[BASE + 6], P[BASE + 7]);                              \
    auto r0 = __builtin_amdgcn_permlane32_swap(a0, b0, false, false); auto r1 = __builtin_amdgcn_permlane32_swap(a1, b1, false, false); \
    u32x4 w = {r0[0], r1[0], r0[1], r1[1]}; OUT = *reinterpret_cast<bf16x8*>(&w); } while (0)
  PK4(p0, 0, pa0); PK4(p0, 8, pa1); PK4(p1, 0, pa2); PK4(p1, 8, pa3);
#undef PK4
}
__device__ __forceinline__ void qkt(f32x16& p0, f32x16& p1, const LAS char* Ks, const bf16x8* qr, int r32, int hi) {
  p0 = f32x16{}; p1 = f32x16{};
#pragma unroll
  for (int d0 = 0; d0 < 6; ++d0) { int cb = (d0 * 16 + hi * 8) * 2;
    bf16x8 b0 = *reinterpret_cast<const LAS bf16x8*>(Ks + KSWZ(r32, cb));
    bf16x8 b1 = *reinterpret_cast<const LAS bf16x8*>(Ks + KSWZ(32 + r32, cb));
    p0 = __builtin_amdgcn_mfma_f32_32x32x16_bf16(b0, qr[d0], p0, 0, 0, 0);
    p1 = __builtin_amdgcn_mfma_f32_32x32x16_bf16(b1, qr[d0], p1, 0, 0, 0); }
}
__device__ __forceinline__ int v_st(int k, int c) { const int kk = (k & ~0xC) | ((k & 4) << 1) | ((k & 8) >> 1); return ((kk >> 3) * 4 + (c >> 5)) * 512 + ((kk & 7) * 32 + (c & 31)) * 2; }
__device__ __forceinline__ int v_rd_base(int lane) { return ((lane & 3) << 3) | (((lane >> 2) & 3) << 6) | (((lane >> 4) & 1) << 5) | (((lane >> 5) & 1) << 8); }
constexpr int v_rd_off(int d0, int ks, int half) { return d0 * 512 + ks * 4096 + half * 2048; }
template <int OFF> __device__ __forceinline__ s16x4 tr_read(int vb) {
  s16x4 r; asm volatile("ds_read_b64_tr_b16 %0, %1 offset:%2" : "=&v"(r) : "v"(vb), "i"(OFF) : "memory"); return r;
}
template <int D0> __device__ __forceinline__ void pv_one(f32x16& od, int vb, bf16x8 pa0, bf16x8 pa1, bf16x8 pa2, bf16x8 pa3) {
  const s16x4 l0 = tr_read<v_rd_off(D0, 0, 0)>(vb), h0 = tr_read<v_rd_off(D0, 0, 1)>(vb), l1 = tr_read<v_rd_off(D0, 1, 0)>(vb), h1 = tr_read<v_rd_off(D0, 1, 1)>(vb);
  const s16x4 l2 = tr_read<v_rd_off(D0, 2, 0)>(vb), h2 = tr_read<v_rd_off(D0, 2, 1)>(vb), l3 = tr_read<v_rd_off(D0, 3, 0)>(vb), h3 = tr_read<v_rd_off(D0, 3, 1)>(vb);
  asm volatile("s_waitcnt lgkmcnt(0)" ::: "memory"); SBAR();
#define PK(L, H) (bf16x8){L[0], L[1], L[2], L[3], H[0], H[1], H[2], H[3]}
  od = __builtin_amdgcn_mfma_f32_32x32x16_bf16(pa0, PK(l0, h0), od, 0, 0, 0);
  od = __builtin_amdgcn_mfma_f32_32x32x16_bf16(pa1, PK(l1, h1), od, 0, 0, 0);
  od = __builtin_amdgcn_mfma_f32_32x32x16_bf16(pa2, PK(l2, h2), od, 0, 0, 0);
  od = __builtin_amdgcn_mfma_f32_32x32x16_bf16(pa3, PK(l3, h3), od, 0, 0, 0);
#undef PK
}
__device__ __forceinline__ void pv_d0(f32x16* o, int vb, bf16x8 pa0, bf16x8 pa1, bf16x8 pa2, bf16x8 pa3) {
  pv_one<0>(o[0], vb, pa0, pa1, pa2, pa3); pv_one<1>(o[1], vb, pa0, pa1, pa2, pa3);
}
__device__ __forceinline__ void attn_unit(const bf16_t* Qb, const bf16_t* Kh, const bf16_t* Vh, const bf16_t* GAb, bf16_t* Yb, LAS char* lds) {
  const int tid = threadIdx.x, wid = tid >> 6, lane = tid & 63, r32 = lane & 31, hi = lane >> 5;
  LAS char* V_lds = lds; LAS char* K_lds = lds + 2 * SHM_V;
  LAS float* ws = (LAS float*)(lds + 2 * SHM_V + 2 * SHM_K) + wid * 64; LAS float* li_l = ws; LAS float* al_l = ws + 32;
  float m_reg = -1e30f, l_reg = 0; f32x16 o[2] = {}; bf16x8 qr[6];
  const bf16_t* Qw = Qb + (size_t)(wid * QBLK + r32) * DQK + hi * 8;
#pragma unroll
  for (int d0 = 0; d0 < 6; ++d0) qr[d0] = *reinterpret_cast<const bf16x8*>(Qw + d0 * 16);
  const int kst0 = KSWZ(tid / 12, (tid % 12) * 16), kst1 = KSWZ((512 + tid) / 12, ((512 + tid) % 12) * 16);
  const bool k2 = __builtin_amdgcn_readfirstlane(wid) < 4;
  const int vst = v_st(tid >> 3, (tid & 7) * 8);
  const int vb0 = (int)(uintptr_t)V_lds + v_rd_base(lane);
  struct { bf16x8 k0, k1, v; } sr_[2];
#define SLOAD(i, key0) do { const bf16_t* kp_ = Kh + (size_t)(key0) * DQK; sr_[i].k0 = *reinterpret_cast<const bf16x8*>(kp_ + tid * 8); \
    if (k2) sr_[i].k1 = *reinterpret_cast<const bf16x8*>(kp_ + (512 + tid) * 8); sr_[i].v = *reinterpret_cast<const bf16x8*>(Vh + (size_t)(key0) * DV + tid * 8); } while (0)
#define SWRITE(b, i) do { *(LAS bf16x8*)(K_lds + (b) * SHM_K + kst0) = sr_[i].k0; if (k2) *(LAS bf16x8*)(K_lds + (b) * SHM_K + kst1) = sr_[i].k1; \
    *(LAS bf16x8*)(V_lds + (b) * SHM_V + vst) = sr_[i].v; } while (0)
#define RESC(a) do { if (__any((a) < 1.f)) { if (hi == 0) al_l[r32] = (a); asm volatile("s_waitcnt lgkmcnt(0)" ::: "memory"); \
    for (int d = 0; d < 2; ++d) for (int r = 0; r < 16; ++r) o[d][r] *= al_l[crow(r, hi)]; } } while (0)
  f32x16 pA0, pA1, pB0, pB1; float mnA, mnB, alA, alB; bf16x8 pa0, pa1, pa2, pa3; constexpr int NT = SEQ / KVBLK;
  constexpr int SE = 0, SO = 1;
  SLOAD(SE, 0); SWRITE(0, SE); __syncthreads();
  qkt(pA0, pA1, K_lds, qr, r32, hi); partialSM(pA0, pA1, m_reg, mnA, alA);
  SLOAD(SO, KVBLK); SLOAD(SE, 2 * KVBLK);
  SWRITE(1, SO); __syncthreads();
  for (int j = 1; j + 1 < NT; j += 2) {
    SBAR(); qkt(pB0, pB1, K_lds + SHM_K, qr, r32, hi);
    finishSM(pA0, pA1, alA, l_reg, pa0, pa1, pa2, pa3); SBAR();
    SLOAD(SO, (j + 2) * KVBLK); SBAR();
    pv_d0(o, vb0, pa0, pa1, pa2, pa3); partialSM(pB0, pB1, m_reg, mnB, alB);
    __syncthreads(); SWRITE(0, SE);
    RESC(alB); __syncthreads();
    SBAR(); qkt(pA0, pA1, K_lds, qr, r32, hi);
    finishSM(pB0, pB1, alB, l_reg, pa0, pa1, pa2, pa3); SBAR();
    if (j + 3 < NT) SLOAD(SE, (j + 3) * KVBLK); SBAR();
    pv_d0(o, vb0 + SHM_V, pa0, pa1, pa2, pa3); partialSM(pA0, pA1, m_reg, mnA, alA);
    __syncthreads(); SWRITE(1, SO);
    RESC(alA); __syncthreads();
  }
  SBAR(); qkt(pB0, pB1, K_lds + SHM_K, qr, r32, hi);
  finishSM(pA0, pA1, alA, l_reg, pa0, pa1, pa2, pa3); SBAR();
  pv_d0(o, vb0, pa0, pa1, pa2, pa3); partialSM(pB0, pB1, m_reg, mnB, alB);
  __syncthreads(); RESC(alB);
  finishSM(pB0, pB1, alB, l_reg, pa0, pa1, pa2, pa3); SBAR();
  pv_d0(o, vb0 + SHM_V, pa0, pa1, pa2, pa3);
  if (hi == 0) li_l[r32] = l_reg; asm volatile("s_waitcnt lgkmcnt(0)" ::: "memory");
  float rli[16];
#pragma unroll
  for (int r = 0; r < 16; ++r) rli[r] = __builtin_amdgcn_rcpf(li_l[crow(r, hi)]);
#pragma unroll
  for (int r = 0; r < 16; ++r) { const int orow = wid * QBLK + crow(r, hi);
#pragma unroll
    for (int d0 = 0; d0 < 2; ++d0) { const int col = d0 * 32 + r32; const float g = bf2f(GAb[(size_t)orow * 512 + col]);
      Yb[(size_t)orow * 1024 + col] = f2bf(o[d0][r] * rli[r] * siluf(g)); } }
  __syncthreads();
#undef SLOAD
#undef SWRITE
#undef RESC
}

constexpr int DST = 5, DSTB = 24576, DV_OFF = 16384;
template <int D0> __device__ __forceinline__ void pv_one_c(f32x16& od, int vb, bf16x8 pa0, bf16x8 pa1, bf16x8 pa2, bf16x8 pa3) {
  const s16x4 l0 = tr_read<D0 * 512 + 0>(vb), h0 = tr_read<D0 * 512 + 1024>(vb), l1 = tr_read<D0 * 512 + 2048>(vb), h1 = tr_read<D0 * 512 + 3072>(vb);
  const s16x4 l2 = tr_read<D0 * 512 + 4096>(vb), h2 = tr_read<D0 * 512 + 5120>(vb), l3 = tr_read<D0 * 512 + 6144>(vb), h3 = tr_read<D0 * 512 + 7168>(vb);
  asm volatile("s_waitcnt lgkmcnt(0)" ::: "memory"); SBAR();
#define PK(L, H) (bf16x8){L[0], L[1], L[2], L[3], H[0], H[1], H[2], H[3]}
  od = __builtin_amdgcn_mfma_f32_32x32x16_bf16(pa0, PK(l0, h0), od, 0, 0, 0);
  od = __builtin_amdgcn_mfma_f32_32x32x16_bf16(pa1, PK(l1, h1), od, 0, 0, 0);
  od = __builtin_amdgcn_mfma_f32_32x32x16_bf16(pa2, PK(l2, h2), od, 0, 0, 0);
  od = __builtin_amdgcn_mfma_f32_32x32x16_bf16(pa3, PK(l3, h3), od, 0, 0, 0);
#undef PK
}
typedef unsigned u32x2a __attribute__((ext_vector_type(2)));
template <int D0> __device__ __forceinline__ void pv_one_t(f32x16& od, int vb, bf16x8 pa0, bf16x8 pa1, bf16x8 pa2, bf16x8 pa3) {
  const s16x4 l0 = tr_read<D0 * 512 + 0>(vb), h0 = tr_read<D0 * 512 + 1024>(vb), l1 = tr_read<D0 * 512 + 2048>(vb), h1 = tr_read<D0 * 512 + 3072>(vb);
  const s16x4 l2 = tr_read<D0 * 512 + 4096>(vb), h2 = tr_read<D0 * 512 + 5120>(vb), l3 = tr_read<D0 * 512 + 6144>(vb), h3 = tr_read<D0 * 512 + 7168>(vb);
  asm volatile("s_waitcnt lgkmcnt(0)" ::: "memory"); SBAR();
#define PK(L, H) (bf16x8){L[0], L[1], L[2], L[3], H[0], H[1], H[2], H[3]}
  od = __builtin_amdgcn_mfma_f32_32x32x16_bf16(PK(l0, h0), pa0, od, 0, 0, 0);
  od = __builtin_amdgcn_mfma_f32_32x32x16_bf16(PK(l1, h1), pa1, od, 0, 0, 0);
  od = __builtin_amdgcn_mfma_f32_32x32x16_bf16(PK(l2, h2), pa2, od, 0, 0, 0);
  od = __builtin_amdgcn_mfma_f32_32x32x16_bf16(PK(l3, h3), pa3, od, 0, 0, 0);
#undef PK
}
__device__ __forceinline__ void epi_tile(const f32x16& o0, const f32x16& o1, float l_acc, int l2, bf16_t* Yg, size_t tw, int h, LAS char* stgo) {
  { auto rr = __builtin_amdgcn_permlane32_swap(__float_as_uint(l_acc), __float_as_uint(l_acc), false, false); l_acc = __uint_as_float(rr[0]) + __uint_as_float(rr[1]); }
  const int qb2 = l2 & 31, hib = l2 >> 5;
  const float rl = __builtin_amdgcn_rcpf(l_acc);
#pragma unroll
  for (int d0 = 0; d0 < 2; ++d0) {
    const f32x16& od = d0 ? o1 : o0;
#pragma unroll
    for (int rg = 0; rg < 4; ++rg) { LAS u32x2a* sp = (LAS u32x2a*)(stgo + qb2 * 128 + ((((4 * d0 + rg) ^ (qb2 & 7))) << 4) + 8 * hib);
      const u32x2a gw = *sp;
      const float g0 = __uint_as_float(gw.x << 16), g1 = __uint_as_float(gw.x & 0xffff0000u), g2 = __uint_as_float(gw.y << 16), g3 = __uint_as_float(gw.y & 0xffff0000u);
      u32x2a w; w.x = cvtpk(od[4 * rg] * rl * siluf(g0), od[4 * rg + 1] * rl * siluf(g1)); w.y = cvtpk(od[4 * rg + 2] * rl * siluf(g2), od[4 * rg + 3] * rl * siluf(g3));
      *sp = w; } }
  asm volatile("s_waitcnt lgkmcnt(0)" ::: "memory");
  char* ydst = (char*)(Yg + tw * 1024 + 512 + h * 64);
#pragma unroll
  for (int j = 0; j < 4; ++j) { const int id = l2 + 64 * j, row = id >> 3, c = id & 7;
    const u32x4 v = *(const LAS u32x4*)(stgo + row * 128 + ((c ^ (row & 7)) << 4));
    __builtin_nontemporal_store(v, (u32x4*)(ydst + (size_t)row * 2048 + c * 16)); }
}
__device__ __forceinline__ void ga_dma(const bf16_t* GAg, size_t tw, int h, int l2, LAS char* stgo) {
  const int rq = l2 >> 3, ph = l2 & 7; const char* gsrc = (const char*)(GAg + tw * 512 + h * 64);
#pragma unroll
  for (int p = 0; p < 4; ++p) { const int row = 8 * p + rq;
    __builtin_amdgcn_global_load_lds((const unsigned*)(gsrc + (size_t)row * 1024 + ((ph ^ (row & 7)) << 4)), (LAS unsigned*)(stgo + p * 1024), 16, 0, 0); }
}
__device__ __forceinline__ void ga_load(const bf16_t* GAg, size_t tw, int h, int l2, u32x4 (&g)[4]) {
  const int rq = l2 >> 3, ph = l2 & 7; const char* gsrc = (const char*)(GAg + tw * 512 + h * 64);
#pragma unroll
  for (int p = 0; p < 4; ++p) { const int row = 8 * p + rq; g[p] = *(const u32x4*)(gsrc + (size_t)row * 1024 + ((ph ^ (row & 7)) << 4)); }
}
__device__ __forceinline__ void ga_write(int l2, LAS char* stgo, const u32x4 (&g)[4]) {
#pragma unroll
  for (int p = 0; p < 4; ++p) *(LAS u32x4*)(stgo + p * 1024 + l2 * 16) = g[p];
}
__device__ __forceinline__ void attn_phase_fast(const bf16_t* Qg, const bf16_t* Kg, const bf16_t* Vg, const bf16_t* GAg, bf16_t* Yg, int u0, int ustride, int utotal, LAS char* lds) {
  const int tid = threadIdx.x, wid = __builtin_amdgcn_readfirstlane(tid >> 6), lane = tid & 63, r32 = lane & 31, hi = lane >> 5;
  if (u0 >= utotal) return;
  unsigned koff0, voff;
  { const int row0 = 4 * wid + (lane >> 4), ph = lane & 15; const int lg0 = ph ^ (row0 & 15);
    koff0 = (unsigned)(row0 * 192 + (lg0 < 12 ? lg0 : 0) * 16);
    const int st = 2 * wid + (lane >> 5), s = lane & 31, k = (st >> 1) * 8 + (s >> 2), c = (st & 1) * 32 + 8 * (s & 3); voff = (unsigned)(k * 128 + c * 2); }
  const int vb0 = (int)(uintptr_t)lds + DV_OFF + v_rd_base(lane);
  constexpr int NT = SEQ / KVBLK;
  const bf16_t* Kh; const bf16_t* Vh;
#define DMA_TILE(t, sb) do { const char* kt_ = (const char*)Kh + (size_t)(t) * (KVBLK * DQK * 2); const char* vt_ = (const char*)Vh + (size_t)(t) * (KVBLK * DV * 2); \
    asm volatile("" : "+s"(kt_), "+s"(vt_));     \
    __builtin_amdgcn_global_load_lds((const unsigned*)(kt_ + koff0), (LAS unsigned*)(lds + (sb) + wid * 1024), 16, 0, 0); \
    __builtin_amdgcn_global_load_lds((const unsigned*)(kt_ + 32 * 192 + koff0), (LAS unsigned*)(lds + (sb) + (wid + 8) * 1024), 16, 0, 0); \
    __builtin_amdgcn_global_load_lds((const unsigned*)(vt_ + voff), (LAS unsigned*)(lds + (sb) + DV_OFF + wid * 1024), 16, 0, 0); } while (0)
#define UNIT_BEGIN(uu) do { const int bh_ = (uu) >> 2, qb_ = (uu) & 3; Kh = Kg + (size_t)bh_ * SEQ * DQK; Vh = Vg + (size_t)bh_ * SEQ * DV; \
    int l3_ = lane; asm volatile("" : "+v"(l3_));     \
    const bf16_t* Qw_ = Qg + ((size_t)bh_ * SEQ + qb_ * 512 + wid * 64 + (l3_ & 31)) * DQK + (l3_ >> 5) * 8; \
    _Pragma("unroll") for (int d0 = 0; d0 < 6; ++d0) qA[d0] = *reinterpret_cast<const bf16x8*>(Qw_ + d0 * 16); \
    _Pragma("unroll") for (int d0 = 0; d0 < 6; ++d0) qB[d0] = *reinterpret_cast<const bf16x8*>(Qw_ + 32 * DQK + d0 * 16); \
    DMA_TILE(0, 0); DMA_TILE(1, DSTB); DMA_TILE(2, 2 * DSTB); DMA_TILE(3, 3 * DSTB); } while (0)
  bf16x8 qA[6], qB[6], kf[6];
  const f32x16 zero16 = {};
  f32x16 s0, s1; bf16x8 pa0, pa1;
  s16x4 vl0, vh0, vl1, vh1, vl2, vh2, vl3, vh3;
#define KLOAD(off, KH) do { int kx_ = ((r32 & 15) ^ hi) << 4; asm volatile("" : "+v"(kx_)); \
    const LAS char* Ks = lds + (off) + r32 * 256 + (KH) * 8192; \
    _Pragma("unroll") for (int d0 = 0; d0 < 6; ++d0) kf[d0] = *reinterpret_cast<const LAS bf16x8*>(Ks + ((d0 * 32) ^ kx_)); } while (0)
#define QKC(S, QR) do { \
    _Pragma("unroll") for (int d0 = 0; d0 < 6; ++d0) S = __builtin_amdgcn_mfma_f32_32x32x16_bf16(kf[d0], QR[d0], d0 == 0 ? zero16 : S, 0, 0, 0); } while (0)
#define VLOAD(vb, KH) do { \
    vl0 = tr_read<(KH) * 4096 + 0>(vb); vh0 = tr_read<(KH) * 4096 + 1024>(vb); vl1 = tr_read<(KH) * 4096 + 2048>(vb); vh1 = tr_read<(KH) * 4096 + 3072>(vb); \
    vl2 = tr_read<512 + (KH) * 4096 + 0>(vb); vh2 = tr_read<512 + (KH) * 4096 + 1024>(vb); vl3 = tr_read<512 + (KH) * 4096 + 2048>(vb); vh3 = tr_read<512 + (KH) * 4096 + 3072>(vb); } while (0)
#define WAITLV() asm volatile("s_waitcnt lgkmcnt(0)" : "+v"(vl0), "+v"(vh0), "+v"(vl1), "+v"(vh1), "+v"(vl2), "+v"(vh2), "+v"(vl3), "+v"(vh3) :: "memory")
#define SGB(mask, n) __builtin_amdgcn_sched_group_barrier(mask, n, 0)
#define SLOTPAT() do { _Pragma("unroll") for (int g_ = 0; g_ < 10; ++g_) { SGB(0x008, 1); SGB(0x002, 4); } } while (0)
#define SOFT(S, LACC) do { \
    _Pragma("unroll") for (int r = 0; r < 16; ++r) S[r] = __builtin_amdgcn_exp2f(S[r]); \
    { float s_ = S[0]; _Pragma("unroll") for (int r = 1; r < 16; ++r) s_ += S[r]; LACC += s_; asm volatile("" : "+v"(LACC)); }     \
    { u32x4 w0 = {cvtpk_b(S[0], S[1]), cvtpk_b(S[2], S[3]), cvtpk_b(S[4], S[5]), cvtpk_b(S[6], S[7])}; pa0 = *reinterpret_cast<bf16x8*>(&w0); \
      u32x4 w1 = {cvtpk_b(S[8], S[9]), cvtpk_b(S[10], S[11]), cvtpk_b(S[12], S[13]), cvtpk_b(S[14], S[15])}; pa1 = *reinterpret_cast<bf16x8*>(&w1); } } while (0)
#define PK(L, H) (bf16x8){L[0], L[1], L[2], L[3], H[0], H[1], H[2], H[3]}
#define PVC(O) do { \
    O[0] = __builtin_amdgcn_mfma_f32_32x32x16_bf16(PK(vl0, vh0), pa0, O[0], 0, 0, 0); \
    O[1] = __builtin_amdgcn_mfma_f32_32x32x16_bf16(PK(vl2, vh2), pa0, O[1], 0, 0, 0); \
    O[0] = __builtin_amdgcn_mfma_f32_32x32x16_bf16(PK(vl1, vh1), pa1, O[0], 0, 0, 0); \
    O[1] = __builtin_amdgcn_mfma_f32_32x32x16_bf16(PK(vl3, vh3), pa1, O[1], 0, 0, 0); } while (0)
#define WAITBAR(N) asm volatile("s_waitcnt vmcnt(" #N ") lgkmcnt(0)\n\ts_barrier" ::: "memory")
#define ADV(x) ((x) == (DST - 1) * DSTB ? 0 : (x) + DSTB)
#define FSTEP(jj, L, Q, VM) do { \
    if (L) DMA_TILE((jj) + 4, s_n4); \
    SBAR(); \
    VLOAD(vb0 + s_cur, 0); QKC(s1, qB); KLOAD(s_cur, 1); SOFT(s0, lA); WAITLV(); PVC(oA); SLOTPAT();     \
    SBAR(); \
    QKC(s0, qA); SOFT(s1, lB); PVC(oB); SLOTPAT(); \
    SBAR(); \
    VLOAD(vb0 + s_cur, 1); QKC(s1, qB); if (Q) KLOAD(s_n1, 0); SOFT(s0, lA); WAITLV(); PVC(oA); SLOTPAT(); \
    SBAR(); \
    if (Q) QKC(s0, qA); \
    SOFT(s1, lB); PVC(oB); SLOTPAT(); \
    WAITBAR(VM); \
    s_cur = s_n1; s_n1 = ADV(s_n1); s_n4 = ADV(s_n4); } while (0)
  int u = u0;
  UNIT_BEGIN(u);
  if (wid >= 4) __builtin_amdgcn_s_setprio(1);
#pragma unroll 1
  for (;;) {
    asm volatile("" : "+v"(qA[0]), "+v"(qA[1]), "+v"(qA[2]), "+v"(qA[3]), "+v"(qA[4]), "+v"(qA[5]));
    asm volatile("" : "+v"(qB[0]), "+v"(qB[1]), "+v"(qB[2]), "+v"(qB[3]), "+v"(qB[4]), "+v"(qB[5]));
    f32x16 oA[2] = {}, oB[2] = {}; float lA = 0.f, lB = 0.f;
    { int l4 = lane; asm volatile("" : "+v"(l4)); const int bh = u >> 2, qb = u & 3, b = bh / NH, h = bh % NH;
      ga_dma(GAg, (size_t)b * SEQ + qb * 512 + wid * 64, h, l4, lds + 124928 + wid * 4096); }
    WAITBAR(8);
    KLOAD(0, 0); QKC(s0, qA);
    int s_cur = 0, s_n1 = DSTB, s_n4 = 4 * DSTB;
#pragma unroll 1
    for (int j = 0; j + 4 < NT; ++j) { FSTEP(j, true, true, 6); }
    FSTEP(NT - 4, false, true, 3); FSTEP(NT - 3, false, true, 0);
    FSTEP(NT - 2, false, true, 0); FSTEP(NT - 1, false, false, 0);
    const int ucur = u; const int un = u + ustride; const bool has_next = un < utotal;
    if (has_next) UNIT_BEGIN(un);
    { const int bh = ucur >> 2, qb = ucur & 3, b = bh / NH, h = bh % NH;
      const size_t tw = (size_t)b * SEQ + qb * 512 + wid * 64;
      LAS char* stgo = lds + 124928 + wid * 4096;
      int l2 = lane; asm volatile("" : "+v"(l2) :: "memory");
      u32x4 gB[4]; ga_load(GAg, tw + 32, h, l2, gB);
      epi_tile(oA[0], oA[1], lA, l2, Yg, tw, h, stgo);
      ga_write(l2, stgo, gB);
      epi_tile(oB[0], oB[1], lB, l2, Yg, tw + 32, h, stgo); }
    if (!has_next) break;
    u = un;
  }
  __builtin_amdgcn_s_setprio(0);
  __syncthreads();
#undef FSTEP
#undef ADV
#undef WAITBAR
#undef PVC
#undef PK
#undef SOFT
#undef SLOTPAT
#undef SGB
#undef WAITLV
#undef VLOAD
#undef QKC
#undef KLOAD
#undef DMA_TILE
#undef UNIT_BEGIN
}
#undef KSWZ
#undef SBAR
}

struct Frame {
    LAS unsigned char* lds;
    int tid, lane, wave, vb, G;
    float* modp; float* rope; float* gate;
    bf16_t *WIN, *WUQ, *WUKV, *WPOOL, *WOUT;
    bf16_t *XN, *UP, *GP, *GA, *QL, *KVL, *Q, *K, *V, *Y;
};
__device__ __forceinline__ float mod_val(const Params& P, const Frame& F, int b, int e) {
    float s = P.ada_b[e];
#pragma unroll
    for (int kq = 0; kq < 4; ++kq) s += F.modp[((size_t)kq * 16 + b) * 3072 + e];
    return s;
}

__device__ __forceinline__ void ph0_mod(const Params& P, Frame& F) {
    LAS float* cact = (LAS float*)F.lds;
    LAS float* red = (LAS float*)(F.lds + 65536);
    int have = -1;
    for (int item = F.vb; item < 192; item += F.G) {
        const int cg = item % 48, kq = item / 48;
        const int col = cg * 64 + F.lane, r0 = kq * 256 + F.wave * 32;
        float wv[32];
#pragma unroll
        for (int r = 0; r < 32; ++r) wv[r] = P.ada_w[(size_t)(r0 + r) * 3072 + col];
        if (have != kq) {
            float cv[8];
#pragma unroll
            for (int j = 0; j < 8; ++j) { const int i = F.tid + NTHREADS * j; cv[j] = P.c[(i >> 8) * 1024 + kq * 256 + (i & 255)]; }
            __syncthreads();
#pragma unroll
            for (int j = 0; j < 8; ++j) { const int i = F.tid + NTHREADS * j; cact[(i & 255) * 16 + (i >> 8)] = siluf(cv[j]); }
            __syncthreads(); have = kq; }
        float acc[16];
#pragma unroll
        for (int b = 0; b < 16; ++b) acc[b] = 0.f;
#pragma unroll
        for (int r = 0; r < 32; ++r) {
            const LAS f32x4_t* cr = (const LAS f32x4_t*)(cact + (F.wave * 32 + r) * 16);
            const f32x4_t c0 = cr[0], c1 = cr[1], c2 = cr[2], c3 = cr[3];
            acc[0] += c0[0] * wv[r]; acc[1] += c0[1] * wv[r]; acc[2] += c0[2] * wv[r]; acc[3] += c0[3] * wv[r];
            acc[4] += c1[0] * wv[r]; acc[5] += c1[1] * wv[r]; acc[6] += c1[2] * wv[r]; acc[7] += c1[3] * wv[r];
            acc[8] += c2[0] * wv[r]; acc[9] += c2[1] * wv[r]; acc[10] += c2[2] * wv[r]; acc[11] += c2[3] * wv[r];
            acc[12] += c3[0] * wv[r]; acc[13] += c3[1] * wv[r]; acc[14] += c3[2] * wv[r]; acc[15] += c3[3] * wv[r];
        }
#pragma unroll
        for (int b = 0; b < 16; ++b) red[(F.wave * 16 + b) * 64 + F.lane] = acc[b];
        __syncthreads();
        for (int o = F.tid; o < 1024; o += NTHREADS) {
            const int b = o >> 6, cl = o & 63; float s = 0.f;
#pragma unroll
            for (int w = 0; w < 8; ++w) s += red[(w * 16 + b) * 64 + cl];
            F.modp[((size_t)kq * 16 + b) * 3072 + cg * 64 + cl] = s;
        }
        __syncthreads();
    }
}


__device__ __forceinline__ unsigned pk2(float lo, float hi) { return (unsigned)f2bf(lo) | ((unsigned)f2bf(hi) << 16); }
__device__ __forceinline__ void p0_transpose_item(const float* W, int K, int N, int nsrc0, bf16_t* WT, int ndst0, int k0, LAS float* scr, int lane) {
    if (nsrc0 >= 0) {
        float tv[32];
#pragma unroll
        for (int i = 0; i < 32; ++i) { const int kk = 2 * i + (lane >> 5); tv[i] = W[(size_t)(k0 + kk) * N + nsrc0 + (lane & 31)]; }
#pragma unroll
        for (int i = 0; i < 32; ++i) { const int kk = 2 * i + (lane >> 5); scr[kk * 33 + (lane & 31)] = tv[i]; }
    } else {
#pragma unroll 8
        for (int i = 0; i < 32; ++i) { const int kk = 2 * i + (lane >> 5); scr[kk * 33 + (lane & 31)] = 0.f; }
    }
    asm volatile("s_waitcnt lgkmcnt(0)" ::: "memory");
    const int c = lane & 7;
#pragma unroll
    for (int j = 0; j < 4; ++j) { const int n = (lane >> 3) + 8 * j; const LAS float* s = scr + (8 * c) * 33 + n;
        uint4 o; o.x = pk2(s[0 * 33], s[1 * 33]); o.y = pk2(s[2 * 33], s[3 * 33]); o.z = pk2(s[4 * 33], s[5 * 33]); o.w = pk2(s[6 * 33], s[7 * 33]);
        *(uint4*)(WT + (size_t)(ndst0 + n) * K + k0 + 8 * c) = o; }
    asm volatile("s_waitcnt lgkmcnt(0)" ::: "memory");
}
__device__ __forceinline__ int win_src_col(int n) { return n < 1024 ? n : (n < 1536 ? OFF_GA + (n - 1024) : (n < 1792 ? OFF_QL + (n - 1536) : (n < 1952 ? OFF_KVL + (n - 1792) : -1))); }
__device__ __forceinline__ void ph0_weights(const Params& P, Frame& F) {
    LAS float* scr = (LAS float*)(F.lds + F.wave * 16384);
    const int NGW = F.G * NWAVES, gw = F.vb * NWAVES + F.wave;
    constexpr int I_IN = 16 * 48, I_OUT = 16 * 32;
    for (int it = gw; it < I_IN + I_OUT; it += NGW) {
        if (it < I_IN) { const int kb = it / 48, nb = 16 + it % 48; if (nb >= 16) p0_transpose_item(P.w_in, DM, INW, win_src_col(32 * nb), F.WIN, 32 * nb, 64 * kb, scr, F.lane); }
        else { const int r = it - I_IN, kb = r / 32, nb = r % 32; p0_transpose_item(P.w_out, DM, DM, 32 * nb, F.WOUT, 32 * nb, 64 * kb, scr, F.lane); }
    }
}

__device__ __forceinline__ void ph1_xn(const Params& P, Frame& F, unsigned* modcnt) {
    LAS float* gs = (LAS float*)F.lds; LAS float* sh = gs + 1024;
#define XN_LOAD(V, I0) do { _Pragma("unroll") for (int q = 0; q < 4; ++q) { const f32x4_t* xr = (const f32x4_t*)(P.x + (size_t)(row0 + F.wave * 16 + (I0) + q) * 1024) + F.lane; \
        _Pragma("unroll") for (int j = 0; j < 4; ++j) V[q][j] = __builtin_nontemporal_load(xr + 64 * j); } } while (0)
#define XN_PROC(V, I0) do { float ss[4]; \
        _Pragma("unroll") for (int q = 0; q < 4; ++q) { float s = 0.f; \
            _Pragma("unroll") for (int j = 0; j < 4; ++j) s += (V[q][j][0] * V[q][j][0] + V[q][j][1] * V[q][j][1]) + (V[q][j][2] * V[q][j][2] + V[q][j][3] * V[q][j][3]); \
            ss[q] = s; } \
        _Pragma("unroll") for (int o = 1; o < 64; o <<= 1) { _Pragma("unroll") for (int q = 0; q < 4; ++q) ss[q] += __shfl_xor(ss[q], o); } \
        _Pragma("unroll") for (int q = 0; q < 4; ++q) { const float r = rsqrtf(ss[q] * (1.f / 1024.f) + EPS); const int t = row0 + F.wave * 16 + (I0) + q; \
            _Pragma("unroll") for (int j = 0; j < 4; ++j) { \
                const float o0 = (V[q][j][0] * r) * gr[j].x + sr[j].x, o1 = (V[q][j][1] * r) * gr[j].y + sr[j].y, o2 = (V[q][j][2] * r) * gr[j].z + sr[j].z, o3 = (V[q][j][3] * r) * gr[j].w + sr[j].w; \
                const unsigned long long pk = (unsigned long long)((unsigned)f2bf(o0) | ((unsigned)f2bf(o1) << 16)) | ((unsigned long long)((unsigned)f2bf(o2) | ((unsigned)f2bf(o3) << 16)) << 32); \
                __hip_atomic_store((unsigned long long*)(F.XN + (size_t)t * 1024 + 4 * F.lane + 256 * j), pk, __ATOMIC_RELAXED, __HIP_MEMORY_SCOPE_AGENT); } } } while (0)
    for (int item = F.vb; item < TOK / 128; item += F.G) {
        const int row0 = item * 128, b = row0 / SEQ;
        f32x4_t va[4][4], vb[4][4];
        XN_LOAD(va, 0);
        if (modcnt != nullptr && item == F.vb) {
            if (F.tid == 0) { unsigned sp = 0; while (__hip_atomic_load(modcnt, __ATOMIC_RELAXED, __HIP_MEMORY_SCOPE_AGENT) < 192u) { __builtin_amdgcn_s_sleep(2); if (++sp > (1u << 22)) break; }
                __builtin_amdgcn_fence(__ATOMIC_ACQUIRE, "agent"); asm volatile("s_waitcnt vmcnt(0)" ::: "memory"); }
        }
        __syncthreads();
        for (int d = F.tid; d < 1024; d += NTHREADS) { const float sc = mod_val(P, F, b, 1024 + d), sf = mod_val(P, F, b, d); gs[d] = P.norm_g[d] * (1.f + sc); sh[d] = sf; }
        if (F.tid < 64) { const int n = (item % 16) * 64 + F.tid; F.gate[(size_t)b * 1024 + n] = mod_val(P, F, b, 2048 + n); }
#pragma unroll 1
        for (int e = F.tid; e < 2048; e += NTHREADS) { const int t = row0 + (e >> 4), f = e & 15;
            const float ang = (float)P.pos[t] * INVF[f]; float sn, cs; sincosf(ang, &sn, &cs);
            F.rope[(size_t)t * 32 + f] = cs; F.rope[(size_t)t * 32 + 16 + f] = sn; }
        __syncthreads();
        f32x4_t gr[4], sr[4];
#pragma unroll
        for (int j = 0; j < 4; ++j) { gr[j] = *(const LAS f32x4_t*)(gs + 4 * F.lane + 256 * j); sr[j] = *(const LAS f32x4_t*)(sh + 4 * F.lane + 256 * j); }
        XN_LOAD(vb, 4);  XN_PROC(va, 0);
        XN_LOAD(va, 8);  XN_PROC(vb, 4);
        XN_LOAD(vb, 12); XN_PROC(va, 8);
        XN_PROC(vb, 12);
    }
    __syncthreads();
#undef XN_LOAD
#undef XN_PROC
}

namespace up {
using bf16x8 = __attribute__((ext_vector_type(8))) short;
using f32x16 = __attribute__((ext_vector_type(16))) float;
__device__ __forceinline__ float half_sum(float v) { auto rr = __builtin_amdgcn_permlane32_swap(__float_as_uint(v), __float_as_uint(v), false, false); return __uint_as_float(rr[0]) + __uint_as_float(rr[1]); }
__device__ __forceinline__ uint2 pack4(float a, float b, float c, float d) { uint2 r; r.x = att::cvtpk(a, b); r.y = att::cvtpk(c, d); return r; }
__device__ __forceinline__ float sumsq8(bf16x8 v) { float s = 0.f;
#pragma unroll
    for (int j = 0; j < 8; ++j) { const float a = bf2f((bf16_t)v[j]); s += a * a; } return s; }

__device__ __forceinline__ void p0_frag_weights(const Params& P, Frame& F) {
    const int NT = F.G * NTHREADS; int gt = F.vb * NTHREADS + F.tid - (F.G == 256 ? 160 * NTHREADS : 0); if (gt < 0) gt += NT;
    for (int id = gt; id < 49152; id += NT) {
        float v[8]; bf16_t* dst;
        if (id < 24576) { const int l = id & 63, ks = (id >> 6) & 15, ti = id >> 10; const int n = (ti / 3) * 96 + (ti % 3) * 32 + (l & 31), k0 = ks * 16 + 8 * (l >> 5);
#pragma unroll
            for (int j = 0; j < 8; ++j) v[j] = P.g_q_lat[k0 + j] * P.w_uq[(size_t)(k0 + j) * 768 + n];
            dst = F.WUQ + (size_t)id * 8; }
        else if (id < 40960) { const int id2 = id - 24576; const int l = id2 & 63, ks = (id2 >> 6) & 7, ti = id2 >> 9; const int n = (ti >> 2) * 128 + (ti & 3) * 32 + (l & 31), k0 = ks * 16 + 8 * (l >> 5);
#pragma unroll
            for (int j = 0; j < 8; ++j) v[j] = P.g_kv_lat[k0 + j] * P.w_ukv[(size_t)(k0 + j) * 1024 + n];
            dst = F.WUKV + (size_t)id2 * 8; }
        else { const int id3 = id - 40960; const int l = id3 & 63, ks = (id3 >> 6) & 7, ti = id3 >> 9; const int gi = ti >> 2, d = (ti & 3) * 32 + (l & 31), k0 = ks * 16 + 8 * (l >> 5);
#pragma unroll
            for (int j = 0; j < 8; ++j) v[j] = P.pool_w[((size_t)gi * 128 + k0 + j) * 128 + d];
            dst = F.WPOOL + (size_t)id3 * 8; }
        uint4 o; o.x = pk2(v[0], v[1]); o.y = pk2(v[2], v[3]); o.z = pk2(v[4], v[5]); o.w = pk2(v[6], v[7]);
        *(uint4*)dst = o;
    }
}

}


namespace up2 {
using up::bf16x8; using up::f32x16; using up::half_sum; using up::sumsq8;
typedef unsigned u32x4 __attribute__((ext_vector_type(4)));
typedef unsigned u32x2 __attribute__((ext_vector_type(2)));
typedef float f32x4v __attribute__((ext_vector_type(4)));
__device__ __forceinline__ u32x2 pack4(float a, float b, float c, float d) { u32x2 r; r.x = att::cvtpk(a, b); r.y = att::cvtpk(c, d); return r; }
constexpr int STG_OFF = 69632, STG_WAVE = 8704;
template <int CH, int RS> __device__ __forceinline__ void tile_store(LAS char* stg, char* gbase, int gpitch, int lane) {
    asm volatile("s_waitcnt lgkmcnt(0)" : "+v"(lane) :: "memory");
#pragma unroll
    for (int j = 0; j < CH / 2; ++j) { const int id = lane + 64 * j, row = id / CH, c = id % CH;
        const u32x4 v = *(const LAS u32x4*)(stg + row * RS + c * 16);
        *(u32x4*)(gbase + (size_t)row * gpitch + c * 16) = v; }
}
__device__ __forceinline__ void wdma(const bf16_t* tile, int npieces8, LAS char* wbuf, int wave, int lane) {
    asm volatile("" : "+v"(lane));
#pragma unroll
    for (int j = 0; j < 6; ++j) if (j < npieces8) { const int p = wave + 8 * j;
        __builtin_amdgcn_global_load_lds((const unsigned*)((const char*)tile + p * 1024 + lane * 16), (LAS unsigned*)(wbuf + p * 1024), 16, 0, 0); }
}
__device__ __forceinline__ void up_unit(const Params& P, Frame& F, int tb, int hh) {
    const int lane = F.lane, wave = F.wave, r32 = lane & 31, hi = lane >> 5;
    const int tw0 = tb * 256 + wave * 32, t = tw0 + r32, b = tw0 / SEQ, sw0 = tw0 % SEQ;
    LAS char* wb0 = (LAS char*)F.lds; LAS char* stg = (LAS char*)F.lds + 98304 + wave * 6656;
#define LOAD_ROPE() int tl_ = t; asm volatile("" : "+v"(tl_) :: "memory"); const float* rp_ = F.rope + (size_t)tl_ * 32 + 4 * hi; \
    const float4 c0 = *(const float4*)(rp_), c1 = *(const float4*)(rp_ + 8), s0 = *(const float4*)(rp_ + 16), s1 = *(const float4*)(rp_ + 24); \
    const float cs[8] = {c0.x, c0.y, c0.z, c0.w, c1.x, c1.y, c1.z, c1.w}, sn[8] = {s0.x, s0.y, s0.z, s0.w, s1.x, s1.y, s1.z, s1.w};
    __syncthreads();
    LAS float* gl = (LAS float*)(F.lds + 151552);
    if (F.tid < 192) gl[F.tid] = F.tid < 96 ? P.g_qnorm[F.tid] : P.g_knorm[F.tid - 96];
    wdma(F.WUQ + (size_t)(hh * 4) * 24576, 6, wb0, wave, lane);
    {
        bf16x8 bq[16]; float ssq = 0.f;
#pragma unroll
        for (int ks = 0; ks < 16; ++ks) { bq[ks] = *reinterpret_cast<const bf16x8*>(F.QL + (size_t)t * 256 + ks * 16 + hi * 8); ssq += sumsq8(bq[ks]); }
        ssq = half_sum(ssq);
        const float rq = rsqrtf(ssq * (1.f / QLORA) + EPS);
#pragma unroll 1
        for (int hq = 0; hq < 4; ++hq) {
            const int h = hh * 4 + hq;
            if (hq == 0) asm volatile("s_waitcnt vmcnt(0) lgkmcnt(0)\n\ts_barrier" ::: "memory"); else asm volatile("s_waitcnt vmcnt(6) lgkmcnt(0)\n\ts_barrier" ::: "memory");
            LAS char* wbuf = wb0 + (hq & 1) * 49152;
            { LAS char* wnext = wb0 + ((hq + 1) & 1) * 49152;
              if (hq < 3) wdma(F.WUQ + (size_t)(h + 1) * 24576, 6, wnext, wave, lane); else wdma(F.WUKV + (size_t)(hh * 4) * 16384, 4, wnext, wave, lane); }
            f32x16 acc[3] = {};
#pragma unroll
            for (int i = 0; i < 3; ++i)
#pragma unroll
                for (int ks = 0; ks < 16; ++ks) { const bf16x8 a = *(const LAS bf16x8*)(wbuf + ((i * 16 + ks) * 64 + lane) * 16); acc[i] = __builtin_amdgcn_mfma_f32_32x32x16_bf16(a, bq[ks], acc[i], 0, 0, 0); if ((ks & 7) == 7) asm volatile("" ::: "memory"); }
            LOAD_ROPE();
            const LAS float* gqn = gl;
            float s2 = 0.f;
#pragma unroll
            for (int i = 0; i < 3; ++i)
#pragma unroll
                for (int r = 0; r < 16; ++r) { acc[i][r] *= rq; s2 += acc[i][r] * acc[i][r]; }
            s2 = half_sum(s2);
            const float rh = rsqrtf(s2 * (1.f / DQK) + EPS) * CQ;
#pragma unroll
            for (int i = 0; i < 3; ++i) {
#pragma unroll
                for (int rg = 0; rg < 4; ++rg) { const f32x4v g = *(const LAS f32x4v*)(gqn + 32 * i + 8 * rg + 4 * hi);
                    acc[i][4 * rg + 0] *= rh * g.x; acc[i][4 * rg + 1] *= rh * g.y; acc[i][4 * rg + 2] *= rh * g.z; acc[i][4 * rg + 3] *= rh * g.w; }
                if (i == 2) {
#pragma unroll
                    for (int r = 0; r < 8; ++r) { const float x1 = acc[2][r], x2 = acc[2][r + 8]; acc[2][r] = x1 * cs[r] - x2 * sn[r]; acc[2][r + 8] = x2 * cs[r] + x1 * sn[r]; } }
#pragma unroll
                for (int rg = 0; rg < 4; ++rg) *(LAS u32x2*)(stg + r32 * 208 + (32 * i + 8 * rg + 4 * hi) * 2) = pack4(acc[i][4 * rg], acc[i][4 * rg + 1], acc[i][4 * rg + 2], acc[i][4 * rg + 3]);
                asm volatile("" ::: "memory");
            }
            asm volatile("s_waitcnt vmcnt(0)" ::: "memory");
            tile_store<12, 208>(stg, (char*)(F.Q + ((size_t)(b * NH + h) * SEQ + sw0) * DQK), DQK * 2, lane);
        }
    }
    {
        bf16x8 bk[8]; float ssq = 0.f;
        int t2 = t; asm volatile("" : "+v"(t2) :: "memory");
#pragma unroll
        for (int ks = 0; ks < 8; ++ks) { bk[ks] = *reinterpret_cast<const bf16x8*>(F.KVL + (size_t)t2 * 160 + ks * 16 + hi * 8); ssq += sumsq8(bk[ks]); }
        ssq = half_sum(ssq);
        const float rkv = rsqrtf(ssq * (1.f / KVLORA) + EPS);
        float kr[16]; float kr2 = 0.f;
#pragma unroll
        for (int rg = 0; rg < 4; ++rg) { const uint2 w = *(const uint2*)(F.KVL + (size_t)t2 * 160 + 128 + 8 * rg + 4 * hi);
            kr[4 * rg + 0] = __uint_as_float(w.x << 16); kr[4 * rg + 1] = __uint_as_float(w.x & 0xffff0000u); kr[4 * rg + 2] = __uint_as_float(w.y << 16); kr[4 * rg + 3] = __uint_as_float(w.y & 0xffff0000u); }
#pragma unroll
        for (int r = 0; r < 16; ++r) kr2 += kr[r] * kr[r];
#pragma unroll 1
        for (int hq = 0; hq < 4; ++hq) {
            const int h = hh * 4 + hq;
            if (hq == 0) asm volatile("s_waitcnt vmcnt(0) lgkmcnt(0)\n\ts_barrier" ::: "memory"); else asm volatile("s_waitcnt vmcnt(10) lgkmcnt(0)\n\ts_barrier" ::: "memory");
            LAS char* wbuf = wb0 + (hq & 1) * 49152;
            if (hq < 3) wdma(F.WUKV + (size_t)(h + 1) * 16384, 4, wb0 + ((hq + 1) & 1) * 49152, wave, lane);
            f32x16 acc[4] = {};
#pragma unroll
            for (int i = 0; i < 4; ++i)
#pragma unroll
                for (int ks = 0; ks < 8; ++ks) { const bf16x8 a = *(const LAS bf16x8*)(wbuf + ((i * 8 + ks) * 64 + lane) * 16); acc[i] = __builtin_amdgcn_mfma_f32_32x32x16_bf16(a, bk[ks], acc[i], 0, 0, 0); if ((ks & 7) == 7) asm volatile("" ::: "memory"); }
            LOAD_ROPE();
            const LAS float* gkn = gl + 96;
            float s2 = kr2;
#pragma unroll
            for (int i = 0; i < 4; ++i)
#pragma unroll
                for (int r = 0; r < 16; ++r) { acc[i][r] *= rkv; if (i < 2) s2 += acc[i][r] * acc[i][r]; }
            s2 = half_sum(s2);
            const float rh = rsqrtf(s2 * (1.f / DQK) + EPS);
#pragma unroll
            for (int i = 0; i < 2; ++i) {
#pragma unroll
                for (int rg = 0; rg < 4; ++rg) { const f32x4v g = *(const LAS f32x4v*)(gkn + 32 * i + 8 * rg + 4 * hi);
                    *(LAS u32x2*)(stg + r32 * 208 + (32 * i + 8 * rg + 4 * hi) * 2) = pack4(acc[i][4 * rg] * rh * g.x, acc[i][4 * rg + 1] * rh * g.y, acc[i][4 * rg + 2] * rh * g.z, acc[i][4 * rg + 3] * rh * g.w); }
                asm volatile("" ::: "memory"); }
            { float kn[16];
#pragma unroll
            for (int rg = 0; rg < 4; ++rg) { const f32x4v g = *(const LAS f32x4v*)(gkn + 64 + 8 * rg + 4 * hi);
                kn[4 * rg] = kr[4 * rg] * rh * g.x; kn[4 * rg + 1] = kr[4 * rg + 1] * rh * g.y; kn[4 * rg + 2] = kr[4 * rg + 2] * rh * g.z; kn[4 * rg + 3] = kr[4 * rg + 3] * rh * g.w; }
            {
#pragma unroll
            for (int r = 0; r < 8; ++r) { const float x1 = kn[r], x2 = kn[r + 8]; kn[r] = x1 * cs[r] - x2 * sn[r]; kn[r + 8] = x2 * cs[r] + x1 * sn[r]; } }
#pragma unroll
            for (int rg = 0; rg < 4; ++rg) *(LAS u32x2*)(stg + r32 * 208 + (64 + 8 * rg + 4 * hi) * 2) = pack4(kn[4 * rg], kn[4 * rg + 1], kn[4 * rg + 2], kn[4 * rg + 3]); }
            asm volatile("s_waitcnt vmcnt(0)" ::: "memory");
            tile_store<12, 208>(stg, (char*)(F.K + ((size_t)(b * NH + h) * SEQ + sw0) * DQK), DQK * 2, lane);
#pragma unroll
            for (int i = 0; i < 2; ++i)
#pragma unroll
                for (int rg = 0; rg < 4; ++rg) *(LAS u32x2*)(stg + r32 * 144 + (32 * i + 8 * rg + 4 * hi) * 2) = pack4(acc[2 + i][4 * rg], acc[2 + i][4 * rg + 1], acc[2 + i][4 * rg + 2], acc[2 + i][4 * rg + 3]);
            tile_store<8, 144>(stg, (char*)(F.V + ((size_t)(b * NH + h) * SEQ + sw0) * DV), DV * 2, lane);
        }
    }
#undef LOAD_ROPE
}
}


namespace up3 {
using up::bf16x8; using up::f32x16; using up::half_sum; using up::sumsq8;
using up2::u32x4; using up2::u32x2; using up2::f32x4v; using up2::pack4; using up2::tile_store; using up2::STG_OFF; using up2::STG_WAVE;
template <int GI> __device__ __forceinline__ void stencil_job_t(const Params& P, Frame& F, int strip) {
    constexpr int half = 1 << GI, NR = 8 + 2 * half;
    const int lane = F.lane, rq = lane >> 4, ch = lane & 15;
    const int t0 = strip * 32, b = t0 / SEQ, s0 = t0 % SEQ, sb = s0 + 8 * rq;
    const bf16_t* ub = F.UP + (size_t)b * SEQ * 512 + GI * 128 + ch * 8;
    bf16x8 rows[NR], gv[8];
#pragma unroll
    for (int i = 0; i < NR; ++i) { const int sp = sb - half + i; const int spc = sp < 0 ? 0 : (sp >= SEQ ? SEQ - 1 : sp); rows[i] = *reinterpret_cast<const bf16x8*>(ub + (size_t)spc * 512); }
#pragma unroll
    for (int k = 0; k < 8; ++k) gv[k] = __builtin_nontemporal_load(reinterpret_cast<const bf16x8*>(F.GP + ((size_t)b * SEQ + sb + k) * 512 + GI * 128 + ch * 8));
    const float4 psa = *(const float4*)(P.pool_scale + GI * 128 + ch * 8), psb = *(const float4*)(P.pool_scale + GI * 128 + ch * 8 + 4);
    const float ps[8] = {psa.x, psa.y, psa.z, psa.w, psb.x, psb.y, psb.z, psb.w};
    float sum[8];
#pragma unroll
    for (int j = 0; j < 8; ++j) sum[j] = 0.f;
#pragma unroll
    for (int i = 0; i < 2 * half; ++i) { const int sp = sb - half + i; const bool ok = (sp >= 0) && (sp < SEQ);
#pragma unroll
        for (int j = 0; j < 8; ++j) sum[j] += ok ? bf2f((bf16_t)rows[i][j]) : 0.f; }
#pragma unroll
    for (int k = 0; k < 8; ++k) {
        const int s = sb + k; const int lo = (s - half) > 0 ? (s - half) : 0, hi_ = (s + half) < SEQ ? (s + half) : SEQ;
        const float inv = 1.f / (float)(hi_ - lo);
        float y[8];
#pragma unroll
        for (int j = 0; j < 8; ++j) y[j] = (sum[j] * inv - bf2f((bf16_t)rows[half + k][j])) * ps[j] * siluf(bf2f((bf16_t)gv[k][j]));
        u32x4 w; w.x = att::cvtpk(y[0], y[1]); w.y = att::cvtpk(y[2], y[3]); w.z = att::cvtpk(y[4], y[5]); w.w = att::cvtpk(y[6], y[7]);
        __builtin_nontemporal_store(w, (u32x4*)(F.Y + ((size_t)b * SEQ + s) * 1024 + GI * 128 + ch * 8));
        if (k < 7) { const int so = s - half, sn_ = s + half; const bool oko = so >= 0, okn = sn_ < SEQ;
#pragma unroll
            for (int j = 0; j < 8; ++j) sum[j] += (okn ? bf2f((bf16_t)rows[k + 2 * half][j]) : 0.f) - (oko ? bf2f((bf16_t)rows[k][j]) : 0.f); }
    }
}
__device__ __forceinline__ void stencil_job(const Params& P, Frame& F, int strip, int gi) {
    if (gi == 0) stencil_job_t<0>(P, F, strip); else if (gi == 1) stencil_job_t<1>(P, F, strip); else if (gi == 2) stencil_job_t<2>(P, F, strip); else stencil_job_t<3>(P, F, strip);
}
__device__ __forceinline__ void fold_pool_weights(const Params& P, Frame& F) {
    const int NGW0 = F.G * NWAVES, lane = F.lane; const bool tail64 = (F.G == 256);
    const int gw = tail64 ? (F.vb - 192) * NWAVES + F.wave : F.vb * NWAVES + F.wave, NGW = tail64 ? 64 * NWAVES : NGW0;
    if (gw < 0) return;
    LAS float* wt = (LAS float*)(F.lds + F.wave * 16384);
    for (int it = gw; it < 1024; it += NGW) {
        const int kb = it >> 3, nc = it & 7, g = nc >> 1, d = (nc & 1) * 64 + lane;
        const float* wrow = P.w_in + (size_t)(kb * 8) * INW + g * 128;
        float wv[8][2];
#pragma unroll
        for (int j = 0; j < 8; ++j) { wv[j][0] = wrow[(size_t)j * INW + lane]; wv[j][1] = wrow[(size_t)j * INW + 64 + lane]; }
#pragma unroll
        for (int j = 0; j < 8; ++j) { wt[lane * 8 + j] = wv[j][0]; wt[(64 + lane) * 8 + j] = wv[j][1]; }
        asm volatile("s_waitcnt lgkmcnt(0)" ::: "memory");
        float acc[8];
#pragma unroll
        for (int j = 0; j < 8; ++j) acc[j] = 0.f;
        const float* pw = P.pool_w + (size_t)g * 128 * 128 + d;
#pragma unroll 16
        for (int c = 0; c < 128; ++c) { const float pv = pw[(size_t)c * 128];
            const f32x4_t wa = *(const LAS f32x4_t*)(wt + c * 8), wb = *(const LAS f32x4_t*)(wt + c * 8 + 4);
            acc[0] += wa.x * pv; acc[1] += wa.y * pv; acc[2] += wa.z * pv; acc[3] += wa.w * pv; acc[4] += wb.x * pv; acc[5] += wb.y * pv; acc[6] += wb.z * pv; acc[7] += wb.w * pv; }
        uint4 o; o.x = pk2(acc[0], acc[1]); o.y = pk2(acc[2], acc[3]); o.z = pk2(acc[4], acc[5]); o.w = pk2(acc[6], acc[7]);
        *(uint4*)(F.WIN + (size_t)(g * 128 + d) * 1024 + kb * 8) = o;
        asm volatile("s_waitcnt lgkmcnt(0)" ::: "memory");
    }
}
__device__ __forceinline__ void ph3_v3(const Params& P, Frame& F) {
    const int gw = F.vb * NWAVES + F.wave, NGW = F.G * NWAVES;
    for (int u = F.vb; u < 256; u += F.G) up2::up_unit(P, F, u >> 1, u & 1);
    for (int it = gw; it < 2048; it += NGW) { stencil_job(P, F, it >> 1, (it & 1) ? 1 : 0); stencil_job(P, F, it >> 1, (it & 1) ? 2 : 3); }
    __syncthreads();
}
}

__device__ __forceinline__ void ph4_attn_mfma(const Params& P, Frame& F) {
    float gq = 0.f, gk = 0.f;
    for (int d = F.lane; d < DQK; d += 64) { gq = fmaxf(gq, fabsf(P.g_qnorm[d])); gk = fmaxf(gk, fabsf(P.g_knorm[d])); }
#pragma unroll
    for (int o = 1; o < 64; o <<= 1) { gq = fmaxf(gq, __shfl_xor(gq, o)); gk = fmaxf(gk, __shfl_xor(gk, o)); }
    const float kbound = 1.01f * 9.797958971132712f * gk;
    const float mglob = 1.01f * CQ * 9.797958971132712f * gq * kbound;
    const bool fast = __builtin_amdgcn_readfirstlane(mglob <= 60.f ? 1 : 0) != 0;
    if (fast) {
        att::attn_phase_fast(F.Q, F.K, F.V, F.GA, F.Y, F.vb, F.G, NB * NH * 4, (LAS char*)F.lds);
    } else {
        for (int u = F.vb; u < NB * NH * 8; u += F.G) {
            const int bh = u >> 3, qb = u & 7, b = bh / NH, h = bh % NH;
            const size_t t0 = (size_t)b * SEQ + qb * 256;
            att::attn_unit(F.Q + ((size_t)bh * SEQ + qb * 256) * DQK, F.K + (size_t)bh * SEQ * DQK, F.V + (size_t)bh * SEQ * DV,
                           F.GA + t0 * 512 + h * 64, F.Y + t0 * 1024 + 512 + h * 64, (LAS char*)F.lds);
        }
    }
}

__global__ void __launch_bounds__(NTHREADS, 2) fwd_kernel(Params P) {
    extern __shared__ __attribute__((aligned(16))) unsigned char lds[];
    Frame F;
    F.lds = (LAS unsigned char*)lds;
    F.tid = threadIdx.x; F.lane = F.tid & 63; F.wave = __builtin_amdgcn_readfirstlane(F.tid >> 6);
    F.G = gridDim.x; { const int bx = blockIdx.x; F.vb = (F.G % 8 == 0) ? (bx % 8) * (F.G / 8) + bx / 8 : bx; }
    unsigned char* ws = P.ws + (size_t)P.pad * MiB;
    F.modp = (float*)(ws + WS_MODP); F.rope = (float*)(ws + WS_ROPE); F.gate = (float*)(ws + WS_GATE);
    F.WIN = (bf16_t*)(ws + WS_WIN); F.WUQ = (bf16_t*)(ws + WS_WUQ); F.WUKV = (bf16_t*)(ws + WS_WUKV); F.WPOOL = (bf16_t*)(ws + WS_WPOOL); F.WOUT = (bf16_t*)(ws + WS_WOUT);
    F.XN = (bf16_t*)(ws + WS_XN); F.UP = (bf16_t*)(ws + WS_UP); F.GP = (bf16_t*)(ws + WS_GP); F.GA = (bf16_t*)(ws + WS_GA);
    F.QL = (bf16_t*)(ws + WS_QL); F.KVL = (bf16_t*)(ws + WS_KVL); F.Q = (bf16_t*)(ws + WS_Q); F.K = (bf16_t*)(ws + WS_K); F.V = (bf16_t*)(ws + WS_V); F.Y = (bf16_t*)(ws + WS_Y);
    volatile LAS unsigned* MISC = (volatile LAS unsigned*)(F.lds + MISC_OFF);
    for (int u = F.tid; u < (LDS_BYTES - LDSCTL_OFF) / 4; u += NTHREADS) ((LAS unsigned*)(F.lds + LDSCTL_OFF))[u] = 0u;
    __syncthreads();
    const int lo = P.ph_lo, hi = P.ph_hi;
    XcdBarrier bar; bar.bar = (unsigned*)(ws + WS_CTL) + CW_BAR + P.li * XCD_BAR_WORDS; bar.x = 0; bar.st = nullptr;
    if (hi - lo > 1) bar = xcd_barrier_post((unsigned*)(ws + WS_CTL) + CW_BAR + P.li * XCD_BAR_WORDS, MISC + 8);
#define IN(k) (lo <= (k) && (k) < hi)
    unsigned long long ts_a = 0, ts_b = 0;
#define SEAM(k) do { if (IN(k) && IN((k) + 1)) xcd_barrier(bar); if (PROBE_TS == (k) + 1) ts_a = __builtin_amdgcn_s_memrealtime(); if (PROBE_TS == (k)) ts_b = __builtin_amdgcn_s_memrealtime(); } while (0)
    if (PROBE_TS == 0 || PROBE_TS == 6) ts_a = __builtin_amdgcn_s_memrealtime();
    if (IN(0) && IN(1)) {
        unsigned* modcnt = (unsigned*)(ws + WS_CTL) + CW_MODCNT;
        int nitems = 0; for (int item = F.vb; item < 192; item += F.G) ++nitems;
        ph0_mod(P, F);
        if (nitems) { asm volatile("s_waitcnt vmcnt(0)" ::: "memory"); __syncthreads();
            if (F.tid == 0) { __builtin_amdgcn_fence(__ATOMIC_RELEASE, "agent"); asm volatile("s_waitcnt vmcnt(0)" ::: "memory"); __hip_atomic_fetch_add(modcnt, (unsigned)nitems, __ATOMIC_RELAXED, __HIP_MEMORY_SCOPE_AGENT); } }
        ph0_weights(P, F); up::p0_frag_weights(P, F); up3::fold_pool_weights(P, F);
        ph1_xn(P, F, modcnt);
        if (PROBE_TS == 0) ts_b = __builtin_amdgcn_s_memrealtime();
        SEAM(1);
    } else {
        if (IN(0)) { ph0_mod(P, F); } SEAM(0);
        if (IN(1)) { ph1_xn(P, F, nullptr); ph0_weights(P, F); up::p0_frag_weights(P, F); up3::fold_pool_weights(P, F); } SEAM(1);
    }
    if (IN(2)) { pg8::Gemm g{F.XN, F.WIN, TOK, 2048, DM}; pg8::StaticOrder S; S.init(TOK, 2048, F.G, (int)blockIdx.x);
        pg8::EpiInProj E{F.UP, F.GP, F.GA, F.QL, F.KVL};
        pg8::gemm_phase<pg8::EpiInProj, pg8::StaticOrder, true, true>(F.lds, g, S, E); } SEAM(2);
    if (IN(3)) { up3::ph3_v3(P, F); } SEAM(3);
    if (IN(4)) { ph4_attn_mfma(P, F); } SEAM(4);
    if (IN(5)) { pg8::Gemm g{F.Y, F.WOUT, TOK, DM, DM}; pg8::StaticOrder S; S.init(TOK, DM, F.G, (int)blockIdx.x);
        pg8::EpiOut E{P.x, F.gate, P.out, (int)(uintptr_t)F.lds + 131072};
        pg8::gemm_phase<pg8::EpiOut, pg8::StaticOrder, true, true>(F.lds, g, S, E); }
    if (PROBE_TS >= 0) { xcd_barrier(bar); if (PROBE_TS >= 5) ts_b = __builtin_amdgcn_s_memrealtime();
        if (blockIdx.x == 0 && F.tid == 0) { const float us = (float)(ts_b - ts_a) * 0.01f; P.out[0] = P.out[0] + us * 0.01f; } }
#undef IN
#undef SEAM
}

extern "C" void kernel_launch(void* const* d_in, const int* in_sizes, int n_in, void* d_out, int out_size, void* d_ws, size_t ws_size, hipStream_t stream) {
    static int grid = 0;
    if (grid == 0) {
        if (n_in != 16 || in_sizes[0] != TOK * DM || out_size != TOK * DM || ws_size < WS_END) {
            fprintf(stderr, "kernel_launch: shape mismatch: n_in %d in0 %d out %d ws %zu\n", n_in, n_in > 0 ? in_sizes[0] : -1, out_size, ws_size); grid = -1; return; }
        int dev = 0, cus = 0, per_cu = 0;
        if (hipGetDevice(&dev) != hipSuccess || hipDeviceGetAttribute(&cus, hipDeviceAttributeMultiprocessorCount, dev) != hipSuccess) { grid = -1; return; }
        if (hipFuncSetAttribute((const void*)fwd_kernel, hipFuncAttributeMaxDynamicSharedMemorySize, LDS_BYTES) != hipSuccess) { fprintf(stderr, "kernel_launch: hipFuncSetAttribute failed\n"); grid = -1; return; }
        if (hipOccupancyMaxActiveBlocksPerMultiprocessor(&per_cu, (const void*)fwd_kernel, NTHREADS, LDS_BYTES) != hipSuccess || per_cu < 1) {
            fprintf(stderr, "kernel_launch: occupancy query reports %d blocks per CU\n", per_cu); (void)hipGetLastError(); grid = -1; return; }
        grid = cus;
    }
    if (grid < 0) return;
    const int shift_mib = (int)((ws_size - WS_END) / (2 * MiB)) * 2;
    (void)hipMemsetAsync((char*)d_ws + (size_t)shift_mib * MiB + WS_CTL, 0, CTL_ZERO_BYTES, stream);
    Params p{}; p.pad = shift_mib;
    p.x = (const float*)d_in[0]; p.c = (const float*)d_in[1]; p.pos = (const int*)d_in[2]; p.ada_w = (const float*)d_in[3]; p.ada_b = (const float*)d_in[4];
    p.norm_g = (const float*)d_in[5]; p.w_in = (const float*)d_in[6]; p.pool_w = (const float*)d_in[7]; p.pool_scale = (const float*)d_in[8];
    p.g_q_lat = (const float*)d_in[9]; p.w_uq = (const float*)d_in[10]; p.g_kv_lat = (const float*)d_in[11]; p.w_ukv = (const float*)d_in[12];
    p.g_qnorm = (const float*)d_in[13]; p.g_knorm = (const float*)d_in[14]; p.w_out = (const float*)d_in[15];
    p.out = (float*)d_out; p.ws = (unsigned char*)d_ws;
    if (PROBE_DUP >= 100) {
        p.ph_lo = 0; p.ph_hi = PROBE_DUP - 100 + 1; p.li = 0;
        hipLaunchKernelGGL(fwd_kernel, dim3(grid), dim3(NTHREADS), LDS_BYTES, stream, p);
        p.ph_lo = PROBE_DUP - 100; p.ph_hi = N_PHASES; p.li = 1;
        hipLaunchKernelGGL(fwd_kernel, dim3(grid), dim3(NTHREADS), LDS_BYTES, stream, p);
    } else if (MK_N_LAUNCHES == 1) {
        p.ph_lo = 0; p.ph_hi = N_PHASES;
        hipLaunchKernelGGL(fwd_kernel, dim3(grid), dim3(NTHREADS), LDS_BYTES, stream, p);
    } else {
        for (int k = 0; k < N_PHASES; ++k) { p.ph_lo = k; p.ph_hi = k + 1; hipLaunchKernelGGL(fwd_kernel, dim3(grid), dim3(NTHREADS), LDS_BYTES, stream, p); }
    }
    const hipError_t le = hipPeekAtLastError();
    if (le != hipSuccess) fprintf(stderr, "kernel_launch: launch failed: %s\n", hipGetErrorName(le));
}
```
